# Optimizing an MI355X kernel written in HIP

```python
import math
import jax, jax.numpy as jnp
from jax import lax
import numpy as np

D_MODEL = 1024
BATCH = 4
SEQ = 4096
DEPTH = 2

N_BRANCH = 4
MIX_W = D_MODEL // N_BRANCH
HEAD_DIM = 64
BLOCK = 128
A_HEADS = MIX_W // HEAD_DIM
A_KV = A_HEADS // 2
WINDOW = 128
B_HEADS = MIX_W // HEAD_DIM
B_KV = B_HEADS // 2
ROPE_THETA = 10000.0
GRID_W = 64
C_VDIM = HEAD_DIM
C_DIM = C_VDIM // 2
C_HEADS = MIX_W // C_VDIM
C_KV = C_HEADS // 2
D_HEADS = 4
D_KDIM = MIX_W // D_HEADS
D_VDIM = MIX_W // D_HEADS
CHUNK = 64
N_META = 16
FRONT = (-N_META) % BLOCK
META_END = FRONT + N_META
N_BUCKETS = 32
MAX_DIST = 128
D_FF = -(-(8 * D_MODEL) // (3 * 256)) * 256
RMS_EPS = 1e-6
MASK_VALUE = -1e30
F_FLOOR = 1e-30
IN_WIDTHS = (A_HEADS * HEAD_DIM, A_KV * HEAD_DIM, A_KV * HEAD_DIM,
             B_HEADS * HEAD_DIM, B_KV * HEAD_DIM, B_KV * HEAD_DIM,
             C_HEADS * 2 * C_DIM, C_KV * 2 * C_DIM, C_KV * C_VDIM,
             D_HEADS * D_KDIM, D_HEADS * D_KDIM, D_HEADS * D_KDIM, D_HEADS * D_VDIM, D_HEADS * D_VDIM,
             N_BRANCH * D_MODEL)
IN_TOTAL = sum(IN_WIDTHS)

kernel_name = 'hybrid_gated_parallel_encoder'


def rms_norm(x, g):
    x32 = x.astype(jnp.float32)
    y = x32 * lax.rsqrt(jnp.mean(x32 * x32, axis=-1, keepdims=True) + RMS_EPS)
    return (y * g.astype(jnp.float32)).astype(x.dtype)


def split_in(proj):
    idx, acc = [], 0
    for w in IN_WIDTHS[:-1]:
        acc += w
        idx.append(acc)
    return jnp.split(proj, idx, axis=-1)


def t5_bucket(rel):
    half = N_BUCKETS // 2
    exact = half // 2
    n = jnp.abs(rel)
    nf = jnp.maximum(n, exact).astype(jnp.float32)
    big = exact + (jnp.log(nf / exact) / math.log(MAX_DIST / exact) * (half - exact)).astype(jnp.int32)
    big = jnp.minimum(big, half - 1)
    return jnp.where(rel > 0, half, 0) + jnp.where(n < exact, n, big)


def windowed_sink_attention(q, k, v, sink, bias_tab):
    Bn, L = q.shape[:2]
    nb = L // BLOCK
    G = A_HEADS // A_KV
    qb = q.reshape(Bn, nb, BLOCK, A_KV, G, HEAD_DIM)

    def band(t):
        tp = jnp.pad(t, ((0, 0), (BLOCK, BLOCK), (0, 0), (0, 0)))
        tb = tp.reshape(Bn, nb + 2, BLOCK, A_KV, HEAD_DIM)
        return jnp.concatenate([tb[:, :-2], tb[:, 1:-1], tb[:, 2:]], axis=2)

    kb, vb = band(k), band(v)
    km, vm = k[:, FRONT:META_END], v[:, FRONT:META_END]
    qpos = jnp.arange(L).reshape(nb, BLOCK)
    kpos = qpos[:, :1] - BLOCK + jnp.arange(3 * BLOCK)[None, :]
    rel_b = kpos[:, None, :] - qpos[:, :, None]
    ok_b = (jnp.abs(rel_b) <= WINDOW) & (kpos >= META_END)[:, None, :] & (kpos < L)[:, None, :]
    rel_m = jnp.arange(FRONT, META_END)[None, None, :] - qpos[:, :, None]

    def head_bias(rel):
        b = bias_tab[t5_bucket(rel)]
        return jnp.moveaxis(b, -1, 0).reshape((A_KV, G) + rel.shape).astype(jnp.float32)

    scale = HEAD_DIM ** -0.5
    s_b = jnp.einsum('bnqhgd,bnkhd->bhgnqk', qb, kb).astype(jnp.float32) * scale + head_bias(rel_b)
    s_b = jnp.where(ok_b, s_b, MASK_VALUE)
    s_m = jnp.einsum('bnqhgd,bmhd->bhgnqm', qb, km).astype(jnp.float32) * scale + head_bias(rel_m)
    s_sink = jnp.broadcast_to(sink.astype(jnp.float32).reshape(A_KV, G, 1, 1, 1), s_m.shape[:-1] + (1,))
    p = jax.nn.softmax(jnp.concatenate([s_b, s_m, s_sink], axis=-1), axis=-1).astype(v.dtype)
    p_b = p[..., :3 * BLOCK]
    p_m = p[..., 3 * BLOCK:3 * BLOCK + N_META]
    o = jnp.einsum('bhgnqk,bnkhd->bnqhgd', p_b, vb) + jnp.einsum('bhgnqm,bmhd->bnqhgd', p_m, vm)
    return o.reshape(Bn, L, A_HEADS * HEAD_DIM)


def rotate_half_pairs(x, ang):
    c = jnp.cos(ang)[:, None, :]
    s = jnp.sin(ang)[:, None, :]
    x1, x2 = jnp.split(x, 2, axis=-1)
    return jnp.concatenate([x1 * c - x2 * s, x2 * c + x1 * s], axis=-1)


def axial_rope(x, row, col):
    half = x.shape[-1] // 2
    inv = ROPE_THETA ** (-jnp.arange(0, half, 2, dtype=jnp.float32) / half)
    x32 = x.astype(jnp.float32)
    xr = rotate_half_pairs(x32[..., :half], row[:, None] * inv[None, :])
    xc = rotate_half_pairs(x32[..., half:], col[:, None] * inv[None, :])
    return jnp.concatenate([xr, xc], axis=-1).astype(x.dtype)


def axial_rope_attention(q, k, v, row, col, key_ok):
    Bn, L = q.shape[:2]
    nb = L // BLOCK
    G = B_HEADS // B_KV
    q = axial_rope(q, row, col)
    k = axial_rope(k, row, col)
    qb = jnp.moveaxis(q.reshape(Bn, nb, BLOCK, B_KV, G, HEAD_DIM), 1, 0)
    scale = HEAD_DIM ** -0.5

    def one_block(qblk):
        s = jnp.einsum('bqhgd,bkhd->bhgqk', qblk, k).astype(jnp.float32) * scale
        s = jnp.where(key_ok, s, MASK_VALUE)
        p = jax.nn.softmax(s, axis=-1).astype(v.dtype)
        return jnp.einsum('bhgqk,bkhd->bqhgd', p, v)

    o = lax.map(one_block, qb)
    return jnp.moveaxis(o, 0, 1).reshape(Bn, L, B_HEADS * HEAD_DIM)


def differential_attention(q, k, v, lam, bias_tab, key_ok, sub_g, lambda_init):
    Bn, L = q.shape[:2]
    nb = L // BLOCK
    G = C_HEADS // C_KV
    qb = jnp.moveaxis(q.reshape(Bn, nb, BLOCK, C_KV, G, 2, C_DIM), 1, 0)
    qpos = jnp.arange(L).reshape(nb, BLOCK)
    kpos = jnp.arange(L)
    scale = C_DIM ** -0.5

    def one_block(args):
        qblk, qp = args
        bias = bias_tab[t5_bucket(kpos[None, :] - qp[:, None])]
        bias = jnp.moveaxis(bias, -1, 0).reshape(C_KV, G, BLOCK, L).astype(jnp.float32)
        s = jnp.einsum('bqhgcd,bkhcd->bchgqk', qblk, k).astype(jnp.float32) * scale + bias
        s = jnp.where(key_ok, s, MASK_VALUE)
        p = jax.nn.softmax(s, axis=-1)
        a = p[:, 0] - lam * p[:, 1]
        return jnp.einsum('bhgqk,bkhd->bqhgd', a.astype(v.dtype), v)

    o = lax.map(one_block, (qb, qpos))
    o = jnp.moveaxis(o, 0, 1).reshape(Bn, L, C_HEADS, C_VDIM)
    o = rms_norm(o, sub_g) * (1.0 - lambda_init)
    return o.reshape(Bn, L, C_HEADS * C_VDIM)


def chunk_gla(q, k, v, log_f):
    Bn, L, H, dk = q.shape
    dv = v.shape[-1]
    n = L // CHUNK

    def to_chunks(t):
        return t.reshape(Bn, n, CHUNK, H, t.shape[-1]).transpose(1, 0, 3, 2, 4)

    tri = jnp.tril(jnp.ones((CHUNK, CHUNK), bool))[:, :, None]

    def step(S, inp):
        qi, ki, vi, gi = inp
        b = jnp.cumsum(gi, axis=2)
        diff = b[:, :, :, None, :] - b[:, :, None, :, :]
        decay = jnp.where(tri, jnp.exp(jnp.where(tri, diff, 0.0)), 0.0)
        attn = jnp.einsum('bhtk,bhtsk,bhsk->bhts', qi, decay, ki)
        o = jnp.einsum('bhts,bhsv->bhtv', attn, vi) + jnp.einsum('bhtk,bhkv->bhtv', qi * jnp.exp(b), S)
        b_last = b[:, :, -1:, :]
        S = S * jnp.exp(b_last[:, :, 0, :, None]) + jnp.einsum('bhsk,bhsv->bhkv', ki * jnp.exp(b_last - b), vi)
        return S, o

    S0 = jnp.zeros((Bn, H, dk, dv), jnp.float32)
    _, o = lax.scan(step, S0, (to_chunks(q), to_chunks(k), to_chunks(v), to_chunks(log_f)))
    return o.transpose(1, 0, 3, 2, 4).reshape(Bn, L, H, dv)


def hgrn2_bidirectional(q, zf, zb, i, g, lb_f, lb_b, valid, out_g):
    Bn, L = q.shape[:2]

    def heads(t, dh):
        return t.reshape(Bn, L, D_HEADS, dh).astype(jnp.float32)

    qh = heads(q, D_KDIM) * (D_KDIM ** -0.5)
    vh = heads(i, D_VDIM)
    vmask = valid[None, :, None, None]

    def gates(z, lb):
        z = heads(z, D_KDIM)
        lb = lb.astype(jnp.float32).reshape(D_HEADS, D_KDIM)
        f = lb + (1.0 - lb) * jax.nn.sigmoid(z)
        log_f = jnp.log(jnp.maximum(f, F_FLOOR))
        kk = (1.0 - lb) * jax.nn.sigmoid(-z) * vmask
        return log_f, kk

    lf_f, k_f = gates(zf, lb_f)
    lf_b, k_b = gates(zb, lb_b)
    flip = lambda t: jnp.flip(t, axis=1)
    o_f = chunk_gla(qh, k_f, vh, lf_f)
    o_b = flip(chunk_gla(flip(qh), flip(k_b), flip(vh), flip(lf_b)))
    o = rms_norm(o_f + o_b, out_g) * jax.nn.silu(heads(g, D_VDIM))
    return o.reshape(Bn, L, D_HEADS * D_VDIM).astype(q.dtype)


def setup_inputs(seed: int = 0) -> dict:
    key = jax.random.key(seed)
    ks = jax.random.split(key, 20)
    nrm = jax.random.normal
    f32 = jnp.float32
    return {
        'x': nrm(ks[0], (BATCH, SEQ, D_MODEL), f32),
        'meta_tokens': nrm(ks[1], (N_META, D_MODEL), f32),
        'rel_bias': 0.5 * nrm(ks[2], (N_BUCKETS, A_HEADS + C_HEADS), f32),
        'hgrn_lb_logits': 0.5 * nrm(ks[3], (2, DEPTH, D_HEADS * D_KDIM), f32),
        'ln_mix': 1.0 + 0.05 * nrm(ks[4], (DEPTH, D_MODEL), f32),
        'w_in': nrm(ks[5], (DEPTH, D_MODEL, IN_TOTAL), f32) * D_MODEL ** -0.5,
        'attn_sink': 0.5 * nrm(ks[6], (DEPTH, A_HEADS), f32),
        'qk_norm_q': 1.0 + 0.05 * nrm(ks[7], (DEPTH, HEAD_DIM), f32),
        'qk_norm_k': 1.0 + 0.05 * nrm(ks[8], (DEPTH, HEAD_DIM), f32),
        'diff_lambda': 0.1 * nrm(ks[9], (DEPTH, 4, C_DIM), f32),
        'diff_subnorm': 1.0 + 0.05 * nrm(ks[10], (DEPTH, C_VDIM), f32),
        'hgrn_out_norm': 1.0 + 0.05 * nrm(ks[11], (DEPTH, D_VDIM), f32),
        'w_branch': nrm(ks[12], (DEPTH, N_BRANCH, MIX_W, D_MODEL), f32) * MIX_W ** -0.5,
        'w_out': nrm(ks[13], (DEPTH, D_MODEL, D_MODEL), f32) * D_MODEL ** -0.5,
        'ln_ffn': 1.0 + 0.05 * nrm(ks[14], (DEPTH, D_MODEL), f32),
        'w_ffn_gate': nrm(ks[15], (DEPTH, D_MODEL, D_FF), f32) * D_MODEL ** -0.5,
        'w_ffn_up': nrm(ks[16], (DEPTH, D_MODEL, D_FF), f32) * D_MODEL ** -0.5,
        'w_ffn_down': nrm(ks[17], (DEPTH, D_FF, D_MODEL), f32) * D_FF ** -0.5,
        'ln_final': 1.0 + 0.05 * nrm(ks[18], (D_MODEL,), f32),
    }


def reference(x, meta_tokens, rel_bias, hgrn_lb_logits, ln_mix, w_in, attn_sink, qk_norm_q, qk_norm_k,
              diff_lambda, diff_subnorm, hgrn_out_norm, w_branch, w_out, ln_ffn, w_ffn_gate, w_ffn_up,
              w_ffn_down, ln_final):
    Bn, S, _ = x.shape
    ROWS = S // GRID_W
    L = META_END + S
    h = jnp.concatenate([jnp.zeros((Bn, FRONT, D_MODEL), x.dtype),
                         jnp.broadcast_to(meta_tokens.astype(x.dtype)[None], (Bn, N_META, D_MODEL)),
                         x], axis=1)
    pos = jnp.arange(L)
    key_ok = pos >= FRONT
    valid = key_ok.astype(jnp.float32)
    row = jnp.concatenate([jnp.zeros((FRONT,), jnp.int32), -jnp.ones((N_META,), jnp.int32),
                           jnp.repeat(jnp.arange(ROWS, dtype=jnp.int32), GRID_W)]).astype(jnp.float32)
    col = jnp.concatenate([jnp.zeros((FRONT,), jnp.int32), jnp.arange(N_META, dtype=jnp.int32),
                           jnp.tile(jnp.arange(GRID_W, dtype=jnp.int32), ROWS)]).astype(jnp.float32)
    lb_p = jax.nn.softmax(hgrn_lb_logits.astype(jnp.float32), axis=1)
    lb_all = jnp.cumsum(lb_p, axis=1) - lb_p[:, :1]
    bias_a = rel_bias[:, :A_HEADS]
    bias_c = rel_bias[:, A_HEADS:]

    for l in range(DEPTH):
        u = rms_norm(h, ln_mix[l])
        (aq, ak, av, bq, bk, bv, cq, ck, cv, dq, dzf, dzb, di, dg, gz) = split_in(u @ w_in[l])
        y_a = windowed_sink_attention(aq.reshape(Bn, L, A_HEADS, HEAD_DIM), ak.reshape(Bn, L, A_KV, HEAD_DIM),
                                      av.reshape(Bn, L, A_KV, HEAD_DIM), attn_sink[l], bias_a)
        y_b = axial_rope_attention(rms_norm(bq.reshape(Bn, L, B_HEADS, HEAD_DIM), qk_norm_q[l]),
                                   rms_norm(bk.reshape(Bn, L, B_KV, HEAD_DIM), qk_norm_k[l]),
                                   bv.reshape(Bn, L, B_KV, HEAD_DIM), row, col, key_ok)
        lam_init = 0.8 - 0.6 * math.exp(-0.3 * l)
        lam_p = diff_lambda[l].astype(jnp.float32)
        lam = jnp.exp(jnp.sum(lam_p[0] * lam_p[1])) - jnp.exp(jnp.sum(lam_p[2] * lam_p[3])) + lam_init
        y_c = differential_attention(cq.reshape(Bn, L, C_HEADS, 2, C_DIM), ck.reshape(Bn, L, C_KV, 2, C_DIM),
                                     cv.reshape(Bn, L, C_KV, C_VDIM), lam, bias_c, key_ok, diff_subnorm[l], lam_init)
        y_d = hgrn2_bidirectional(dq, dzf, dzb, di, dg, lb_all[0, l], lb_all[1, l], valid, hgrn_out_norm[l])
        gate = jax.nn.sigmoid(gz.astype(jnp.float32)).astype(h.dtype).reshape(Bn, L, N_BRANCH, D_MODEL)
        merged = gate[:, :, 0] * (y_a @ w_branch[l, 0])
        for n, y in enumerate((y_b, y_c, y_d), start=1):
            merged = merged + gate[:, :, n] * (y @ w_branch[l, n])
        h = h + merged @ w_out[l]
        u = rms_norm(h, ln_ffn[l])
        h = h + (jax.nn.silu(u @ w_ffn_gate[l]) * (u @ w_ffn_up[l])) @ w_ffn_down[l]

    return rms_norm(h, ln_final)[:, META_END:]
```

```cpp
#include <hip/hip_runtime.h>
#include <hip/hip_cooperative_groups.h>
#include <cstdio>
#include <cstdint>
namespace cg = cooperative_groups;

namespace cfg {
constexpr int BATCH = 4, SEQ = 4096, DM = 1024, L = 4224, T = BATCH * L, FRONT = 112, NMETA = 16, MEND = 128;
constexpr int NIN = 6912, DFF = 2816, NGU = 2 * DFF, DEPTH = 2;
constexpr float LOG2E = 1.4426950408889634f;
constexpr float QSCALE64 = 0.125f * LOG2E;
constexpr float QSCALE32 = 0.17677669529663687f * LOG2E;
constexpr float RMS_EPS = 1e-6f;
constexpr size_t MiB = 1u << 20;
constexpr size_t WS_TAB = 1 * MiB;
constexpr size_t TAB_RT = 0, TAB_LUTA = 16384, TAB_LUTC = 32768, TAB_LB = 49152, TAB_LAM = 57344, TAB_QKG = 57600;
constexpr size_t WS_W1 = 2 * MiB;
constexpr size_t WS_WB = WS_W1 + (size_t)NIN * DM * 2;
constexpr size_t WS_WO = WS_WB + (size_t)DM * DM * 2;
constexpr size_t WS_WGU = WS_WO + (size_t)DM * DM * 2;
constexpr size_t WS_WD = WS_WGU + (size_t)NGU * DM * 2;
constexpr size_t WS_HB = 36 * MiB;
constexpr size_t WS_QKV = 69 * MiB;
constexpr size_t QKV_MIX = (size_t)T * 512 * 2;
constexpr size_t WS_MERGED = WS_QKV;
constexpr size_t WS_D = WS_QKV + 3 * QKV_MIX;
constexpr size_t D_ARR = (size_t)T * 256 * 2;
constexpr size_t WS_GATE = WS_D + 5 * D_ARR;
constexpr size_t WS_OFB = WS_GATE + (size_t)T * 4096;
constexpr size_t WS_SSQ = WS_OFB + 2 * D_ARR;
constexpr size_t WS_HSIDE = 244 * MiB;
constexpr size_t WS_FF = WS_QKV;
constexpr size_t WS_END = WS_HSIDE + (size_t)BATCH * 128 * DM * 4;
static_assert(WS_WD + (size_t)DM * DFF * 2 <= WS_HB, "weights fit below HB");
static_assert(WS_HB + (size_t)T * DM * 2 <= WS_QKV, "HB fits");
static_assert(WS_FF + (size_t)T * DFF * 2 <= WS_GATE, "FF overlay fits below GATE");
static_assert(WS_SSQ + (size_t)T * 16 * 4 <= WS_HSIDE, "SSQ fits");
static_assert(WS_END <= 256 * MiB, "workspace fits 256 MiB");
constexpr int CW_FIN = 9216;
constexpr int LDS_BYTES = 147456;
}

typedef unsigned short bf16;
#define GAS __attribute__((address_space(1)))
#define LAS __attribute__((address_space(3)))
typedef unsigned v4u __attribute__((ext_vector_type(4)));
typedef unsigned v2u __attribute__((ext_vector_type(2)));
typedef float f32x2_g __attribute__((ext_vector_type(2))); typedef __bf16 bf16x2_g __attribute__((ext_vector_type(2)));
__device__ __forceinline__ unsigned pk2(float lo, float hi) { f32x2_g v = {lo, hi}; bf16x2_g b = __builtin_convertvector(v, bf16x2_g); return __builtin_bit_cast(unsigned, b); }
__device__ __forceinline__ unsigned f2bf(float f) { return pk2(f, 0.0f); }
__device__ __forceinline__ float bf2f(unsigned short h) { return __builtin_bit_cast(float, (unsigned)h << 16); }
__device__ __forceinline__ float bflo(unsigned w) { return __builtin_bit_cast(float, w << 16); }
__device__ __forceinline__ float bfhi(unsigned w) { return __builtin_bit_cast(float, w & 0xffff0000u); }
__device__ __forceinline__ float fexp2(float x) { return __builtin_amdgcn_exp2f(x); }
__device__ __forceinline__ float sigmoidf_(float x) { return 1.0f / (1.0f + __expf(-x)); }

namespace pg8 {
#define PG8_LAS __attribute__((address_space(3)))
typedef unsigned short bf16_t;
typedef short bf16x8 __attribute__((ext_vector_type(8)));
typedef float f32x4 __attribute__((ext_vector_type(4)));
typedef unsigned u32x4 __attribute__((ext_vector_type(4)));
constexpr int BM = 256, BK = 64, HALF = 128, HTB = HALF * BK * 2  , STAGE_BYTES = 8 * HTB, NXCD = 8, WGM = 8;

__host__ __device__ __forceinline__ int lds_byte(int r, int c) { const int st = (r >> 4) * 2 + (c >> 5), rr = r & 15, cc = c & 31, ob = rr * 64 + cc * 2; return st * 1024 + (ob ^ (((ob >> 9) & 1) << 5)); }
__host__ __device__ __forceinline__ void stage_rc(int b, int& R, int& C) { const int st = b / 1024, sb = b % 1024, swz = sb ^ (((sb >> 9) & 1) << 5); R = (st >> 1) * 16 + swz / 64; C = (st & 1) * 32 + (swz % 64) / 2; }
__host__ __device__ __forceinline__ int perm32(int rho) { const int n = rho >> 4, i = rho & 15; return 8 * (i >> 2) + 4 * n + (i & 3); }

struct Unit { int pm, pn; };
struct Gemm { const bf16_t* A; const bf16_t* Bt; int M, N, K; };

struct StaticOrder {
    int nM, nN, nwg, G, c;
    __host__ __device__ void init(int M, int N, int G_, int c_) { nM = M / BM; nN = N / BM; nwg = nM * nN; G = G_; c = c_; }
    __host__ __device__ bool next(int i, Unit& u) const {
        const long L = (long)i * G + c; if (L >= nwg) return false;
        int wgid = (int)L; { const int q = nwg / NXCD, r = nwg % NXCD, xcd = wgid % NXCD, off = wgid / NXCD; wgid = (xcd < r ? xcd * (q + 1) : r * (q + 1) + (xcd - r) * q) + off; }
        const int nig = WGM * nN, gid = wgid / nig, fm = gid * WGM, gsz = (nM - fm) < WGM ? (nM - fm) : WGM;
        u.pm = fm + ((wgid % nig) % gsz); u.pn = (wgid % nig) / gsz; return true;
    }
    __device__ __forceinline__ void a_ready(const Unit&) const {}
    __device__ __forceinline__ void done(const Unit&) const {}
};


__device__ __forceinline__ unsigned cvt_pk_bf16(float lo, float hi) { unsigned r; asm volatile("v_cvt_pk_bf16_f32 %0, %1, %2" : "=v"(r) : "v"(lo), "v"(hi)); return r; }
typedef unsigned u32x2 __attribute__((ext_vector_type(2)));
__device__ __forceinline__ float row_rstd(const float* ssq, int r) {
    const f32x4* p = (const f32x4*)(ssq + (size_t)r * 16);
    const f32x4 a = p[0], b = p[1], c = p[2], d = p[3];
    const float s = (((a[0] + a[1]) + (a[2] + a[3])) + ((b[0] + b[1]) + (b[2] + b[3]))) + (((c[0] + c[1]) + (c[2] + c[3])) + ((d[0] + d[1]) + (d[2] + d[3])));
    return __builtin_amdgcn_rsqf(s * (1.0f / 1024.0f) + cfg::RMS_EPS);
}
__device__ __forceinline__ void rows_rstd(const float* ssq, int rbase, float (&rs)[2][4]) {
#pragma unroll
    for (int ai = 0; ai < 2; ++ai) {
        f32x4 t[4][4];
#pragma unroll
        for (int m = 0; m < 4; ++m) { const f32x4* p = (const f32x4*)(ssq + (size_t)(rbase + ai * HALF + m * 16) * 16);
#pragma unroll
            for (int q = 0; q < 4; ++q) t[m][q] = p[q]; }
#pragma unroll
        for (int m = 0; m < 4; ++m) { float s = 0.f;
#pragma unroll
            for (int q = 0; q < 4; ++q) s += (t[m][q][0] + t[m][q][1]) + (t[m][q][2] + t[m][q][3]);
            rs[ai][m] = __builtin_amdgcn_rsqf(s * (1.0f / 1024.0f) + cfg::RMS_EPS); }
        asm volatile("" : "+v"(rs[ai][0]), "+v"(rs[ai][1]), "+v"(rs[ai][2]), "+v"(rs[ai][3]));
    }
}
__device__ __forceinline__ void st_bf16x4(bf16_t* p, f32x4 v) { u32x2 w; w.x = cvt_pk_bf16(v[0], v[1]); w.y = cvt_pk_bf16(v[2], v[3]); *(u32x2*)p = w; }
__device__ __forceinline__ void st_bf16x4_pair(bf16_t* p, f32x4 v0, f32x4 v1, int fq) {
    const unsigned a0 = cvt_pk_bf16(v0[0], v0[1]), a1 = cvt_pk_bf16(v0[2], v0[3]), b0 = cvt_pk_bf16(v1[0], v1[1]), b1 = cvt_pk_bf16(v1[2], v1[3]);
    const auto s0 = __builtin_amdgcn_permlane16_swap(a0, b0, false, false); const auto s1 = __builtin_amdgcn_permlane16_swap(a1, b1, false, false);
    u32x4 o; o.x = s0[0]; o.y = s1[0]; o.z = s0[1]; o.w = s1[1];
    *(u32x4*)((fq & 1) ? p + 16 - 4 : p) = o;
}

constexpr int RSTD_LDS_OFF = 131072 + 1024, RSTD_SLOTS = 8;
template <class Sched>
__device__ __forceinline__ void build_rstd_tables(const Sched& S, const float* ssq, PG8_LAS float* tab, int tid) {
    const int row = tid >> 1, half = tid & 1; Unit u; PG8_LAS int* pmt = (PG8_LAS int*)(tab + RSTD_SLOTS * 256);
    if (tid < RSTD_SLOTS) pmt[tid] = -1;
    __syncthreads();
    int ns = 0, last = -1;
    for (int i = 0; ns < RSTD_SLOTS && S.next(i, u); ++i) {
        if (u.pm == last) continue;
        last = u.pm;
        const f32x4* p = (const f32x4*)(ssq + (size_t)(u.pm * BM + row) * 16 + 8 * half); const f32x4 a = p[0], b = p[1];
        float s = ((a[0] + a[1]) + (a[2] + a[3])) + ((b[0] + b[1]) + (b[2] + b[3]));
        s += __shfl_xor(s, 1);
        if (half == 0) tab[ns * 256 + row] = __builtin_amdgcn_rsqf(s * (1.0f / 1024.0f) + cfg::RMS_EPS);
        if (tid == 0) pmt[ns] = u.pm;
        ++ns;
    }
    __syncthreads();
}
__device__ __forceinline__ void rows_rstd_lds(const PG8_LAS float* tab, int pm, int wr, int fr, float (&rs)[2][4]) {
    const PG8_LAS int* pmt = (const PG8_LAS int*)(tab + RSTD_SLOTS * 256);
    int slot = 0;
#pragma unroll
    for (int j = 1; j < RSTD_SLOTS; ++j) if (pmt[j] == pm) slot = j;
#pragma unroll
    for (int ai = 0; ai < 2; ++ai)
#pragma unroll
        for (int m = 0; m < 4; ++m) rs[ai][m] = tab[slot * 256 + ai * HALF + wr * 64 + m * 16 + fr];
}

struct Epi1 {
    static constexpr bool PERM = false, AFTER_DRAIN = false, HOOK = false;
    unsigned char* ws;
    __device__ __forceinline__ void hook(f32x4 (&)[2][2][4][2], const Unit&, int, int, int, int, int) const {}
    __device__ __forceinline__ void operator()(const f32x4 (&acc)[2][2][4][2], const Unit& u, int wr, int wc, int fr, int fq) const {
        const int pn = u.pn;
        const PG8_LAS float* tab = (const PG8_LAS float*)RSTD_LDS_OFF;
        float rsv[2][4]; rows_rstd_lds(tab, u.pm, wr, fr, rsv);
        if (pn < 6) {
            const float* rt = (const float*)(ws + cfg::WS_TAB + cfg::TAB_RT); const float* gq = (const float*)(ws + cfg::WS_TAB + cfg::TAB_QKG); const float* gk = gq + 64;
            const int mixer = pn >> 1;
            unsigned char* mb = ws + cfg::WS_QKV + (size_t)mixer * cfg::QKV_MIX;
            bf16_t* base; int pitch, colofs; float scale = 1.0f; int mode = 0; const float* g = gq;
            if (!(pn & 1)) { base = (bf16_t*)mb; pitch = 256; colofs = wc * 64; scale = (mixer == 2) ? cfg::QSCALE32 : cfg::QSCALE64; mode = (mixer == 1); }
            else if (wc < 2) { base = (bf16_t*)(mb + (size_t)cfg::T * 512); pitch = 128; colofs = wc * 64; mode = (mixer == 1); g = gk; }
            else { base = (bf16_t*)(mb + (size_t)cfg::T * 768); pitch = 128; colofs = (wc - 2) * 64; }
            f32x4 gain[2][2];
            if (mode) {
#pragma unroll
                for (int bj = 0; bj < 2; ++bj)
#pragma unroll
                    for (int n = 0; n < 2; ++n) gain[bj][n] = *(const f32x4*)(g + 32 * bj + 16 * n + 4 * fq);
            }
#pragma unroll
            for (int ai = 0; ai < 2; ++ai)
#pragma unroll
                for (int m = 0; m < 4; ++m) {
                    const int r = u.pm * BM + ai * HALF + wr * 64 + m * 16 + fr;
                    const float rs = rsv[ai][m];
                    f32x4 x[2][2];
#pragma unroll
                    for (int bj = 0; bj < 2; ++bj)
#pragma unroll
                        for (int n = 0; n < 2; ++n) x[bj][n] = acc[ai][bj][m][n] * rs;
                    if (mode) {
                        float ss = 0.f;
#pragma unroll
                        for (int bj = 0; bj < 2; ++bj)
#pragma unroll
                            for (int n = 0; n < 2; ++n) { const f32x4 v = x[bj][n]; ss += (v[0] * v[0] + v[1] * v[1]) + (v[2] * v[2] + v[3] * v[3]); }
                        ss += __shfl_xor(ss, 16); ss += __shfl_xor(ss, 32);
                        const float r2 = __builtin_amdgcn_rsqf(ss * (1.0f / 64.0f) + cfg::RMS_EPS);
                        const int b = r / cfg::L, pos = r - b * cfg::L;
                        int tv[2];
                        if (pos < cfg::FRONT) { tv[0] = 1; tv[1] = 1; }
                        else if (pos < cfg::MEND) { tv[0] = 0; tv[1] = pos - cfg::FRONT + 1; }
                        else { const int s = pos - cfg::MEND; tv[0] = (s >> 6) + 1; tv[1] = (s & 63) + 1; }
#pragma unroll
                        for (int bj = 0; bj < 2; ++bj) {
                            const f32x4* cs = (const f32x4*)(rt + (size_t)(tv[bj] * 16 + 4 * fq) * 2);
                            const f32x4 cs0 = cs[0], cs1 = cs[1];
                            const f32x4 y1 = x[bj][0] * gain[bj][0] * r2, y2 = x[bj][1] * gain[bj][1] * r2;
                            f32x4 o1, o2;
                            o1[0] = y1[0] * cs0[0] - y2[0] * cs0[1]; o2[0] = y2[0] * cs0[0] + y1[0] * cs0[1];
                            o1[1] = y1[1] * cs0[2] - y2[1] * cs0[3]; o2[1] = y2[1] * cs0[2] + y1[1] * cs0[3];
                            o1[2] = y1[2] * cs1[0] - y2[2] * cs1[1]; o2[2] = y2[2] * cs1[0] + y1[2] * cs1[1];
                            o1[3] = y1[3] * cs1[2] - y2[3] * cs1[3]; o2[3] = y2[3] * cs1[2] + y1[3] * cs1[3];
                            x[bj][0] = o1; x[bj][1] = o2;
                        }
                    }
                    bf16_t* rowp = base + (size_t)r * pitch + colofs + 4 * fq;
#pragma unroll
                    for (int bj = 0; bj < 2; ++bj)
                        st_bf16x4_pair(rowp + 32 * bj, x[bj][0] * scale, x[bj][1] * scale, fq);
                }
        } else if (pn < 11) {
            const int arr = pn - 6;
            bf16_t* base = (bf16_t*)(ws + cfg::WS_D + (size_t)arr * cfg::D_ARR);
            const float scale = (arr == 0) ? 0.125f : 1.0f;
#pragma unroll
            for (int ai = 0; ai < 2; ++ai)
#pragma unroll
                for (int m = 0; m < 4; ++m) {
                    const int r = u.pm * BM + ai * HALF + wr * 64 + m * 16 + fr;
                    const float rs = rsv[ai][m] * scale;
                    bf16_t* rowp = base + (size_t)r * 256 + wc * 32 + 4 * fq;
#pragma unroll
                    for (int bj = 0; bj < 2; ++bj)
                        st_bf16x4_pair(rowp + 128 * bj, acc[ai][bj][m][0] * rs, acc[ai][bj][m][1] * rs, fq);
                }
        } else {
            const int br = (pn - 11) >> 2, pnD = (pn - 11) & 3;
            unsigned* base = (unsigned*)(ws + cfg::WS_GATE + (size_t)((u.pm * 4 + pnD) * 4 + br) * 65536) + (wr * 4 + wc) * 2048 + (fq * 16 + fr) * 4;
#pragma unroll
            for (int ai = 0; ai < 2; ++ai)
#pragma unroll
                for (int m = 0; m < 4; ++m) {
                    const float rs = rsv[ai][m] * -cfg::LOG2E;
                    u32x4 wq;
#pragma unroll
                    for (int bj = 0; bj < 2; ++bj)
#pragma unroll
                        for (int n = 0; n < 2; ++n) {
                            const f32x4 v = acc[ai][bj][m][n] * rs; unsigned w = 0;
#pragma unroll
                            for (int j = 0; j < 4; ++j) { const float g256 = __builtin_amdgcn_rcpf(__builtin_fmaf(__builtin_amdgcn_exp2f(v[j]), 1.0f / 256.0f, 1.0f / 256.0f));
                                w = __builtin_amdgcn_cvt_pk_u8_f32(g256 - 0.5f, (unsigned)j, w); }
                            wq[bj * 2 + n] = w;
                        }
                    *(u32x4*)(base + (ai * 4 + m) * 256) = wq;
                }
        }
    }
};

struct EpiHorner {
    static constexpr bool PERM = false, AFTER_DRAIN = false, HOOK = true;
    unsigned char* ws;
    static __device__ __forceinline__ f32x4 deqr(unsigned w) {
        f32x4 g; g[0] = (float)(w & 255u); g[1] = (float)((w >> 8) & 255u); g[2] = (float)((w >> 16) & 255u); g[3] = (float)(w >> 24);
        return g + 0.5f;
    }
    static __device__ __forceinline__ f32x4 deq(unsigned w) {
        f32x4 g; g[0] = __builtin_fmaf((float)(w & 255u), 1.0f / 256.0f, 0.5f / 256.0f); g[1] = __builtin_fmaf((float)((w >> 8) & 255u), 1.0f / 256.0f, 0.5f / 256.0f);
        g[2] = __builtin_fmaf((float)((w >> 16) & 255u), 1.0f / 256.0f, 0.5f / 256.0f); g[3] = __builtin_fmaf((float)(w >> 24), 1.0f / 256.0f, 0.5f / 256.0f);
        return g;
    }
    __device__ __forceinline__ void hook(f32x4 (&acc)[2][2][4][2], const Unit& u, int t, int wr, int wc, int fr, int fq) const {
        const int nb = (t >> 2) - 1; const unsigned char* gate = ws + cfg::WS_GATE;
        const unsigned* g0p = (const unsigned*)(gate + (size_t)((u.pm * 4 + u.pn) * 4 + nb) * 65536) + (wr * 4 + wc) * 2048 + (fq * 16 + fr) * 4;
        unsigned w0[2][4][2][2], w1[2][4][2][2];
#pragma unroll
        for (int ai = 0; ai < 2; ++ai)
#pragma unroll
            for (int m = 0; m < 4; ++m) { const u32x4 q0 = *(const u32x4*)(g0p + (ai * 4 + m) * 256), q1 = *(const u32x4*)(g0p + (ai * 4 + m) * 256 + 16384);
#pragma unroll
                for (int bj = 0; bj < 2; ++bj)
#pragma unroll
                    for (int n = 0; n < 2; ++n) { w0[ai][m][bj][n] = q0[bj * 2 + n]; w1[ai][m][bj][n] = q1[bj * 2 + n]; } }
        __builtin_amdgcn_sched_barrier(0);
#pragma unroll
        for (int ai = 0; ai < 2; ++ai)
#pragma unroll
            for (int m = 0; m < 4; ++m)
#pragma unroll
                for (int bj = 0; bj < 2; ++bj)
#pragma unroll
                    for (int n = 0; n < 2; ++n) { const f32x4 g0 = deq(w0[ai][m][bj][n]), g1 = deq(w1[ai][m][bj][n]);
                        f32x4 rr; rr[0] = g0[0] * __builtin_amdgcn_rcpf(g1[0]); rr[1] = g0[1] * __builtin_amdgcn_rcpf(g1[1]); rr[2] = g0[2] * __builtin_amdgcn_rcpf(g1[2]); rr[3] = g0[3] * __builtin_amdgcn_rcpf(g1[3]);
                        acc[ai][bj][m][n] *= rr; }
        __builtin_amdgcn_sched_barrier(0);
    }
    __device__ __forceinline__ void operator()(const f32x4 (&acc)[2][2][4][2], const Unit& u, int wr, int wc, int fr, int fq) const {
        const unsigned char* gate = ws + cfg::WS_GATE; bf16_t* out = (bf16_t*)(ws + cfg::WS_MERGED);
        const unsigned* g3p = (const unsigned*)(gate + (size_t)((u.pm * 4 + u.pn) * 4 + 3) * 65536) + (wr * 4 + wc) * 2048 + (fq * 16 + fr) * 4;
        unsigned w3[2][4][2][2];
#pragma unroll
        for (int ai = 0; ai < 2; ++ai)
#pragma unroll
            for (int m = 0; m < 4; ++m) { const u32x4 q3 = *(const u32x4*)(g3p + (ai * 4 + m) * 256);
#pragma unroll
                for (int bj = 0; bj < 2; ++bj)
#pragma unroll
                    for (int n = 0; n < 2; ++n) w3[ai][m][bj][n] = q3[bj * 2 + n]; }
#pragma unroll
        for (int ai = 0; ai < 2; ++ai)
#pragma unroll
            for (int m = 0; m < 4; ++m) {
                const int r = u.pm * BM + ai * HALF + wr * 64 + m * 16 + fr;
                bf16_t* rowp = out + (size_t)r * 1024 + u.pn * 256 + wc * 32 + 4 * fq;
#pragma unroll
                for (int bj = 0; bj < 2; ++bj)
                    st_bf16x4_pair(rowp + 128 * bj, acc[ai][bj][m][0] * deq(w3[ai][m][bj][0]), acc[ai][bj][m][1] * deq(w3[ai][m][bj][1]), fq);
            }
    }
};

__device__ __forceinline__ f32x4 ld_bf16x4(const bf16_t* p) { const u32x2 w = *(const u32x2*)p; f32x4 v; v[0] = __builtin_bit_cast(float, w.x << 16); v[1] = __builtin_bit_cast(float, w.x & 0xffff0000u); v[2] = __builtin_bit_cast(float, w.y << 16); v[3] = __builtin_bit_cast(float, w.y & 0xffff0000u); return v; }
struct EpiRes {
    static constexpr bool PERM = true, AFTER_DRAIN = false, HOOK = false;
    unsigned char* ws; int feed;
    __device__ __forceinline__ void hook(f32x4 (&)[2][2][4][2], const Unit&, int, int, int, int, int) const {}
    __device__ __forceinline__ void operator()(const f32x4 (&acc)[2][2][4][2], const Unit& u, int wr, int wc, int fr, int fq) const {
        bf16_t* hb = (bf16_t*)(ws + cfg::WS_HB); float* ssq = (float*)(ws + cfg::WS_SSQ);
        const int c0 = u.pn * 256 + wc * 32 + 8 * fq;
        u32x4 hv[2][4][2];
#pragma unroll
        for (int ai = 0; ai < 2; ++ai)
#pragma unroll
            for (int m = 0; m < 4; ++m) { const bf16_t* br = hb + (size_t)(u.pm * BM + ai * HALF + wr * 64 + m * 16 + fr) * 1024 + c0;
#pragma unroll
                for (int bj = 0; bj < 2; ++bj) hv[ai][m][bj] = *(const u32x4*)(br + 128 * bj); }
        __builtin_amdgcn_sched_barrier(0);
#pragma unroll
        for (int ai = 0; ai < 2; ++ai) {
#pragma unroll
            for (int m = 0; m < 4; ++m) {
                const int r = u.pm * BM + ai * HALF + wr * 64 + m * 16 + fr;
                bf16_t* br = hb + (size_t)r * 1024 + c0;
                float ss = 0.f;
#pragma unroll
                for (int bj = 0; bj < 2; ++bj) {
                    const u32x4 w = hv[ai][m][bj]; f32x4 v0, v1;
                    v0[0] = __builtin_bit_cast(float, w.x << 16); v0[1] = __builtin_bit_cast(float, w.x & 0xffff0000u); v0[2] = __builtin_bit_cast(float, w.y << 16); v0[3] = __builtin_bit_cast(float, w.y & 0xffff0000u);
                    v1[0] = __builtin_bit_cast(float, w.z << 16); v1[1] = __builtin_bit_cast(float, w.z & 0xffff0000u); v1[2] = __builtin_bit_cast(float, w.w << 16); v1[3] = __builtin_bit_cast(float, w.w & 0xffff0000u);
                    v0 += acc[ai][bj][m][0]; v1 += acc[ai][bj][m][1];
                    u32x4 o; o.x = cvt_pk_bf16(v0[0], v0[1]); o.y = cvt_pk_bf16(v0[2], v0[3]); o.z = cvt_pk_bf16(v1[0], v1[1]); o.w = cvt_pk_bf16(v1[2], v1[3]);
                    *(u32x4*)(br + 128 * bj) = o;
                    ss += ((v0[0] * v0[0] + v0[1] * v0[1]) + (v0[2] * v0[2] + v0[3] * v0[3])) + ((v1[0] * v1[0] + v1[1] * v1[1]) + (v1[2] * v1[2] + v1[3] * v1[3]));
                }
                ss += __shfl_xor(ss, 16); ss += __shfl_xor(ss, 32);
                if (feed && fq == 0) ssq[(size_t)r * 16 + u.pn * 4 + wc] = ss;
            }
        }
    }
};

struct EpiResFinal {
    static constexpr bool PERM = false, AFTER_DRAIN = true, HOOK = false;
    float* hout; unsigned char* ws; const float* lnf;
    __device__ __forceinline__ void hook(f32x4 (&)[2][2][4][2], const Unit&, int, int, int, int, int) const {}
    __device__ __forceinline__ void fused(f32x4 (&acc)[2][2][4][2], const Unit& u, int wr, int wc, int fr, int fq, PG8_LAS unsigned char* lds, int wid, int lane) const {
        const bf16_t* hb = (const bf16_t*)(ws + cfg::WS_HB); float* ssq = (float*)(ws + cfg::WS_SSQ); unsigned* cnt = (unsigned*)ws + cfg::CW_FIN + 16 * u.pm;
        const int c0 = u.pn * 256 + wc * 32 + 4 * fq;
#pragma unroll
        for (int ai = 0; ai < 2; ++ai) {
            f32x4 hv[4][2][2];
#pragma unroll
            for (int m = 0; m < 4; ++m) { const bf16_t* br = hb + (size_t)(u.pm * BM + ai * HALF + wr * 64 + m * 16 + fr) * 1024 + c0;
#pragma unroll
                for (int bj = 0; bj < 2; ++bj)
#pragma unroll
                    for (int n = 0; n < 2; ++n) hv[m][bj][n] = ld_bf16x4(br + 128 * bj + 16 * n); }
#pragma unroll
            for (int m = 0; m < 4; ++m) {
                const int r = u.pm * BM + ai * HALF + wr * 64 + m * 16 + fr;
                float ss = 0.f;
#pragma unroll
                for (int bj = 0; bj < 2; ++bj)
#pragma unroll
                    for (int n = 0; n < 2; ++n) { const f32x4 v = hv[m][bj][n] + acc[ai][bj][m][n]; acc[ai][bj][m][n] = v; ss += (v[0] * v[0] + v[1] * v[1]) + (v[2] * v[2] + v[3] * v[3]); }
                ss += __shfl_xor(ss, 16); ss += __shfl_xor(ss, 32);
                if (fq == 0) __hip_atomic_store(ssq + (size_t)r * 16 + u.pn * 4 + wc, ss, __ATOMIC_RELAXED, __HIP_MEMORY_SCOPE_AGENT);
            }
        }
        asm volatile("s_waitcnt vmcnt(0)" ::: "memory");
        if (lane == 0) { const unsigned one = 1u; asm volatile("global_atomic_add %0, %1, off" :: "v"(cnt), "v"(one) : "memory"); }
        if (wid == 0) {
            if (lane == 0) { unsigned sp = 0; while (__hip_atomic_load(cnt, __ATOMIC_RELAXED, __HIP_MEMORY_SCOPE_AGENT) < 32u) { __builtin_amdgcn_s_sleep(2); if (++sp > (1u << 18)) break; } }
            __builtin_amdgcn_fence(__ATOMIC_ACQUIRE, "agent"); asm volatile("s_waitcnt vmcnt(0)" ::: "memory");
        }
        asm volatile("s_waitcnt lgkmcnt(0)\n\ts_barrier" ::: "memory");
        f32x4 g[2][2];
#pragma unroll
        for (int bj = 0; bj < 2; ++bj)
#pragma unroll
            for (int n = 0; n < 2; ++n) g[bj][n] = *(const f32x4*)(lnf + c0 + 128 * bj + 16 * n);
#pragma unroll
        for (int ai = 0; ai < 2; ++ai) {
            float rs[4];
#pragma unroll
            for (int mh = 0; mh < 4; mh += 2) { f32x4 t[2][4];
#pragma unroll
              for (int m = 0; m < 2; ++m) { const f32x4* p = (const f32x4*)(ssq + (size_t)(u.pm * BM + ai * HALF + wr * 64 + (mh + m) * 16 + fr) * 16);
#pragma unroll
                  for (int q = 0; q < 4; ++q) t[m][q] = p[q]; }
#pragma unroll
              for (int m = 0; m < 2; ++m) { float s = 0.f;
#pragma unroll
                  for (int q = 0; q < 4; ++q) s += (t[m][q][0] + t[m][q][1]) + (t[m][q][2] + t[m][q][3]);
                  rs[mh + m] = __builtin_amdgcn_rsqf(s * (1.0f / 1024.0f) + cfg::RMS_EPS); } }
#pragma unroll
            for (int m = 0; m < 4; ++m) { const int r = u.pm * BM + ai * HALF + wr * 64 + m * 16 + fr, b = r / cfg::L, pos = r - b * cfg::L;
                float* hr = (pos >= cfg::MEND ? hout + (size_t)(b * cfg::SEQ + pos - cfg::MEND) * cfg::DM : (float*)(ws + cfg::WS_HSIDE) + (size_t)(b * 128 + pos) * cfg::DM) + c0;
#pragma unroll
                for (int bj = 0; bj < 2; ++bj)
#pragma unroll
                    for (int n = 0; n < 2; ++n) *(f32x4*)(hr + 128 * bj + 16 * n) = acc[ai][bj][m][n] * rs[m] * g[bj][n]; }
        }
    }
};

struct EpiGLU {
    static constexpr bool PERM = true, AFTER_DRAIN = false, HOOK = false;
    unsigned char* ws;
    __device__ __forceinline__ void hook(f32x4 (&)[2][2][4][2], const Unit&, int, int, int, int, int) const {}
    __device__ __forceinline__ void operator()(const f32x4 (&acc)[2][2][4][2], const Unit& u, int wr, int wc, int fr, int fq) const {
        const PG8_LAS float* tab = (const PG8_LAS float*)RSTD_LDS_OFF; bf16_t* ff = (bf16_t*)(ws + cfg::WS_FF);
        float rsv[2][4]; rows_rstd_lds(tab, u.pm, wr, fr, rsv);
#pragma unroll
        for (int ai = 0; ai < 2; ++ai)
#pragma unroll
            for (int m = 0; m < 4; ++m) {
                const int r = u.pm * BM + ai * HALF + wr * 64 + m * 16 + fr;
                const float rs = rsv[ai][m], rsn = rs * -cfg::LOG2E, rs2 = rs * rs;
                u32x4 w;
#pragma unroll
                for (int n = 0; n < 2; ++n) {
                    const f32x4 t = acc[ai][0][m][n] * rsn, gu = (acc[ai][0][m][n] * acc[ai][1][m][n]) * rs2; f32x4 o;
#pragma unroll
                    for (int j = 0; j < 4; ++j) o[j] = gu[j] * __builtin_amdgcn_rcpf(1.0f + __builtin_amdgcn_exp2f(t[j]));
                    if (n == 0) { w.x = cvt_pk_bf16(o[0], o[1]); w.y = cvt_pk_bf16(o[2], o[3]); } else { w.z = cvt_pk_bf16(o[0], o[1]); w.w = cvt_pk_bf16(o[2], o[3]); }
                }
                *(u32x4*)(ff + (size_t)r * cfg::DFF + u.pn * 128 + wc * 32 + 8 * fq) = w;
            }
    }
};


constexpr int TAIL_ROW0 = 16384, TAIL_TASKS = 256;
template <int NSTEP>
__device__ __forceinline__ void tail_chunk(const bf16_t* ap, const bf16_t* bp, int ld, f32x4 (&acc)[2][4]) {
    bf16x8 a[NSTEP][2], b[NSTEP][4];
#pragma unroll
    for (int s = 0; s < NSTEP; ++s) { a[s][0] = *(const bf16x8*)(ap + 32 * s); a[s][1] = *(const bf16x8*)(ap + (size_t)16 * ld + 32 * s);
#pragma unroll
        for (int cb = 0; cb < 4; ++cb) b[s][cb] = *(const bf16x8*)(bp + (size_t)(16 * cb) * ld + 32 * s); }
    __builtin_amdgcn_sched_barrier(0);
#pragma unroll
    for (int s = 0; s < NSTEP; ++s)
#pragma unroll
        for (int h = 0; h < 2; ++h)
#pragma unroll
            for (int cb = 0; cb < 4; ++cb) acc[h][cb] = __builtin_amdgcn_mfma_f32_16x16x32_bf16(a[s][h], b[s][cb], acc[h][cb], 0, 0, 0);
}
template <int NSTEP>
__device__ __forceinline__ void tail_ld(const bf16_t* ap, const bf16_t* bp, int ld, bf16x8 (&a)[3][2], bf16x8 (&b)[3][4]) {
#pragma unroll
    for (int s = 0; s < NSTEP; ++s) { a[s][0] = *(const bf16x8*)(ap + 32 * s); a[s][1] = *(const bf16x8*)(ap + (size_t)16 * ld + 32 * s);
#pragma unroll
        for (int cb = 0; cb < 4; ++cb) b[s][cb] = *(const bf16x8*)(bp + (size_t)(16 * cb) * ld + 32 * s); }
}
template <int NSTEP>
__device__ __forceinline__ void tail_mm(const bf16x8 (&a)[3][2], const bf16x8 (&b)[3][4], f32x4 (&acc)[2][4]) {
#pragma unroll
    for (int s = 0; s < NSTEP; ++s)
#pragma unroll
        for (int h = 0; h < 2; ++h)
#pragma unroll
            for (int cb = 0; cb < 4; ++cb) acc[h][cb] = __builtin_amdgcn_mfma_f32_16x16x32_bf16(a[s][h], b[s][cb], acc[h][cb], 0, 0, 0);
}
__device__ __forceinline__ void tail_reduce(f32x4 (&acc)[2][4], float* part, int wave, int lane) {
    if (wave) { float* mine = part + (wave - 1) * 2048 + lane;
#pragma unroll
        for (int h = 0; h < 2; ++h)
#pragma unroll
            for (int cb = 0; cb < 4; ++cb)
#pragma unroll
                for (int r = 0; r < 4; ++r) mine[((h * 4 + cb) * 4 + r) * 64] = acc[h][cb][r]; }
    __syncthreads();
    if (!wave) {
#pragma unroll 2
        for (int o = 0; o < 7; ++o)
#pragma unroll
            for (int h = 0; h < 2; ++h)
#pragma unroll
                for (int cb = 0; cb < 4; ++cb)
#pragma unroll
                    for (int r = 0; r < 4; ++r) acc[h][cb][r] += part[o * 2048 + ((h * 4 + cb) * 4 + r) * 64 + lane];
    }
}
__device__ __forceinline__ void tail_res(const bf16_t* A, const bf16_t* Bt, int K, float* hout, bf16_t* hb, float* ssq, int feed, const float* lnf, unsigned* cntT, int bx, int wave, int lane, float* part) {
    const int task = bx, rb = task >> 4, cg = task & 15, row0 = TAIL_ROW0 + 32 * rb, col0 = 64 * cg, c = lane & 15, q4 = lane >> 4;
    f32x4 acc[2][4];
#pragma unroll
    for (int h = 0; h < 2; ++h)
#pragma unroll
        for (int cb = 0; cb < 4; ++cb) acc[h][cb] = (f32x4){0.f, 0.f, 0.f, 0.f};
    unsigned short hbv[2][4][4] = {};
    float lnv[4] = {0.f, 0.f, 0.f, 0.f};
    if (wave == 0 && task < TAIL_TASKS) {
#pragma unroll
        for (int h = 0; h < 2; ++h)
#pragma unroll
            for (int r = 0; r < 4; ++r)
#pragma unroll
                for (int cb = 0; cb < 4; ++cb) hbv[h][r][cb] = hb[(size_t)(row0 + 16 * h + 4 * q4 + r) * 1024 + col0 + c + 16 * cb];
        if (lnf) {
#pragma unroll
            for (int cb = 0; cb < 4; ++cb) lnv[cb] = lnf[col0 + c + 16 * cb]; }
    }
    if (task < TAIL_TASKS) {
        const int Ke = K >> 3; const bf16_t* ap = A + (size_t)(row0 + c) * K + wave * Ke + 8 * q4; const bf16_t* bp = Bt + (size_t)(col0 + c) * K + wave * Ke + 8 * q4;
        if (Ke == 128) tail_chunk<4>(ap, bp, K, acc);
        else {
            bf16x8 a0[3][2], b0[3][4], a1[3][2], b1[3][4];
            tail_ld<3>(ap, bp, K, a0, b0); tail_ld<3>(ap + 96, bp + 96, K, a1, b1); __builtin_amdgcn_sched_barrier(0);
            tail_mm<3>(a0, b0, acc); __builtin_amdgcn_sched_barrier(0);
            tail_ld<3>(ap + 192, bp + 192, K, a0, b0); __builtin_amdgcn_sched_barrier(0);
            tail_mm<3>(a1, b1, acc); __builtin_amdgcn_sched_barrier(0);
            tail_ld<2>(ap + 288, bp + 288, K, a1, b1); __builtin_amdgcn_sched_barrier(0);
            tail_mm<3>(a0, b0, acc); tail_mm<2>(a1, b1, acc);
        }
    }
    tail_reduce(acc, part, wave, lane);
    if (wave == 0 && task < TAIL_TASKS && lnf) {
        float hvv[2][4][4];
#pragma unroll
        for (int h = 0; h < 2; ++h)
#pragma unroll
            for (int r = 0; r < 4; ++r) { const int row = row0 + 16 * h + 4 * q4 + r; float ss = 0.f;
#pragma unroll
                for (int cb = 0; cb < 4; ++cb) { const float hv = __builtin_bit_cast(float, (unsigned)hbv[h][r][cb] << 16) + acc[h][cb][r]; hvv[h][r][cb] = hv; ss += hv * hv; }
                ss += __shfl_xor(ss, 1); ss += __shfl_xor(ss, 2); ss += __shfl_xor(ss, 4); ss += __shfl_xor(ss, 8);
                if (c == 0) __hip_atomic_store(ssq + (size_t)row * 16 + cg, ss, __ATOMIC_RELAXED, __HIP_MEMORY_SCOPE_AGENT); }
        asm volatile("s_waitcnt vmcnt(0)" ::: "memory");
        unsigned* cn = cntT + 16 * rb;
        if (lane == 0) { const unsigned one = 1u; asm volatile("global_atomic_add %0, %1, off" :: "v"(cn), "v"(one) : "memory");
            unsigned sp = 0; while (__hip_atomic_load(cn, __ATOMIC_RELAXED, __HIP_MEMORY_SCOPE_AGENT) < 16u) { __builtin_amdgcn_s_sleep(2); if (++sp > (1u << 18)) break; } }
        __builtin_amdgcn_fence(__ATOMIC_ACQUIRE, "agent"); asm volatile("s_waitcnt vmcnt(0)" ::: "memory");
#pragma unroll
        for (int h = 0; h < 2; ++h)
#pragma unroll
            for (int r = 0; r < 4; ++r) { const int row = row0 + 16 * h + 4 * q4 + r; const f32x4* p = (const f32x4*)(ssq + (size_t)row * 16); const f32x4 a = p[0], b = p[1], cc = p[2], d = p[3];
                const float s = (((a[0] + a[1]) + (a[2] + a[3])) + ((b[0] + b[1]) + (b[2] + b[3]))) + (((cc[0] + cc[1]) + (cc[2] + cc[3])) + ((d[0] + d[1]) + (d[2] + d[3])));
                const float rs = __builtin_amdgcn_rsqf(s * (1.0f / 1024.0f) + cfg::RMS_EPS); float* hr = hout + (size_t)(row - 3 * cfg::L - cfg::MEND + 3 * cfg::SEQ) * cfg::DM + col0 + c;
#pragma unroll
                for (int cb = 0; cb < 4; ++cb) hr[16 * cb] = hvv[h][r][cb] * rs * lnv[cb]; }
    } else if (wave == 0 && task < TAIL_TASKS) {
#pragma unroll
        for (int h = 0; h < 2; ++h)
#pragma unroll
            for (int r = 0; r < 4; ++r) { const int row = row0 + 16 * h + 4 * q4 + r; bf16_t* br = hb + (size_t)row * 1024 + col0 + c; float ss = 0.f;
#pragma unroll
                for (int cb = 0; cb < 4; ++cb) { const float hv = __builtin_bit_cast(float, (unsigned)hbv[h][r][cb] << 16) + acc[h][cb][r]; br[16 * cb] = (bf16_t)f2bf(hv); ss += hv * hv; }
                ss += __shfl_xor(ss, 1); ss += __shfl_xor(ss, 2); ss += __shfl_xor(ss, 4); ss += __shfl_xor(ss, 8);
                if (feed && c == 0) ssq[(size_t)row * 16 + cg] = ss; }
    }
    __syncthreads();
}
__device__ __forceinline__ void tail_branch(const bf16_t* Y, const bf16_t* Wbt, const unsigned char* gate, bf16_t* out, int bx, int wave, int lane, float* part) {
    const int task = bx, n = wave >> 1, kh = wave & 1;
    const int rb = task >> 4, cg = task & 15, row0 = TAIL_ROW0 + 32 * rb, col0 = 64 * cg, c = lane & 15, q4 = lane >> 4;
    f32x4 acc[2][4];
#pragma unroll
    for (int h = 0; h < 2; ++h)
#pragma unroll
        for (int cb = 0; cb < 4; ++cb) acc[h][cb] = (f32x4){0.f, 0.f, 0.f, 0.f};
    if (task < TAIL_TASKS) {
        unsigned char gbv[2][4][4];
#pragma unroll
        for (int h = 0; h < 2; ++h)
#pragma unroll
            for (int r = 0; r < 4; ++r) { const int row = row0 + 16 * h + 4 * q4 + r, rr = row & 255;
#pragma unroll
                for (int cb = 0; cb < 4; ++cb) { const int col = col0 + 16 * cb + c, cc = col & 255;
                    const int w_ = ((rr >> 6) & 1) * 4 + ((cc >> 5) & 3), idx = (((w_ * 2 + (rr >> 7)) * 4 + ((rr >> 4) & 3)) * 64 + ((cc >> 2) & 3) * 16 + (rr & 15)) * 4 + (cc >> 7) * 2 + ((cc >> 4) & 1);
                    gbv[h][r][cb] = gate[(size_t)(((row >> 8) * 4 + (col >> 8)) * 4 + n) * 65536 + (size_t)idx * 4 + (cc & 3)]; } }
        tail_chunk<4>(Y + (size_t)(row0 + c) * 1024 + 256 * n + 128 * kh + 8 * q4, Wbt + (size_t)(col0 + c) * 1024 + 256 * n + 128 * kh + 8 * q4, 1024, acc);
#pragma unroll
        for (int h = 0; h < 2; ++h)
#pragma unroll
            for (int r = 0; r < 4; ++r)
#pragma unroll
                for (int cb = 0; cb < 4; ++cb) acc[h][cb][r] *= __builtin_fmaf((float)gbv[h][r][cb], 1.0f / 256.0f, 0.5f / 256.0f);
    }
    tail_reduce(acc, part, wave, lane);
    if (wave == 0 && task < TAIL_TASKS) {
#pragma unroll
        for (int h = 0; h < 2; ++h)
#pragma unroll
            for (int r = 0; r < 4; ++r) { bf16_t* op = out + (size_t)(row0 + 16 * h + 4 * q4 + r) * 1024 + col0 + c;
#pragma unroll
                for (int cb = 0; cb < 4; ++cb) op[16 * cb] = (bf16_t)f2bf(acc[h][cb][r]); }
    }
    __syncthreads();
}
template <class Epi, class Sched, bool ALIGN_EPI = false, bool SP2 = false>
__device__ __forceinline__ void gemm_phase(PG8_LAS unsigned char* lds, const Gemm g, const Sched& S, const Epi& E, int tid_in) {
    int tid_l = tid_in; asm volatile("" : "+v"(tid_l));
    const int tid = tid_l, wid = __builtin_amdgcn_readfirstlane(tid >> 6), lane = tid & 63, wr = wid >> 2, wc = wid & 3, fr = lane & 15, fq = lane >> 4;
    const int K = g.K, nt = K / BK;
    unsigned voffA[2], voffB[2];
#pragma unroll
    for (int i = 0; i < 2; ++i) { int R, C; stage_rc(tid * 16 + i * 8192, R, C); const int Rb = Epi::PERM ? ((R & ~31) + perm32(R & 31)) : R;
        voffA[i] = (unsigned)(R * K + C) * 2u; voffB[i] = (unsigned)(Rb * K + C) * 2u; }
    const size_t kstep = (size_t)(BK * 2);
    const size_t hstep = (size_t)HALF * K * 2;
    const size_t tstep = 2 * hstep;
    const unsigned ldsw = (unsigned)wid * 1024u;
    const int aoff = lds_byte(wr * 64 + fr, fq * 8), boff = lds_byte(wc * 32 + fr, fq * 8);
#define PG8_SA(b, h) (((b) * 2 + (h)) * HTB)
#define PG8_SB(b, h) ((4 + (b) * 2 + (h)) * HTB)
#define PG8_STAGE(bufoff, gbase, voff) do { _Pragma("unroll") for (int _i = 0; _i < 2; ++_i) \
        __builtin_amdgcn_global_load_lds((const unsigned*)((const char*)(gbase) + (voff)[_i]), (PG8_LAS unsigned*)(lds + (bufoff) + ldsw + _i * 8192), 16, 0, 0); } while (0)
#define PG8_LDA(dst, b, h) do { _Pragma("unroll") for (int m = 0; m < 4; ++m) _Pragma("unroll") for (int k = 0; k < 2; ++k) dst[m][k] = *(const PG8_LAS bf16x8*)(lds + PG8_SA(b, h) + aoff + m * 2048 + k * 1024); } while (0)
#define PG8_LDB(dst, b, h) do { _Pragma("unroll") for (int n = 0; n < 2; ++n) _Pragma("unroll") for (int k = 0; k < 2; ++k) dst[n][k] = *(const PG8_LAS bf16x8*)(lds + PG8_SB(b, h) + boff + n * 2048 + k * 1024); } while (0)
#define PG8_MMA(ai, bj, At, Bt) do { __builtin_amdgcn_s_setprio(1); _Pragma("unroll") for (int m = 0; m < 4; ++m) _Pragma("unroll") for (int n = 0; n < 2; ++n) _Pragma("unroll") for (int k = 0; k < 2; ++k) \
        acc[ai][bj][m][n] = __builtin_amdgcn_mfma_f32_16x16x32_bf16(Bt[n][k], At[m][k], acc[ai][bj][m][n], 0, 0, 0); __builtin_amdgcn_s_setprio(0); } while (0)
#define PG8_WAIT_V(n) asm volatile("s_waitcnt vmcnt(" #n ")" ::: "memory")
#define PG8_WAIT_L(n) asm volatile("s_waitcnt lgkmcnt(" #n ")" ::: "memory")
#define PG8_BAR __builtin_amdgcn_s_barrier()
#define PG8_SCHED __builtin_amdgcn_sched_barrier(0)
    Unit cur, nxt; int ui = 0;
    if (!S.next(0, cur)) return;
    f32x4 acc[2][2][4][2];
#pragma unroll
    for (int a = 0; a < 2; ++a)
#pragma unroll
        for (int b = 0; b < 2; ++b)
#pragma unroll
            for (int m = 0; m < 4; ++m)
#pragma unroll
                for (int n = 0; n < 2; ++n) acc[a][b][m][n] = (f32x4){0.f, 0.f, 0.f, 0.f};
    bf16x8 At[4][2], B0[2][2], B1[2][2];
    const char* cA = (const char*)g.A + (size_t)cur.pm * tstep; const char* cB = (const char*)g.Bt + (size_t)cur.pn * tstep;
    S.a_ready(cur);
    if constexpr (SP2) {
        PG8_STAGE(PG8_SB(0, 0), cB, voffB); PG8_STAGE(PG8_SB(0, 1), cB + hstep, voffB); PG8_STAGE(PG8_SA(0, 0), cA, voffA); PG8_STAGE(PG8_SA(0, 1), cA + hstep, voffA);
        if (wr == 1) PG8_BAR;
        PG8_WAIT_V(2); PG8_BAR;
        PG8_STAGE(PG8_SB(1, 0), cB + kstep, voffB); PG8_STAGE(PG8_SA(1, 0), cA + kstep, voffA); PG8_STAGE(PG8_SB(1, 1), cB + hstep + kstep, voffB);
        PG8_WAIT_V(6); PG8_BAR;
    } else {
        PG8_STAGE(PG8_SB(0, 0), cB, voffB); PG8_STAGE(PG8_SA(0, 0), cA, voffA); PG8_STAGE(PG8_SB(0, 1), cB + hstep, voffB); PG8_STAGE(PG8_SA(0, 1), cA + hstep, voffA);
        if (wr == 1) PG8_BAR;
        PG8_WAIT_V(4); PG8_BAR;
        PG8_STAGE(PG8_SB(1, 0), cB + kstep, voffB); PG8_STAGE(PG8_SA(1, 0), cA + kstep, voffA); PG8_STAGE(PG8_SB(1, 1), cB + hstep + kstep, voffB);
        PG8_WAIT_V(6); PG8_BAR;
    }
    for (;;) {
        const bool has_next = S.next(ui + 1, nxt);
        const char* nA = has_next ? (const char*)g.A + (size_t)nxt.pm * tstep : cA; const char* nB = has_next ? (const char*)g.Bt + (size_t)nxt.pn * tstep : cB;
        for (int t = 0; t < nt; t += 2) {
            const bool last = (t == nt - 2);
            if constexpr (Epi::HOOK) { if (t != 0 && (t & 3) == 0) E.hook(acc, cur, t, wr, wc, fr, fq); }
            const char* a1 = cA + (size_t)(t + 1) * kstep;
            const char* a2 = last ? nA : cA + (size_t)(t + 2) * kstep; const char* b2 = last ? nB : cB + (size_t)(t + 2) * kstep;
            const char* a3 = a2 + kstep; const char* b3 = b2 + kstep;
            if (last && has_next) S.a_ready(nxt);
            if constexpr (SP2) {
            PG8_LDB(B0, 0, 0); PG8_LDB(B1, 0, 1); PG8_SCHED; PG8_LDA(At, 0, 0); PG8_STAGE(PG8_SA(1, 1), a1 + hstep, voffA);
            PG8_WAIT_V(8); PG8_WAIT_L(0); PG8_BAR; PG8_MMA(0, 0, At, B0); PG8_MMA(0, 1, At, B1); PG8_BAR; PG8_SCHED;
            PG8_LDA(At, 0, 1); PG8_STAGE(PG8_SB(0, 0), b2, voffB); PG8_STAGE(PG8_SB(0, 1), b2 + hstep, voffB); PG8_STAGE(PG8_SA(0, 0), a2, voffA);
            PG8_WAIT_V(8); PG8_WAIT_L(0); PG8_BAR; PG8_MMA(1, 0, At, B0); PG8_MMA(1, 1, At, B1); PG8_BAR; PG8_SCHED;
            PG8_LDB(B0, 1, 0); PG8_LDB(B1, 1, 1); PG8_SCHED; PG8_LDA(At, 1, 0); PG8_STAGE(PG8_SA(0, 1), a2 + hstep, voffA);
            PG8_WAIT_V(8); PG8_WAIT_L(0); PG8_BAR; PG8_MMA(0, 0, At, B0); PG8_MMA(0, 1, At, B1); PG8_BAR; PG8_SCHED;
            PG8_LDA(At, 1, 1); PG8_STAGE(PG8_SB(1, 0), b3, voffB); PG8_STAGE(PG8_SB(1, 1), b3 + hstep, voffB); PG8_STAGE(PG8_SA(1, 0), a3, voffA);
            PG8_WAIT_V(8); PG8_WAIT_L(0); PG8_BAR; PG8_MMA(1, 0, At, B0); PG8_MMA(1, 1, At, B1); PG8_BAR; PG8_SCHED;
            } else {
            PG8_LDB(B0, 0, 0); PG8_SCHED; PG8_LDA(At, 0, 0); PG8_STAGE(PG8_SA(1, 1), a1 + hstep, voffA);
            PG8_WAIT_L(8); PG8_BAR; PG8_WAIT_L(0); PG8_MMA(0, 0, At, B0); PG8_BAR; PG8_SCHED;
            PG8_LDB(B1, 0, 1); PG8_STAGE(PG8_SB(0, 0), b2, voffB);
            PG8_BAR; PG8_WAIT_L(0); PG8_MMA(0, 1, At, B1); PG8_BAR;
            PG8_LDA(At, 0, 1); PG8_STAGE(PG8_SA(0, 0), a2, voffA);
            PG8_BAR; PG8_WAIT_L(0); PG8_MMA(1, 0, At, B0); PG8_BAR; PG8_SCHED;
            PG8_STAGE(PG8_SB(0, 1), b2 + hstep, voffB);
            PG8_WAIT_V(6); PG8_BAR; PG8_MMA(1, 1, At, B1); PG8_BAR;
            PG8_LDB(B0, 1, 0); PG8_SCHED; PG8_LDA(At, 1, 0); PG8_STAGE(PG8_SA(0, 1), a2 + hstep, voffA);
            PG8_WAIT_L(8); PG8_BAR; PG8_WAIT_L(0); PG8_MMA(0, 0, At, B0); PG8_BAR; PG8_SCHED;
            PG8_LDB(B1, 1, 1); PG8_STAGE(PG8_SB(1, 0), b3, voffB);
            PG8_BAR; PG8_WAIT_L(0); PG8_MMA(0, 1, At, B1); PG8_BAR;
            PG8_LDA(At, 1, 1); PG8_STAGE(PG8_SA(1, 0), a3, voffA);
            PG8_BAR; PG8_WAIT_L(0); PG8_MMA(1, 0, At, B0); PG8_BAR; PG8_SCHED;
            PG8_STAGE(PG8_SB(1, 1), b3 + hstep, voffB);
            PG8_WAIT_V(6); PG8_BAR; PG8_MMA(1, 1, At, B1); PG8_BAR;
            }
        }
        if constexpr (ALIGN_EPI) { if (wr == 0) PG8_BAR; }
        if constexpr (!Epi::AFTER_DRAIN) { E(acc, cur, wr, wc, fr, fq); S.done(cur); }
        if (!has_next) break;
#pragma unroll
        for (int a = 0; a < 2; ++a)
#pragma unroll
            for (int b = 0; b < 2; ++b)
#pragma unroll
                for (int m = 0; m < 4; ++m)
#pragma unroll
                    for (int n = 0; n < 2; ++n) acc[a][b][m][n] = (f32x4){0.f, 0.f, 0.f, 0.f};
        cur = nxt; cA = nA; cB = nB; ++ui;
        if constexpr (ALIGN_EPI) { if (wr == 1) PG8_BAR; }
    }
    PG8_WAIT_V(0);
    if constexpr (!ALIGN_EPI) { if (wr == 0) PG8_BAR; }
    PG8_BAR;
    if constexpr (Epi::AFTER_DRAIN) { E.fused(acc, cur, wr, wc, fr, fq, lds, wid, lane); S.done(cur); }
#undef PG8_SA
#undef PG8_SB
#undef PG8_STAGE
#undef PG8_LDA
#undef PG8_LDB
#undef PG8_MMA
#undef PG8_WAIT_V
#undef PG8_WAIT_L
#undef PG8_BAR
#undef PG8_SCHED
}
}

namespace att {
typedef short bf16x8 __attribute__((ext_vector_type(8)));
typedef short s16x4 __attribute__((ext_vector_type(4)));
typedef float f32x16 __attribute__((ext_vector_type(16)));
typedef unsigned u32x4 __attribute__((ext_vector_type(4)));
typedef float f32x4 __attribute__((ext_vector_type(4)));
constexpr int SLOTB = 8192, LDS_K = 0, LDS_V = 3 * SLOTB, LDS_WS = 6 * SLOTB, LDS_OST = LDS_WS + 8 * 256, OST_W = 8448, LDS_END = LDS_OST + 8 * OST_W, LDS_LUT = 131072 + 1024;
static_assert(LDS_END <= 131072 && LDS_LUT + 2 * 4352 <= cfg::LDS_BYTES, "attention LDS map");
__device__ __forceinline__ int crow(int r, int hi) { return (r & 3) + 8 * (r >> 2) + 4 * hi; }
__device__ __forceinline__ void glds16(const void* gsrc, unsigned lds_dst) { unsigned keep;
    asm volatile("s_mov_b32 %0, m0\n\ts_mov_b32 m0, %2\n\ts_nop 0\n\tglobal_load_lds_dwordx4 %1, off\n\ts_mov_b32 m0, %0" : "=&s"(keep) : "v"(gsrc), "s"(lds_dst) : "memory"); }
typedef float f32x2_t __attribute__((ext_vector_type(2))); typedef __bf16 bf16x2_t __attribute__((ext_vector_type(2)));
__device__ __forceinline__ unsigned cvtpk_s(float lo, float hi) { f32x2_t v = {lo, hi}; bf16x2_t b = __builtin_convertvector(v, bf16x2_t); return __builtin_bit_cast(unsigned, b); }
#define ATT_WAIT_BAR(N) asm volatile("s_waitcnt vmcnt(" #N ") lgkmcnt(0)\n\ts_barrier" ::: "memory")
#define ATT_MFMA(a, b, c) __builtin_amdgcn_mfma_f32_32x32x16_bf16(a, b, c, 0, 0, 0)

__device__ __forceinline__ void pv(f32x16* o, int vb, bf16x8 pa0, bf16x8 pa1, bf16x8 pa2, bf16x8 pa3) {
#pragma unroll
    for (int d0 = 0; d0 < 2; ++d0) { s16x4 lo[4], hi[4];
#pragma unroll
        for (int ks = 0; ks < 4; ++ks) {
            asm volatile("ds_read_b64_tr_b16 %0,%1 offset:%c2" : "=&v"(lo[ks]) : "v"(vb), "i"(d0 * 4096 + ks * 1024) : "memory");
            asm volatile("ds_read_b64_tr_b16 %0,%1 offset:%c2" : "=&v"(hi[ks]) : "v"(vb), "i"(d0 * 4096 + ks * 1024 + 512) : "memory"); }
        asm volatile("s_waitcnt lgkmcnt(0)" ::: "memory"); __builtin_amdgcn_sched_barrier(0);
#define ATT_PK(k) (bf16x8){lo[k][0], lo[k][1], lo[k][2], lo[k][3], hi[k][0], hi[k][1], hi[k][2], hi[k][3]}
        o[d0] = ATT_MFMA(pa0, ATT_PK(0), o[d0]);
        o[d0] = ATT_MFMA(pa1, ATT_PK(1), o[d0]);
        o[d0] = ATT_MFMA(pa2, ATT_PK(2), o[d0]);
        o[d0] = ATT_MFMA(pa3, ATT_PK(3), o[d0]);
#undef ATT_PK
    }
}

struct Ctx { const unsigned char* mix; bf16* Y; const float* sink; const float* subg; float lam, lam_scale; };

template <int MODE>
__device__ __forceinline__ void attn_unit(const Ctx& C, int item, char* shm, int tid) {
    using cfg::L; using cfg::T;
    constexpr int NK = (MODE == 2) ? 2 : 4;
    const int lane = tid & 63, r32 = lane & 31, hi = lane >> 5; const int wid = __builtin_amdgcn_readfirstlane(tid >> 6);
    const bf16* Qg = (const bf16*)C.mix; const bf16* Kg = (const bf16*)(C.mix + (size_t)T * 512); const bf16* Vg = (const bf16*)(C.mix + (size_t)T * 768);
    const int kvh = item & 1; int b, qpos0, h, kc0 = 0;
    if (MODE == 2) { const int qi = (item >> 1) % 66; b = (item >> 1) / 66; const int g = wid >> 2, c = (wid >> 1) & 1, rb = wid & 1; h = 2 * kvh + g; qpos0 = 64 * qi + 32 * rb; kc0 = 2 * c; }
    else { const int qb = (item >> 1) % 33; b = (item >> 1) / 33; h = 2 * kvh + (wid >> 2); qpos0 = 128 * qb + 32 * (wid & 3); }
    const int qpos = qpos0 + r32; const long mrow = (long)b * L + qpos;
    int kt_lo, nwin, NT;
    if (MODE == 0) { const int qb = qpos0 >> 7; kt_lo = 2 * qb - 2; if (kt_lo < 2) kt_lo = 2; int kt_hi = 2 * qb + 3; if (kt_hi > 65) kt_hi = 65; nwin = kt_hi - kt_lo + 1; NT = nwin + 1; }
    else { kt_lo = 1; nwin = 65; NT = 65; }
#define ATT_KT(t) ((t) < nwin ? kt_lo + (t) : 1)
    const unsigned lds0 = (unsigned)(uintptr_t)shm;
    float* wsf = (float*)(shm + LDS_WS) + wid * 64;
    const float* lutS = (const float*)(shm + LDS_LUT) + (MODE == 0 ? 1088 : 0);
    const bf16* Kh = Kg + (size_t)b * L * 128 + kvh * 64; const bf16* Vh = Vg + (size_t)b * L * 128 + kvh * 64;
    const bf16* ksrc = Kh + (long)lane * 128 + wid * 8;
    const bf16* vsrc = Vh + (long)(16 * (wid & 3) + (lane >> 2)) * 128 + (wid >> 2) * 32 + (lane & 3) * 8;
    const unsigned kdst = lds0 + LDS_K + wid * 1024, vdst = lds0 + LDS_V + wid * 1024;
#define ATT_DMA(t, slot) do { const long ko_ = (long)ATT_KT(t) * 64 * 128; glds16(ksrc + ko_, (unsigned)__builtin_amdgcn_readfirstlane(kdst + (slot))); glds16(vsrc + ko_, (unsigned)__builtin_amdgcn_readfirstlane(vdst + (slot))); } while (0)
    const int vb0 = (int)(lds0 + LDS_V) + ((lane >> 4) & 1) * 32 + (lane & 3) * 8 + (4 * hi + ((lane & 15) >> 2)) * 64;
    bf16x8 qr[NK];
    { const bf16* qp = Qg + mrow * 256 + h * 64 + 16 * kc0 + 8 * hi;
#pragma unroll
      for (int d0 = 0; d0 < NK; ++d0) qr[d0] = *(const bf16x8*)(qp + 16 * d0); }
    ATT_DMA(0, 0); if (NT > 1) ATT_DMA(1, SLOTB);
    float m_run = -1e30f, l_run = 0.f; f32x16 o[2];
#pragma unroll
    for (int r = 0; r < 16; ++r) { o[0][r] = 0.f; o[1][r] = 0.f; }
    int sl_cur = 0, sl_nn = 2 * SLOTB;
    for (int t = 0; t < NT; ++t) {
        if (t + 1 < NT) ATT_WAIT_BAR(2); else ATT_WAIT_BAR(0);
        if (t + 2 < NT) ATT_DMA(t + 2, sl_nn);
        const int kt = ATT_KT(t), k0 = kt * 64;
        float cinit = 0.f; bool near = false;
        if (MODE == 2) { if (k0 + 63 - qpos0 <= -128) cinit = lutS[h * 260]; else if (k0 - qpos0 - 31 >= 128) cinit = lutS[h * 260 + 256]; else near = true; }
        if (MODE == 0) near = true;
        f32x16 p0, p1;
        { const char* kb = shm + LDS_K + sl_cur + hi * 1024 + r32 * 16 + kc0 * 2048;
          f32x16 cz;
#pragma unroll
          for (int r = 0; r < 16; ++r) cz[r] = cinit;
#pragma unroll
          for (int d0 = 0; d0 < NK; ++d0) { const bf16x8 b0 = *(const bf16x8*)(kb + d0 * 2048), b1 = *(const bf16x8*)(kb + d0 * 2048 + 512);
              if (d0 == 0) { p0 = ATT_MFMA(b0, qr[0], cz); p1 = ATT_MFMA(b1, qr[0], cz); } else { p0 = ATT_MFMA(b0, qr[d0], p0); p1 = ATT_MFMA(b1, qr[d0], p1); } } }
        if (near) {
#pragma unroll
            for (int r = 0; r < 16; ++r) { const int j = crow(r, hi);
                int rel0 = k0 + j - qpos, rel1 = rel0 + 32;
                const int c0 = rel0 < -128 ? -128 : (rel0 > 128 ? 128 : rel0), c1 = rel1 < -128 ? -128 : (rel1 > 128 ? 128 : rel1);
                p0[r] += lutS[h * 260 + c0 + 128]; p1[r] += lutS[h * 260 + c1 + 128];
                if (MODE == 0 && kt != 1) { if (rel0 < -128 || rel0 > 128) p0[r] = -INFINITY; if (rel1 < -128 || rel1 > 128) p1[r] = -INFINITY; } }
        }
        if (kt == 1) {
#pragma unroll
            for (int r = 0; r < 16; ++r) { p0[r] = -INFINITY; if (r < 8) p1[r] = -INFINITY; }
        }
        float rm = fmaxf(p0[0], p1[0]);
#pragma unroll
        for (int r = 1; r < 16; ++r) rm = fmaxf(rm, fmaxf(p0[r], p1[r]));
        { auto rr = __builtin_amdgcn_permlane32_swap(__float_as_uint(rm), __float_as_uint(rm), false, false); rm = fmaxf(__uint_as_float(rr[0]), __uint_as_float(rr[1])); }
        bool resc = false;
        if (__any(rm > m_run + 8.0f)) { const float mn = fmaxf(m_run, rm); const float alpha = fexp2(m_run - mn); m_run = mn; l_run *= alpha; if (hi == 0) wsf[r32] = alpha; resc = true; }
        float sacc = 0.f;
#pragma unroll
        for (int r = 0; r < 16; ++r) { p0[r] = fexp2(p0[r] - m_run); p1[r] = fexp2(p1[r] - m_run); sacc += p0[r] + p1[r]; }
        l_run += sacc;
        if (resc) {
            asm volatile("s_waitcnt lgkmcnt(0)" ::: "memory");
#pragma unroll
            for (int r = 0; r < 16; ++r) { const float f = wsf[crow(r, hi)]; o[0][r] *= f; o[1][r] *= f; }
        }
        u32x4 pw0 = {cvtpk_s(p0[0], p0[1]), cvtpk_s(p0[2], p0[3]), cvtpk_s(p0[4], p0[5]), cvtpk_s(p0[6], p0[7])};
        u32x4 pw1 = {cvtpk_s(p0[8], p0[9]), cvtpk_s(p0[10], p0[11]), cvtpk_s(p0[12], p0[13]), cvtpk_s(p0[14], p0[15])};
        u32x4 pw2 = {cvtpk_s(p1[0], p1[1]), cvtpk_s(p1[2], p1[3]), cvtpk_s(p1[4], p1[5]), cvtpk_s(p1[6], p1[7])};
        u32x4 pw3 = {cvtpk_s(p1[8], p1[9]), cvtpk_s(p1[10], p1[11]), cvtpk_s(p1[12], p1[13]), cvtpk_s(p1[14], p1[15])};
        pv(o, vb0 + sl_cur, __builtin_bit_cast(bf16x8, pw0), __builtin_bit_cast(bf16x8, pw1), __builtin_bit_cast(bf16x8, pw2), __builtin_bit_cast(bf16x8, pw3));
        sl_nn = sl_cur; sl_cur = (sl_cur == 2 * SLOTB) ? 0 : sl_cur + SLOTB;
    }
    { auto rr = __builtin_amdgcn_permlane32_swap(__float_as_uint(l_run), __float_as_uint(l_run), false, false); l_run = __uint_as_float(rr[0]) + __uint_as_float(rr[1]); }
    if (MODE == 0) l_run += fexp2(C.sink[h] * cfg::LOG2E - m_run);
    if (hi == 0) wsf[32 + r32] = l_run;
    asm volatile("s_waitcnt lgkmcnt(0)" ::: "memory");
    float rli[16];
#pragma unroll
    for (int r = 0; r < 16; ++r) rli[r] = __builtin_amdgcn_rcpf(wsf[32 + crow(r, hi)]);
    if (MODE != 2) {
        bf16* Ow = C.Y + ((long)b * L + qpos0) * 1024 + (MODE == 0 ? 0 : 256) + h * 64;
        unsigned short* stg = (unsigned short*)(shm + LDS_OST + wid * OST_W);
#pragma unroll
        for (int r = 0; r < 16; ++r) { const int orow = crow(r, hi);
#pragma unroll
            for (int d0 = 0; d0 < 2; ++d0) stg[orow * 64 + d0 * 32 + r32] = (unsigned short)f2bf(o[d0][r] * rli[r]); }
        asm volatile("s_waitcnt lgkmcnt(0)" ::: "memory");
#pragma unroll
        for (int i = 0; i < 4; ++i) { const int row = i * 8 + (lane >> 3), ch = lane & 7; const u32x4 v = *(const u32x4*)(stg + row * 64 + ch * 8); *(u32x4*)(Ow + (long)row * 1024 + ch * 8) = v; }
    } else {
        const int g = wid >> 2, c = (wid >> 1) & 1, rb = wid & 1;
        float* buf = (float*)(shm + LDS_OST + (g * 2 + rb) * OST_W);
        if (c == 1) {
#pragma unroll
            for (int r = 0; r < 16; ++r) { const int orow = crow(r, hi);
#pragma unroll
                for (int d0 = 0; d0 < 2; ++d0) buf[orow * 66 + d0 * 32 + r32] = o[d0][r] * rli[r]; }
        }
        asm volatile("s_waitcnt lgkmcnt(0)\n\ts_barrier" ::: "memory");
        if (c == 0) {
#pragma unroll
            for (int r = 0; r < 16; ++r) { const int orow = crow(r, hi);
#pragma unroll
                for (int d0 = 0; d0 < 2; ++d0) { float* e = buf + orow * 66 + d0 * 32 + r32; *e = o[d0][r] * rli[r] - C.lam * *e; } }
            asm volatile("s_waitcnt lgkmcnt(0)" ::: "memory");
            const int row = lane >> 1, half = lane & 1; const float* src = buf + row * 66 + half * 32;
            float x[32]; float ss = 0.f;
#pragma unroll
            for (int d = 0; d < 32; ++d) { x[d] = src[d]; ss += x[d] * x[d]; }
            ss += __shfl_xor(ss, 1);
            const float rn = __builtin_amdgcn_rsqf(ss * (1.0f / 64.0f) + cfg::RMS_EPS) * C.lam_scale;
            const float* sg = C.subg + half * 32;
            bf16* yp = C.Y + ((long)b * L + qpos0 + row) * 1024 + 512 + h * 64 + half * 32;
#pragma unroll
            for (int d = 0; d < 32; d += 8) { u32x4 w;
                w.x = pk2(x[d] * rn * sg[d], x[d + 1] * rn * sg[d + 1]); w.y = pk2(x[d + 2] * rn * sg[d + 2], x[d + 3] * rn * sg[d + 3]);
                w.z = pk2(x[d + 4] * rn * sg[d + 4], x[d + 5] * rn * sg[d + 5]); w.w = pk2(x[d + 6] * rn * sg[d + 6], x[d + 7] * rn * sg[d + 7]);
                *(u32x4*)(yp + d) = w; }
        }
    }
    asm volatile("s_waitcnt lgkmcnt(0)\n\ts_barrier" ::: "memory");
#undef ATT_DMA
#undef ATT_KT
}
}

namespace att {
typedef __attribute__((address_space(3))) const char* lds_cptr;
typedef short v4i16_t __attribute__((ext_vector_type(4)));
__device__ __forceinline__ s16x4 vtr(lds_cptr p) { return __builtin_bit_cast(s16x4, __builtin_amdgcn_ds_read_tr16_b64_v4i16((__attribute__((address_space(3))) v4i16_t*)p)); }
__device__ __forceinline__ bf16x8 kld(lds_cptr p) { return *(const __attribute__((address_space(3))) bf16x8*)p; }
#define SBAR() __builtin_amdgcn_sched_barrier(0)

template <int MODE>
__device__ __forceinline__ void attn_unit_p(const Ctx& C, int item, char* shm, int tid) {
    using cfg::L; using cfg::T;
    constexpr int NK = (MODE == 2) ? 2 : 4;
    const int lane = tid & 63, r32 = lane & 31, hi = lane >> 5; const int wid = __builtin_amdgcn_readfirstlane(tid >> 6);
    const bf16* Qg = (const bf16*)C.mix; const bf16* Kg = (const bf16*)(C.mix + (size_t)T * 512); const bf16* Vg = (const bf16*)(C.mix + (size_t)T * 768);
    const int kvh = item & 1; int b, qpos0, h, kc0 = 0;
    if (MODE == 2) { const int qi = (item >> 1) % 66; b = (item >> 1) / 66; const int g = wid >> 2, c = (wid >> 1) & 1, rb = wid & 1; h = 2 * kvh + g; qpos0 = 64 * qi + 32 * rb; kc0 = 2 * c; }
    else { const int qb = (item >> 1) % 33; b = (item >> 1) / 33; h = 2 * kvh + (wid >> 2); qpos0 = 128 * qb + 32 * (wid & 3); }
    const int qpos = qpos0 + r32; const long mrow = (long)b * L + qpos;
    int kt_lo = 1, NT = 65;
    if (MODE == 0) { const int qb = qpos0 >> 7; kt_lo = 2 * qb - 2; if (kt_lo < 2) kt_lo = 2; int kt_hi = 2 * qb + 3; if (kt_hi > 65) kt_hi = 65; NT = kt_hi - kt_lo + 2; }
#define ATT_KT(t) (MODE == 0 ? ((t) == 0 ? 1 : kt_lo + (t) - 1) : 1 + (t))
    const unsigned lds0 = (unsigned)(uintptr_t)shm;
    float* wsf = (float*)(shm + LDS_WS) + wid * 64;
    const float* lutS = (const float*)(shm + LDS_LUT) + (MODE == 0 ? 1088 : 0);
    const bf16* Kh = Kg + (size_t)b * L * 128 + kvh * 64; const bf16* Vh = Vg + (size_t)b * L * 128 + kvh * 64;
    const bf16* ksrc = Kh + (long)lane * 128 + wid * 8;
    const bf16* vsrc = Vh + (long)(16 * (wid & 3) + (lane >> 2)) * 128 + (wid >> 2) * 32 + (lane & 3) * 8;
    const unsigned kdst = lds0 + LDS_K + wid * 1024, vdst = lds0 + LDS_V + wid * 1024;
#define DMA_K(t, slot) glds16(ksrc + (long)ATT_KT(t) * 64 * 128, (unsigned)__builtin_amdgcn_readfirstlane(kdst + (slot)))
#define DMA_V(t, slot) glds16(vsrc + (long)ATT_KT(t) * 64 * 128, (unsigned)__builtin_amdgcn_readfirstlane(vdst + (slot)))
    const int vb0 = (int)(lds0 + LDS_V) + ((lane >> 4) & 1) * 32 + (lane & 3) * 8 + (4 * hi + ((lane & 15) >> 2)) * 64;
    const lds_cptr shm3 = (lds_cptr)shm; const lds_cptr kp0 = shm3 + LDS_K + hi * 1024 + r32 * 16 + kc0 * 2048;
    const lds_cptr vp0 = shm3 + LDS_V + ((lane >> 4) & 1) * 32 + (lane & 3) * 8 + (4 * hi + ((lane & 15) >> 2)) * 64;
    bf16x8 kf[2 * NK];
    DMA_K(0, 0); DMA_V(0, 0); DMA_K(1, SLOTB);
    bf16x8 qr[NK];
    { const bf16* qp = Qg + mrow * 256 + h * 64 + 16 * kc0 + 8 * hi;
#pragma unroll
      for (int d0 = 0; d0 < NK; ++d0) qr[d0] = *(const bf16x8*)(qp + 16 * d0); }
    float mhat = 0.f, l_reg = 0.f; f32x16 o[2]; f32x16 negm;
#pragma unroll
    for (int r = 0; r < 16; ++r) { o[0][r] = 0.f; o[1][r] = 0.f; negm[r] = 0.f; }
    asm volatile("" : "+v"(negm));
    bool resc = false;
    f32x16 czp; float czb = 0.f;
#pragma unroll
    for (int r = 0; r < 16; ++r) czp[r] = 0.f;
    const float fbLo = (MODE == 2) ? lutS[h * 260] : 0.f, fbHi = (MODE == 2) ? lutS[h * 260 + 256] : 0.f;
#define FARB(t) ((MODE != 2) ? 0.f : ((ATT_KT(t) * 64 + 63 - qpos0 <= -128) ? fbLo : ((ATT_KT(t) * 64 - qpos0 - 31 >= 128) ? fbHi : 0.f)))
#define HOOK(P0, P1, t) do { const int kt_ = ATT_KT(t), k0_ = kt_ * 64; \
        const bool near_ = (MODE == 0) || (MODE == 2 && !(k0_ + 63 - qpos0 <= -128) && !(k0_ - qpos0 - 31 >= 128)); \
        if (near_) { _Pragma("unroll") for (int r = 0; r < 16; ++r) { const int rel0 = k0_ + crow(r, hi) - qpos, rel1 = rel0 + 32; \
            const int c0_ = rel0 < -128 ? -128 : (rel0 > 128 ? 128 : rel0), c1_ = rel1 < -128 ? -128 : (rel1 > 128 ? 128 : rel1); \
            P0[r] += lutS[h * 260 + c0_ + 128]; P1[r] += lutS[h * 260 + c1_ + 128]; \
            if (MODE == 0 && kt_ != 1) { if (rel0 < -128 || rel0 > 128) P0[r] = -INFINITY; if (rel1 < -128 || rel1 > 128) P1[r] = -INFINITY; } } } \
        if (kt_ == 1) { _Pragma("unroll") for (int r = 0; r < 16; ++r) { P0[r] = -INFINITY; if (r < 8) P1[r] = -INFINITY; } } } while (0)
#define RESC() do { if (resc) { asm volatile("s_waitcnt lgkmcnt(0)" ::: "memory"); \
        _Pragma("unroll") for (int d_ = 0; d_ < 2; ++d_) _Pragma("unroll") for (int r = 0; r < 16; ++r) o[d_][r] *= wsf[crow(r, hi)]; } } while (0)
    f32x16 pA0, pA1, pB0, pB1;
    int sl_prev = 0, sl_cur = 0, sl_next = SLOTB;
#define ROT() do { sl_prev = sl_cur; sl_cur = sl_next; sl_next = (sl_next == 2 * SLOTB) ? 0 : sl_next + SLOTB; } while (0)
    DMA_K(2, 2 * SLOTB);
    ATT_WAIT_BAR(3);
    { f32x16 cz;
#pragma unroll
      for (int r = 0; r < 16; ++r) cz[r] = FARB(0);
#pragma unroll
      for (int d0 = 0; d0 < NK; ++d0) { const bf16x8 b0 = kld(kp0 + d0 * 2048), b1 = kld(kp0 + d0 * 2048 + 512);
          if (d0 == 0) { pA0 = ATT_MFMA(b0, qr[0], cz); pA1 = ATT_MFMA(b1, qr[0], cz); } else { pA0 = ATT_MFMA(b0, qr[d0], pA0); pA1 = ATT_MFMA(b1, qr[d0], pA1); } } }
    HOOK(pA0, pA1, 0);
    { float rm = fmaxf(pA0[0], pA1[0]);
#pragma unroll
      for (int r = 1; r < 16; ++r) rm = fmaxf(rm, fmaxf(pA0[r], pA1[r]));
      { auto rr = __builtin_amdgcn_permlane32_swap(__float_as_uint(rm), __float_as_uint(rm), false, false); rm = fmaxf(__uint_as_float(rr[0]), __uint_as_float(rr[1])); }
      mhat = rm;
#pragma unroll
      for (int r = 0; r < 16; ++r) { pA0[r] = fexp2(pA0[r] - rm); pA1[r] = fexp2(pA1[r] - rm); negm[r] = -mhat; czp[r] = -mhat; }
      asm volatile("" : "+v"(negm)); czb = 0.f; }
    ATT_WAIT_BAR(0);
    if (3 < NT) DMA_K(3, 0); DMA_V(1, SLOTB);
    ROT();
#pragma unroll
    for (int j = 0; j < NK; ++j) { kf[2 * j] = kld(kp0 + sl_cur + j * 2048); kf[2 * j + 1] = kld(kp0 + sl_cur + j * 2048 + 512); }
    ATT_WAIT_BAR(2);
    s16x4 vlo[8], vhi[8]; u32x4 pw0, pw1, pw2, pw3;
#define PKW(P, B) cvtpk_s(P[B], P[B + 1])
#define PAF(k) __builtin_bit_cast(bf16x8, pw##k)
#define VFR(i) (bf16x8){vlo[i][0], vlo[i][1], vlo[i][2], vlo[i][3], vhi[i][0], vhi[i][1], vhi[i][2], vhi[i][3]}
#define PIN(x) asm volatile("" : "+v"(x))
#define MX3(a, b, c) __builtin_fmaxf(__builtin_fmaxf((a), (b)), (c))
#define GAPA(MF, A0, A1, A2, A3, W0, W1, PW) do { MF; sacc += (f32x2_t){A0, A1}; sacc += (f32x2_t){A2, A3}; PIN(sacc); W0; W1; PIN(PW); SBAR(); } while (0)
#define EX(v) __builtin_amdgcn_exp2f(v)
#define GAPB(MF, X, B) do { MF; X[B] = EX(X[B]); X[B + 1] = EX(X[B + 1]); X[B + 2] = EX(X[B + 2]); X[B + 3] = EX(X[B + 3]); PIN(X); SBAR(); } while (0)
#define VRD(i) do { vlo[i] = vtr(vp_ + (((i) >> 2) * 4096 + ((i) & 3) * 1024)); vhi[i] = vtr(vp_ + (((i) >> 2) * 4096 + ((i) & 3) * 1024 + 512)); } while (0)
#define KRD(G, j) do { if ((G) && (j) < NK) { kf[2 * (j)] = kld(kp0 + sl_next + (j) * 2048); kf[2 * (j) + 1] = kld(kp0 + sl_next + (j) * 2048 + 512); SBAR(); } } while (0)
#define QK(n, C0, C1) do { if ((n) < 2 * NK) { if ((n) == 0) C0 = ATT_MFMA(kf[0], qr[0], cz_); else if ((n) == 1) C1 = ATT_MFMA(kf[1], qr[0], cz_); \
        else if (((n) & 1) == 0) C0 = ATT_MFMA(kf[(n) < 2 * NK ? (n) : 0], qr[((n) >> 1) < NK ? ((n) >> 1) : 0], C0); else C1 = ATT_MFMA(kf[(n) < 2 * NK ? (n) : 0], qr[((n) >> 1) < NK ? ((n) >> 1) : 0], C1); } } while (0)
#define STEP(C0, C1, P0, P1, t, GK, GV, GL) do { SBAR(); \
    const lds_cptr vp_ = vp0 + sl_prev; \
    if (MODE == 2) { const float fb_ = FARB(t); if (fb_ != czb) { czb = fb_; _Pragma("unroll") for (int r = 0; r < 16; ++r) czp[r] = negm[r] + fb_; asm volatile("" : "+v"(czp)); } } \
    const f32x16& cz_ = (MODE == 2) ? czp : negm; \
    VRD(0); SBAR(); f32x2_t sacc = {P0[0], P0[1]}; \
    GAPA(QK(0, C0, C1), P0[2], P0[3], P0[4], P0[5],     pw0[0] = PKW(P0, 0), pw0[1] = PKW(P0, 2), pw0); \
    VRD(4); SBAR(); GAPA(QK(1, C0, C1), P0[6], P0[7], P0[8], P0[9],     pw0[2] = PKW(P0, 4), pw0[3] = PKW(P0, 6), pw0); \
    VRD(1); SBAR(); GAPA(QK(2, C0, C1), P0[10], P0[11], P0[12], P0[13], pw1[0] = PKW(P0, 8), pw1[1] = PKW(P0, 10), pw1); \
    VRD(5); SBAR(); GAPA(QK(3, C0, C1), P0[14], P0[15], P1[0], P1[1],   pw1[2] = PKW(P0, 12), pw1[3] = PKW(P0, 14), pw1); \
    VRD(2); SBAR(); GAPA(QK(4, C0, C1), P1[2], P1[3], P1[4], P1[5],     pw2[0] = PKW(P1, 0), pw2[1] = PKW(P1, 2), pw2); \
    VRD(6); SBAR(); GAPA(QK(5, C0, C1), P1[6], P1[7], P1[8], P1[9],     pw2[2] = PKW(P1, 4), pw2[3] = PKW(P1, 6), pw2); \
    VRD(3); SBAR(); GAPA(QK(6, C0, C1), P1[10], P1[11], P1[12], P1[13], pw3[0] = PKW(P1, 8), pw3[1] = PKW(P1, 10), pw3); \
    VRD(7); SBAR(); GAPA(QK(7, C0, C1), P1[14], P1[15], 0.f, 0.f,       pw3[2] = PKW(P1, 12), pw3[3] = PKW(P1, 14), pw3); \
    l_reg += sacc[0] + sacc[1]; \
    if (GK) { DMA_K((t) + 3, sl_cur); } if (GV) { DMA_V((t) + 1, sl_next); } \
    HOOK(C0, C1, t); \
    { float a = MX3(C0[0], C0[1], C1[0]), b_ = MX3(C0[2], C0[3], C1[1]); a = MX3(a, C1[2], C1[3]); \
      _Pragma("unroll") for (int r = 4; r < 16; r += 4) { a = MX3(a, C0[r], C0[r + 1]); b_ = MX3(b_, C0[r + 2], C0[r + 3]); a = MX3(a, C1[r], C1[r + 1]); b_ = MX3(b_, C1[r + 2], C1[r + 3]); } \
      float rm = __builtin_fmaxf(a, b_); { auto rr = __builtin_amdgcn_permlane32_swap(__float_as_uint(rm), __float_as_uint(rm), false, false); rm = __builtin_fmaxf(__uint_as_float(rr[0]), __uint_as_float(rr[1])); } \
      resc = false; \
      if (__builtin_expect(__any(rm > 8.0f), 0)) { const float dl = __builtin_fmaxf(rm, 0.f); mhat += dl; \
        _Pragma("unroll") for (int r = 0; r < 16; ++r) { C0[r] -= dl; C1[r] -= dl; } \
        _Pragma("unroll") for (int r = 0; r < 16; ++r) negm[r] = -mhat; asm volatile("" : "+v"(negm)); \
        if (MODE == 2) { _Pragma("unroll") for (int r = 0; r < 16; ++r) czp[r] = czb - mhat; asm volatile("" : "+v"(czp)); } \
        const float f = __builtin_amdgcn_exp2f(-dl); l_reg *= f; if (hi == 0) wsf[r32] = f; resc = true; } } \
    SBAR(); \
    GAPB(o[0] = ATT_MFMA(PAF(0), VFR(0), o[0]), C0, 0); \
    GAPB(o[1] = ATT_MFMA(PAF(0), VFR(4), o[1]), C0, 4); \
    KRD(GL, 0); GAPB(o[0] = ATT_MFMA(PAF(1), VFR(1), o[0]), C0, 8); \
    KRD(GL, 1); GAPB(o[1] = ATT_MFMA(PAF(1), VFR(5), o[1]), C0, 12); \
    KRD(GL, 2); GAPB(o[0] = ATT_MFMA(PAF(2), VFR(2), o[0]), C1, 0); \
    KRD(GL, 3); GAPB(o[1] = ATT_MFMA(PAF(2), VFR(6), o[1]), C1, 4); \
    GAPB(o[0] = ATT_MFMA(PAF(3), VFR(3), o[0]), C1, 8); \
    GAPB(o[1] = ATT_MFMA(PAF(3), VFR(7), o[1]), C1, 12); \
    } while (0)
#define ENDW(tt) do { if ((tt) + 3 < NT) { ATT_WAIT_BAR(2); } else if ((tt) + 2 < NT) { ATT_WAIT_BAR(1); } else { ATT_WAIT_BAR(0); } } while (0)
#define DRAIN(P0, P1, slot) do { float sacc = P0[0] + P0[1]; _Pragma("unroll") for (int r = 2; r < 16; ++r) sacc += P0[r]; _Pragma("unroll") for (int r = 0; r < 16; ++r) sacc += P1[r]; l_reg += sacc; \
    pw0 = (u32x4){PKW(P0, 0), PKW(P0, 2), PKW(P0, 4), PKW(P0, 6)}; pw1 = (u32x4){PKW(P0, 8), PKW(P0, 10), PKW(P0, 12), PKW(P0, 14)}; pw2 = (u32x4){PKW(P1, 0), PKW(P1, 2), PKW(P1, 4), PKW(P1, 6)}; pw3 = (u32x4){PKW(P1, 8), PKW(P1, 10), PKW(P1, 12), PKW(P1, 14)}; \
    SBAR(); pv(o, vb0 + (slot), PAF(0), PAF(1), PAF(2), PAF(3)); } while (0)
    int t = 1;
    for (; t + 5 < NT; t += 2) {
        STEP(pB0, pB1, pA0, pA1, t, true, true, true);     ATT_WAIT_BAR(2); RESC(); ROT();
        STEP(pA0, pA1, pB0, pB1, t + 1, true, true, true); ATT_WAIT_BAR(2); RESC(); ROT();
    }
    for (; t + 1 < NT; t += 2) {
        STEP(pB0, pB1, pA0, pA1, t, (t + 3 < NT), (t + 1 < NT), (t + 1 < NT));     ENDW(t);     RESC(); ROT();
        STEP(pA0, pA1, pB0, pB1, t + 1, (t + 4 < NT), (t + 2 < NT), (t + 2 < NT)); ENDW(t + 1); RESC(); ROT();
    }
    if (t < NT) { STEP(pB0, pB1, pA0, pA1, t, false, false, false); RESC(); DRAIN(pB0, pB1, sl_cur); }
    else { DRAIN(pA0, pA1, sl_prev); }
#undef PKW
#undef PAF
#undef VFR
#undef PIN
#undef MX3
#undef GAPA
#undef GAPB
#undef EX
#undef VRD
#undef KRD
#undef QK
#undef STEP
#undef ENDW
#undef DRAIN
#undef HOOK
#undef FARB
#undef RESC
#undef ROT
    { auto rr = __builtin_amdgcn_permlane32_swap(__float_as_uint(l_reg), __float_as_uint(l_reg), false, false); l_reg = __uint_as_float(rr[0]) + __uint_as_float(rr[1]); }
    if (MODE == 0) l_reg += fexp2(C.sink[h] * cfg::LOG2E - mhat);
    if (hi == 0) wsf[32 + r32] = l_reg;
    asm volatile("s_waitcnt lgkmcnt(0)" ::: "memory");
    float rli[16];
#pragma unroll
    for (int r = 0; r < 16; ++r) rli[r] = __builtin_amdgcn_rcpf(wsf[32 + crow(r, hi)]);
    if (MODE != 2) {
        bf16* Ow = C.Y + ((long)b * L + qpos0) * 1024 + (MODE == 0 ? 0 : 256) + h * 64;
        unsigned short* stg = (unsigned short*)(shm + LDS_OST + wid * OST_W);
#pragma unroll
        for (int r = 0; r < 16; ++r) { const int orow = crow(r, hi);
#pragma unroll
            for (int d0 = 0; d0 < 2; ++d0) stg[orow * 64 + d0 * 32 + r32] = (unsigned short)f2bf(o[d0][r] * rli[r]); }
        asm volatile("s_waitcnt lgkmcnt(0)" ::: "memory");
#pragma unroll
        for (int i = 0; i < 4; ++i) { const int row = i * 8 + (lane >> 3), ch = lane & 7; const u32x4 v = *(const u32x4*)(stg + row * 64 + ch * 8); *(u32x4*)(Ow + (long)row * 1024 + ch * 8) = v; }
    } else {
        const int g = wid >> 2, c = (wid >> 1) & 1, rb = wid & 1;
        float* buf = (float*)(shm + LDS_OST + (g * 2 + rb) * OST_W);
        if (c == 1) {
#pragma unroll
            for (int r = 0; r < 16; ++r) { const int orow = crow(r, hi);
#pragma unroll
                for (int d0 = 0; d0 < 2; ++d0) buf[orow * 66 + d0 * 32 + r32] = o[d0][r] * rli[r]; }
        }
        asm volatile("s_waitcnt lgkmcnt(0)\n\ts_barrier" ::: "memory");
        if (c == 0) {
#pragma unroll
            for (int r = 0; r < 16; ++r) { const int orow = crow(r, hi);
#pragma unroll
                for (int d0 = 0; d0 < 2; ++d0) { float* e = buf + orow * 66 + d0 * 32 + r32; *e = o[d0][r] * rli[r] - C.lam * *e; } }
            asm volatile("s_waitcnt lgkmcnt(0)" ::: "memory");
            const int row = lane >> 1, half = lane & 1; const float* src = buf + row * 66 + half * 32;
            float x[32]; float ss = 0.f;
#pragma unroll
            for (int d = 0; d < 32; ++d) { x[d] = src[d]; ss += x[d] * x[d]; }
            ss += __shfl_xor(ss, 1);
            const float rn = __builtin_amdgcn_rsqf(ss * (1.0f / 64.0f) + cfg::RMS_EPS) * C.lam_scale;
            const float* sg = C.subg + half * 32;
            bf16* yp = C.Y + ((long)b * L + qpos0 + row) * 1024 + 512 + h * 64 + half * 32;
#pragma unroll
            for (int d = 0; d < 32; d += 8) { u32x4 w;
                w.x = pk2(x[d] * rn * sg[d], x[d + 1] * rn * sg[d + 1]); w.y = pk2(x[d + 2] * rn * sg[d + 2], x[d + 3] * rn * sg[d + 3]);
                w.z = pk2(x[d + 4] * rn * sg[d + 4], x[d + 5] * rn * sg[d + 5]); w.w = pk2(x[d + 6] * rn * sg[d + 6], x[d + 7] * rn * sg[d + 7]);
                *(u32x4*)(yp + d) = w; }
        }
    }
    asm volatile("s_waitcnt lgkmcnt(0)\n\ts_barrier" ::: "memory");
#undef DMA_K
#undef DMA_V
#undef ATT_KT
}
#undef SBAR
}

namespace hg {
typedef float f32x4 __attribute__((ext_vector_type(4)));
typedef short bf16x8 __attribute__((ext_vector_type(8)));
typedef unsigned u32x4 __attribute__((ext_vector_type(4)));
constexpr int B_QT = 0, B_KE = 18432, B_VT = 36864, B_SS = 54272, B_KT = 63488, B_RR = 80896, B_TOT = 83200, B_SX = 85248, B_END = 87552;
static_assert(B_END <= 131072, "HGRN LDS map");
#define HG_MFMA(a, b, c) __builtin_amdgcn_mfma_f32_16x16x32_bf16(a, b, c, 0, 0, 0)
#define WT_STORE(p, v) __hip_atomic_store((p), (v), __ATOMIC_RELAXED, __HIP_MEMORY_SCOPE_AGENT)

struct Ptrs { const bf16* DQ; const bf16* ZF; const bf16* ZB; const bf16* DI; const bf16* DG; const float* lbf; const float* lbb; float* ST; float* AC; };

__device__ __forceinline__ bf16x8 pack8(const float* x) { u32x4 w; w.x = pk2(x[0], x[1]); w.y = pk2(x[2], x[3]); w.z = pk2(x[4], x[5]); w.w = pk2(x[6], x[7]); return __builtin_bit_cast(bf16x8, w); }

struct Raw { unsigned short zf[16], zb[16], q[16], v[16]; };
template <bool S1MODE>
__device__ __forceinline__ void pre_load(const Ptrs& P, int b, int h, int c, int tid, Raw& R) {
    const int I = tid >> 6, k = tid & 63;
#pragma unroll
    for (int i = 0; i < 16; ++i) {
        const size_t off = (size_t)(b * cfg::L + 128 * c + 16 * I + i) * 256 + h * 64 + k;
        R.zf[i] = P.ZF[off]; R.zb[i] = P.ZB[off]; R.v[i] = P.DI[off]; if (!S1MODE) R.q[i] = P.DQ[off];
    }
}
template <bool S1MODE>
__device__ __forceinline__ void pre_compute(const Ptrs& P, int h, int c, int dir, unsigned char* lb_, int tid, const Raw& R) {
    const int I = dir ? 7 - (tid >> 6) : (tid >> 6), k = tid & 63;
#define RN(a, i) (dir ? R.a[15 - (i)] : R.a[i])
    unsigned short* QT = (unsigned short*)(lb_ + B_QT); unsigned short* KE = (unsigned short*)(lb_ + B_KE); unsigned short* VT = (unsigned short*)(lb_ + B_VT);
    unsigned short* KT = (unsigned short*)(lb_ + B_KT); float* RR = (float*)(lb_ + B_RR); float* TOT = (float*)(lb_ + B_TOT);
    const float lb = (dir ? P.lbb : P.lbf)[h * 64 + k];
    float pr = 1.f; float fv[16], kq[16];
#pragma unroll
    for (int i = 0; i < 16; ++i) {
        const int tau = 16 * I + i;
        const float z = __builtin_amdgcn_fmed3f(bf2f(dir ? R.zb[15 - i] : R.zf[i]), -80.0f, 80.0f), ez = __builtin_amdgcn_exp2f(-cfg::LOG2E * z), sg = __builtin_amdgcn_rcpf(1.0f + ez);
        const float fr_ = lb + (1.0f - lb) * sg, f = fmaxf(fr_, 1e-30f);
        pr *= f; fv[i] = f;
        kq[i] = 1.0f - fr_;
        if (!S1MODE) QT[tau * 72 + k] = (unsigned short)pk2(bf2f(RN(q, i)) * pr, 0.f);
    }
    if (c == 0) {
#pragma unroll
        for (int i = 0; i < 16; ++i) { const int tau = 16 * I + i, t = dir ? 127 - tau : tau; if (t < cfg::FRONT) kq[i] = 0.0f; }
    }
    { u32x4 w0, w1;
      w0.x = RN(v, 0) | ((unsigned)RN(v, 1) << 16); w0.y = RN(v, 2) | ((unsigned)RN(v, 3) << 16); w0.z = RN(v, 4) | ((unsigned)RN(v, 5) << 16); w0.w = RN(v, 6) | ((unsigned)RN(v, 7) << 16);
      w1.x = RN(v, 8) | ((unsigned)RN(v, 9) << 16); w1.y = RN(v, 10) | ((unsigned)RN(v, 11) << 16); w1.z = RN(v, 12) | ((unsigned)RN(v, 13) << 16); w1.w = RN(v, 14) | ((unsigned)RN(v, 15) << 16);
      *(u32x4*)(lb_ + B_VT + k * 272 + 32 * I) = w0; *(u32x4*)(lb_ + B_VT + k * 272 + 32 * I + 16) = w1; }
    { float sf = 1.f;
#pragma unroll
      for (int i = 15; i >= 0; --i) { kq[i] *= sf; sf *= fv[i]; } }
    if (!S1MODE) {
#pragma unroll
        for (int i = 0; i < 16; ++i) KE[(16 * I + i) * 72 + k] = (unsigned short)pk2(kq[i], 0.f);
    }
    TOT[I * 64 + k] = pr;
    __syncthreads();
    float dd[8];
#pragma unroll
    for (int J = 0; J < 8; ++J) dd[J] = TOT[J * 64 + k];
    if (S1MODE) {
        float ef = 1.f, all = 1.f;
#pragma unroll
        for (int J = 0; J < 8; ++J) { ef *= (J > I) ? dd[J] : 1.0f; all *= dd[J]; }
        float x[16];
#pragma unroll
        for (int i = 0; i < 16; ++i) x[i] = kq[i] * ef;
        *(bf16x8*)(lb_ + B_KT + k * 272 + 32 * I) = pack8(x); *(bf16x8*)(lb_ + B_KT + k * 272 + 32 * I + 16) = pack8(x + 8);
        if (tid < 64) RR[8 * 64 + k] = all;
        __syncthreads();
    } else {
        float r = 1.f;
#pragma unroll
        for (int J = 0; J < 8; ++J) r *= (J < I) ? dd[J] : 1.0f;
        RR[I * 64 + k] = r;
        __syncthreads();
    }
}
#undef RN
__device__ __forceinline__ int hg_item_bh(int item) { return item < 256 ? item >> 4 : item - 256; }
__device__ __forceinline__ int hg_item_j(int item) { return item < 256 ? item & 15 : 16; }
__device__ __forceinline__ size_t st_item(int b, int h, int c, int dir) { return (size_t)(((b * 4 + h) * 33 + c) * 2 + dir); }

__device__ __forceinline__ void s1_body(const Ptrs& P, int b, int h, int c, unsigned char* lb_, int tid, const Raw& R) {
    const int w = __builtin_amdgcn_readfirstlane(tid >> 6), lane = tid & 63, i = lane & 15, q4 = lane >> 4, kb = w >> 1, vh = w & 1;
#pragma unroll
    for (int dir = 0; dir < 2; ++dir) {
        __syncthreads();
        pre_compute<true>(P, h, c, dir, lb_, tid, R);
        f32x4 c0 = {0.f, 0.f, 0.f, 0.f}, c1 = {0.f, 0.f, 0.f, 0.f};
#pragma unroll
        for (int step = 0; step < 4; ++step) {
            const bf16x8 a = *(const bf16x8*)(lb_ + B_KT + (16 * kb + i) * 272 + 16 * q4 + 64 * step);
            const bf16x8 b0 = *(const bf16x8*)(lb_ + B_VT + (32 * vh + i) * 272 + 16 * q4 + 64 * step), b1 = *(const bf16x8*)(lb_ + B_VT + (32 * vh + 16 + i) * 272 + 16 * q4 + 64 * step);
            c0 = HG_MFMA(a, b0, c0); c1 = HG_MFMA(a, b1, c1); }
        const size_t it = st_item(b, h, c, dir); float* L = P.ST + it * 4096;
#pragma unroll
        for (int r = 0; r < 4; ++r) { const int kk = 16 * kb + 4 * q4 + r; WT_STORE(L + kk * 64 + 32 * vh + i, c0[r]); WT_STORE(L + kk * 64 + 32 * vh + 16 + i, c1[r]); }
        if (tid < 64) WT_STORE(P.AC + it * 64 + tid, ((const float*)(lb_ + B_RR))[8 * 64 + tid]);
    }
}
__device__ __forceinline__ void s1_item(const Ptrs& P, int item, unsigned char* lb_, int tid) {
    const int bh = hg_item_bh(item), j = hg_item_j(item), c0 = 2 * j, h = bh & 3, b = bh >> 2; const bool two = c0 + 1 < 33;
    Raw Ra, Rb; pre_load<true>(P, b, h, c0, tid, Ra); pre_load<true>(P, b, h, two ? c0 + 1 : c0, tid, Rb);
    s1_body(P, b, h, c0, lb_, tid, Ra);
    if (two) s1_body(P, b, h, c0 + 1, lb_, tid, Rb);
}

__device__ __forceinline__ void scan(const Ptrs& P, int gid, int nthreads) {
    for (int e = gid; e < 32 * 4096; e += nthreads) {
        const int chain = e >> 12, el = e & 4095, dir = chain & 1, bh = chain >> 1, k = el >> 6;
        float Lv[33], av[33];
#pragma unroll
        for (int cc = 0; cc < 33; ++cc) { const int c = dir ? 32 - cc : cc; const size_t it = (size_t)((bh * 33 + c) * 2 + dir); Lv[cc] = P.ST[it * 4096 + el]; av[cc] = P.AC[it * 64 + k]; }
        float st = 0.f;
#pragma unroll
        for (int cc = 0; cc < 33; ++cc) { const int c = dir ? 32 - cc : cc; const size_t it = (size_t)((bh * 33 + c) * 2 + dir); P.ST[it * 4096 + el] = st; st = av[cc] * st + Lv[cc]; }
    }
}

__device__ __forceinline__ void scan_chain(const Ptrs& P, int chain, int tid) {
    const int dir = chain & 1, bh = chain >> 1;
    for (int j = 0; j < 8; ++j) {
        const int el = tid + 512 * j, k = el >> 6;
        float Lv[33], av[33];
#pragma unroll
        for (int cc = 0; cc < 33; ++cc) { const int c = dir ? 32 - cc : cc; const size_t it = (size_t)((bh * 33 + c) * 2 + dir); Lv[cc] = P.ST[it * 4096 + el]; av[cc] = P.AC[it * 64 + k]; }
        float st = 0.f;
#pragma unroll
        for (int cc = 0; cc < 33; ++cc) { const int c = dir ? 32 - cc : cc; const size_t it = (size_t)((bh * 33 + c) * 2 + dir); WT_STORE(P.ST + it * 4096 + el, st); st = av[cc] * st + Lv[cc]; }
    }
}

struct S3Pre { Raw R; v2u gq[4]; f32x4 sa[2], sb[2]; };
__device__ __forceinline__ void s3_body(const Ptrs& P, const float* outg, bf16* Y, int b, int h, int c, unsigned char* lb_, int tid, const S3Pre& Q) {
    const int w = __builtin_amdgcn_readfirstlane(tid >> 6), lane = tid & 63, i = lane & 15, q4 = lane >> 4;
    const float* RR = (const float*)(lb_ + B_RR);
    f32x4 acc[4];
#pragma unroll
    for (int vb = 0; vb < 4; ++vb) acc[vb] = (f32x4){0.f, 0.f, 0.f, 0.f};
    const Raw& R = Q.R; const int skk = tid >> 3, sv0 = (tid & 7) * 8;
#pragma unroll
    for (int dir = 0; dir < 2; ++dir) {
        __syncthreads();
        { unsigned short* SS = (unsigned short*)(lb_ + B_SS);
#pragma unroll
          for (int j = 0; j < 4; ++j) { SS[(sv0 + j) * 72 + skk] = (unsigned short)f2bf(Q.sa[dir][j]); SS[(sv0 + 4 + j) * 72 + skk] = (unsigned short)f2bf(Q.sb[dir][j]); } }
        pre_compute<false>(P, h, c, dir, lb_, tid, R);
        const int Ib = dir ? 7 - w : w, ip = dir ? 15 - i : i, trow = 16 * Ib + ip;
        float qv[16], ri[16];
        { const bf16x8 qa = *(const bf16x8*)(lb_ + B_QT + trow * 144 + 16 * q4), qb = *(const bf16x8*)(lb_ + B_QT + trow * 144 + 16 * q4 + 64);
#pragma unroll
          for (int j = 0; j < 8; ++j) { qv[j] = bf2f((unsigned short)qa[j]); qv[8 + j] = bf2f((unsigned short)qb[j]); }
          const f32x4 r0 = *(const f32x4*)(RR + Ib * 64 + 8 * q4), r1 = *(const f32x4*)(RR + Ib * 64 + 8 * q4 + 4), r2 = *(const f32x4*)(RR + Ib * 64 + 32 + 8 * q4), r3 = *(const f32x4*)(RR + Ib * 64 + 32 + 8 * q4 + 4);
#pragma unroll
          for (int j = 0; j < 4; ++j) { ri[j] = r0[j]; ri[4 + j] = r1[j]; ri[8 + j] = r2[j]; ri[12 + j] = r3[j]; } }
        { float x[16];
#pragma unroll
          for (int j = 0; j < 16; ++j) x[j] = qv[j] * ri[j];
          const bf16x8 bq0 = pack8(x), bq1 = pack8(x + 8);
#pragma unroll
          for (int vb = 0; vb < 4; ++vb) { const unsigned char* sp = lb_ + B_SS + (16 * vb + i) * 144 + 16 * q4;
              acc[vb] = HG_MFMA(*(const bf16x8*)sp, bq0, acc[vb]); acc[vb] = HG_MFMA(*(const bf16x8*)(sp + 64), bq1, acc[vb]); } }
        const float* TOTc = (const float*)(lb_ + B_TOT);
        float Fq[16];
        { const f32x4 d0 = *(const f32x4*)(TOTc + Ib * 64 + 8 * q4), d1 = *(const f32x4*)(TOTc + Ib * 64 + 8 * q4 + 4), d2 = *(const f32x4*)(TOTc + Ib * 64 + 32 + 8 * q4), d3 = *(const f32x4*)(TOTc + Ib * 64 + 32 + 8 * q4 + 4);
#pragma unroll
          for (int j = 0; j < 4; ++j) { Fq[j] = __builtin_amdgcn_rcpf(fmaxf(d0[j], 1e-37f)); Fq[4 + j] = __builtin_amdgcn_rcpf(fmaxf(d1[j], 1e-37f)); Fq[8 + j] = __builtin_amdgcn_rcpf(fmaxf(d2[j], 1e-37f)); Fq[12 + j] = __builtin_amdgcn_rcpf(fmaxf(d3[j], 1e-37f)); } }
        for (int J0 = Ib & ~1; J0 >= 0; J0 -= 2) {
            u32x4 pbw = {0u, 0u, 0u, 0u};
#pragma unroll
            for (int hb = 1; hb >= 0; --hb) {
                const int J = J0 + hb;
                if (J <= Ib) {
                    float x[16];
#pragma unroll
                    for (int j = 0; j < 16; ++j) x[j] = qv[j] * Fq[j];
                    const bf16x8 bq0 = pack8(x), bq1 = pack8(x + 8);
                    const unsigned char* kp = lb_ + B_KE + (16 * J + i) * 144 + 16 * q4;
                    f32x4 at = {0.f, 0.f, 0.f, 0.f};
                    at = HG_MFMA(*(const bf16x8*)kp, bq0, at); at = HG_MFMA(*(const bf16x8*)(kp + 64), bq1, at);
                    if (J == Ib) {
#pragma unroll
                        for (int r = 0; r < 4; ++r) if (4 * q4 + r > ip) at[r] = 0.f;
#pragma unroll
                        for (int j = 0; j < 16; ++j) Fq[j] = 1.0f;
                    } else {
                        const f32x4 d0 = *(const f32x4*)(TOTc + J * 64 + 8 * q4), d1 = *(const f32x4*)(TOTc + J * 64 + 8 * q4 + 4), d2 = *(const f32x4*)(TOTc + J * 64 + 32 + 8 * q4), d3 = *(const f32x4*)(TOTc + J * 64 + 32 + 8 * q4 + 4);
#pragma unroll
                        for (int j = 0; j < 4; ++j) { Fq[j] *= d0[j]; Fq[4 + j] *= d1[j]; Fq[8 + j] *= d2[j]; Fq[12 + j] *= d3[j]; }
                    }
                    if (hb == 0) { pbw.x = pk2(at[0], at[1]); pbw.y = pk2(at[2], at[3]); } else { pbw.z = pk2(at[0], at[1]); pbw.w = pk2(at[2], at[3]); }
                }
            }
            const int J1 = (J0 + 1 <= Ib) ? J0 + 1 : J0;
            const bf16x8 pb = __builtin_bit_cast(bf16x8, pbw);
#pragma unroll
            for (int vb = 0; vb < 4; ++vb) { const unsigned char* vp = lb_ + B_VT + (16 * vb + i) * 272 + 8 * q4;
                const v2u a0 = *(const v2u*)(vp + 32 * J0), a1 = *(const v2u*)(vp + 32 * J1);
                const u32x4 aw = {a0.x, a0.y, a1.x, a1.y};
                acc[vb] = HG_MFMA(__builtin_bit_cast(bf16x8, aw), pb, acc[vb]); }
        }
    }
    float ss = 0.f;
#pragma unroll
    for (int vb = 0; vb < 4; ++vb) ss += (acc[vb][0] * acc[vb][0] + acc[vb][1] * acc[vb][1]) + (acc[vb][2] * acc[vb][2] + acc[vb][3] * acc[vb][3]);
    ss += __shfl_xor(ss, 16); ss += __shfl_xor(ss, 32);
    const float rn = __builtin_amdgcn_rsqf(ss * (1.0f / 64.0f) + cfg::RMS_EPS);
    const size_t m = (size_t)b * cfg::L + 128 * c + 16 * w + i;
    v2u wv[4];
#pragma unroll
    for (int vb = 0; vb < 4; ++vb) { const int v = 16 * vb + 4 * q4;
        const v2u g = Q.gq[vb]; const f32x4 og = *(const f32x4*)(outg + v);
        const float gg[4] = {bflo(g.x), bfhi(g.x), bflo(g.y), bfhi(g.y)}; float y[4];
#pragma unroll
        for (int r = 0; r < 4; ++r) y[r] = acc[vb][r] * rn * og[r] * (gg[r] * __builtin_amdgcn_rcpf(1.0f + __builtin_amdgcn_exp2f(-cfg::LOG2E * gg[r])));
        wv[vb].x = pk2(y[0], y[1]); wv[vb].y = pk2(y[2], y[3]); }
#pragma unroll
    for (int vb = 0; vb < 4; vb += 2) {
        const auto s0 = __builtin_amdgcn_permlane16_swap(wv[vb].x, wv[vb + 1].x, false, false); const auto s1 = __builtin_amdgcn_permlane16_swap(wv[vb].y, wv[vb + 1].y, false, false);
        u32x4 o; o.x = s0[0]; o.y = s1[0]; o.z = s0[1]; o.w = s1[1];
        *(u32x4*)(Y + m * 1024 + 768 + h * 64 + 16 * vb + ((q4 & 1) ? 16 + 4 * (q4 - 1) : 4 * q4)) = o; }
}
__device__ __forceinline__ void s3_pre(const Ptrs& P, int b, int h, int c, int tid, S3Pre& Q) {
    const int w = __builtin_amdgcn_readfirstlane(tid >> 6), lane = tid & 63, i = lane & 15, q4 = lane >> 4;
    pre_load<false>(P, b, h, c, tid, Q.R);
    const size_t m = (size_t)b * cfg::L + 128 * c + 16 * w + i;
#pragma unroll
    for (int vb = 0; vb < 4; ++vb) Q.gq[vb] = *(const v2u*)(P.DG + m * 256 + h * 64 + 16 * vb + 4 * q4);
}
__device__ __forceinline__ void s3_states(const Ptrs& P, int b, int h, int c, int tid, S3Pre& Q) {
    const int skk = tid >> 3, sv0 = (tid & 7) * 8;
#pragma unroll
    for (int dir = 0; dir < 2; ++dir) { const float* S = P.ST + st_item(b, h, c, dir) * 4096; Q.sa[dir] = *(const f32x4*)(S + skk * 64 + sv0); Q.sb[dir] = *(const f32x4*)(S + skk * 64 + sv0 + 4); }
}
template <class WaitF>
__device__ __forceinline__ void s3_item(const Ptrs& P, const float* outg, bf16* Y, int item, unsigned char* lb_, int tid, WaitF wait_states) {
    const int bh = hg_item_bh(item), j = hg_item_j(item), c0 = 2 * j, h = bh & 3, b = bh >> 2; const bool two = c0 + 1 < 33; const int c1 = two ? c0 + 1 : c0;
    S3Pre Qa, Qb;
    s3_pre(P, b, h, c0, tid, Qa); pre_load<false>(P, b, h, c1, tid, Qb.R);
    wait_states();
    s3_states(P, b, h, c0, tid, Qa);
    s3_body(P, outg, Y, b, h, c0, lb_, tid, Qa);
    if (two) { { const int w = __builtin_amdgcn_readfirstlane(tid >> 6), lane = tid & 63, i = lane & 15, q4 = lane >> 4; const size_t m = (size_t)b * cfg::L + 128 * c1 + 16 * w + i;
#pragma unroll
          for (int vb = 0; vb < 4; ++vb) Qb.gq[vb] = *(const v2u*)(P.DG + m * 256 + h * 64 + 16 * vb + 4 * q4); }
        s3_states(P, b, h, c1, tid, Qb); s3_body(P, outg, Y, b, h, c1, lb_, tid, Qb); }
}
}

constexpr int NWAVES = 8;
#ifndef DIS
#define DIS 0
#endif
#ifndef MK_SPLIT
#define MK_SPLIT 0
#endif
#define LDS_WAIT() asm volatile("s_waitcnt lgkmcnt(0)" ::: "memory")
#define RLX_AGENT __ATOMIC_RELAXED, __HIP_MEMORY_SCOPE_AGENT
constexpr int CW_SCHED = 0, CW_DEP = 1024, CW_BAR = 12288; constexpr size_t CTL_ZERO_BYTES = 65536;
constexpr int MISC_OFF = 131072 + 320;
#ifndef DEP_SPIN
#define DEP_SPIN 1
#endif
#ifndef DEP_ACQ
#define DEP_ACQ 1
#endif
__device__ __forceinline__ void dep_signal(unsigned* cnt, bool t0) {
    asm volatile("s_waitcnt vmcnt(0)" ::: "memory");
    __syncthreads();
    if (t0 && cnt) { const unsigned one = 1u; asm volatile("global_atomic_add %0, %1, off" :: "v"(cnt), "v"(one) : "memory"); }
}
__device__ __forceinline__ void dep_wait(unsigned* cnt, unsigned want, bool t0) {
    if (t0) { unsigned sp = 0;
        while (DEP_SPIN && __hip_atomic_load(cnt, __ATOMIC_RELAXED, __HIP_MEMORY_SCOPE_AGENT) < want) { __builtin_amdgcn_s_sleep(4); if (++sp > (1u << 18)) break; }
        if (DEP_ACQ) { __builtin_amdgcn_fence(__ATOMIC_ACQUIRE, "agent"); asm volatile("s_waitcnt vmcnt(0)" ::: "memory"); } }
    __syncthreads();
}
#ifndef PROBE_QMASK
#define PROBE_QMASK 127
#endif
#ifndef PROBE_REP
#define PROBE_REP 0
#endif
#ifndef USE_XCD_BAR
#define USE_XCD_BAR 1
#endif
#ifndef ATT_PIPE
#define ATT_PIPE 1
#endif
#if ATT_PIPE
#define ATT_UNIT att::attn_unit_p
#else
#define ATT_UNIT att::attn_unit
#endif
#ifndef NAIVE_ATTN
#define NAIVE_ATTN 0
#endif
#define XB_TMO      128
#define XB_XCNT(j)  (256  + 64 * (j))
#define XB_XSUB(j)  (1280 + 64 * (j))
#define XB_XGEN(j)  (2304 + 64 * (j))
#define XB_TOP      3328
#define XB_TOPGEN   3392
#define XCD_BAR_WORDS 3456
#define XB_SPIN_CAP (1u << 18)

__device__ __forceinline__ unsigned xb_ld(unsigned* p)              { return __hip_atomic_load(p, __ATOMIC_RELAXED, __HIP_MEMORY_SCOPE_AGENT); }
__device__ __forceinline__ unsigned xb_add(unsigned* p, unsigned v) { return __hip_atomic_fetch_add(p, v, __ATOMIC_RELAXED, __HIP_MEMORY_SCOPE_AGENT); }
__device__ __forceinline__ unsigned xb_xcc_id() { return (unsigned)__builtin_amdgcn_s_getreg((3 << 11) | 20) & 0xFu; }
#define XB_SPIN(cond, bar) do { unsigned _sp = 0; while (cond) { __builtin_amdgcn_s_sleep(1); \
    if ((++_sp & 255u) == 0u) { if (xb_ld(&(bar)[XB_TMO])) break; if (_sp > XB_SPIN_CAP) { atomicAdd(&(bar)[XB_TMO], 1u); break; } } } } while (0)

struct XcdBarrier {
    unsigned* bar; unsigned x; int t0;
    volatile LAS unsigned* st;
};

__device__ __forceinline__ XcdBarrier xcd_barrier_post(unsigned* bar, volatile LAS unsigned* st) {
    XcdBarrier b; b.bar = bar; b.x = xb_xcc_id(); b.st = st;
    if (threadIdx.x == 0) (void)xb_add(&bar[XB_XCNT(b.x)], 1u);
    return b;
}
__device__ __forceinline__ void xcd_barrier_complete(unsigned* bar, unsigned x, unsigned& nloc, unsigned& nx) {
    const unsigned G = gridDim.x * gridDim.y * gridDim.z;
    unsigned sum, cnt, mine, sp = 0u;
    for (;;) {
        sum = 0u; cnt = 0u; mine = 0u;
#pragma unroll
        for (unsigned j = 0; j < 16; ++j) { const unsigned c = xb_ld(&bar[XB_XCNT(j)]); sum += c; cnt += (c > 0u) ? 1u : 0u; mine = (j == x) ? c : mine; }
        if (sum == G) break;
        __builtin_amdgcn_s_sleep(1);
        if ((++sp & 255u) == 0u) { if (xb_ld(&bar[XB_TMO])) break; if (sp > XB_SPIN_CAP) { atomicAdd(&bar[XB_TMO], 1u); break; } }
    }
    nloc = mine > 0u ? mine : 1u; nx = cnt > 0u ? cnt : 1u;
}

__device__ __forceinline__ void xcd_barrier(const XcdBarrier& b) {
    asm volatile("s_waitcnt vmcnt(0)" ::: "memory");
    __syncthreads();
    if (b.t0) {
        unsigned* bar = b.bar;
        __builtin_amdgcn_s_waitcnt(0);
        unsigned nloc = b.st[0], nx = b.st[1];
        if (nloc == 0u) { xcd_barrier_complete(bar, b.x, nloc, nx); b.st[0] = nloc; b.st[1] = nx; }
        const unsigned old = xb_add(&bar[XB_XSUB(b.x)], 1u);
        const unsigned gen = old / nloc;
        if (old + 1u == (gen + 1u) * nloc) {
            __builtin_amdgcn_fence(__ATOMIC_RELEASE, "agent");
            asm volatile("s_waitcnt vmcnt(0)" ::: "memory");
            const unsigned og = xb_add(&bar[XB_TOP], 1u);
            const unsigned tg = og / nx;
            if (og + 1u == (tg + 1u) * nx) xb_add(&bar[XB_TOPGEN], 1u);
            else XB_SPIN(xb_ld(&bar[XB_TOPGEN]) == tg, bar);
            __builtin_amdgcn_fence(__ATOMIC_ACQUIRE, "agent");
            xb_add(&bar[XB_XGEN(b.x)], 1u);
            asm volatile("s_waitcnt vmcnt(0)" ::: "memory");
        } else {
            XB_SPIN(xb_ld(&bar[XB_XGEN(b.x)]) == gen, bar);
            __builtin_amdgcn_fence(__ATOMIC_ACQUIRE, "agent");
            asm volatile("s_waitcnt vmcnt(0)" ::: "memory");
        }
    }
    __syncthreads();
}
using cfg::T; using cfg::L;

struct Args { const float* in[19]; float* out; unsigned char* ws; int ph_lo, ph_hi; };
typedef const __attribute__((address_space(4))) Args* CArgs;
__device__ __forceinline__ CArgs phase_args() { CArgs p = (CArgs)__builtin_amdgcn_kernarg_segment_ptr(); asm volatile("" : "+s"(p)); return p; }

__device__ __forceinline__ float wave_sum(float v) {
#pragma unroll
    for (int o = 1; o < 64; o <<= 1) v += __shfl_xor(v, o);
    return v;
}

struct RmId { __device__ __forceinline__ int operator()(int n) const { return n; } };
struct RmW1 { __device__ __forceinline__ int operator()(int n) const { const int pn = n >> 8, cc = n & 255; return pn < 6 ? (pn << 8) + 128 * ((cc & 63) >> 5) + 32 * (cc >> 6) + (cc & 31) : n; } };
struct RmGU { int half; __device__ __forceinline__ int operator()(int j) const { return ((j >> 7) << 8) + half * 128 + (j & 127); } };
__device__ __forceinline__ void transpose_load(const float* W, int N, const float* gain, int nblk, int item, int lane, float (&wv)[32], float (&gv)[32]) {
    const int kb = item / nblk, nb = item % nblk, k0 = 64 * kb, n0 = 32 * nb;
#pragma unroll
    for (int i = 0; i < 32; ++i) wv[i] = W[(size_t)(k0 + 2 * i + (lane >> 5)) * N + n0 + (lane & 31)];
    if (gain) {
#pragma unroll
        for (int i = 0; i < 32; ++i) gv[i] = gain[k0 + 2 * i + (lane >> 5)];
    }
}
template <class RowMap>
__device__ __forceinline__ void transpose_finish(int K, bf16* WT, bool hasgain, RowMap rm, LAS float* scr, int nblk, int item, int lane, const float (&wv)[32], const float (&gv)[32]) {
    const int kb = item / nblk, nb = item % nblk, k0 = 64 * kb, n0 = 32 * nb;
#pragma unroll
    for (int i = 0; i < 32; ++i) scr[(2 * i + (lane >> 5)) * 33 + (lane & 31)] = hasgain ? wv[i] * gv[i] : wv[i];
    LDS_WAIT(); asm volatile("" ::: "memory");
    const int c = lane & 7;
#pragma unroll
    for (int j = 0; j < 4; ++j) { const int n = (lane >> 3) + 8 * j; const LAS float* s = scr + (8 * c) * 33 + n;
        v4u o; o.x = pk2(s[0 * 33], s[1 * 33]); o.y = pk2(s[2 * 33], s[3 * 33]); o.z = pk2(s[4 * 33], s[5 * 33]); o.w = pk2(s[6 * 33], s[7 * 33]);
        *(v4u*)(WT + (size_t)rm(n0 + n) * K + k0 + 8 * c) = o; }
    LDS_WAIT(); asm volatile("" ::: "memory");
}
template <class RowMap>
__device__ __forceinline__ void transpose_run(const float* W, int K, int N, bf16* WT, const float* gain, RowMap rm, LAS float* scr, int first, int count, int stride, int lane) {
    const int nblk = N / 32; const bool hg_ = gain != nullptr;
    float a[32], ga[32], b[32], gb[32];
    if (count > 0) transpose_load(W, N, gain, nblk, first, lane, a, ga);
    for (int j = 0; j < count; j += 2) {
        const bool two = j + 1 < count;
        if (two) transpose_load(W, N, gain, nblk, first + (j + 1) * stride, lane, b, gb);
        transpose_finish(K, WT, hg_, rm, scr, nblk, first + j * stride, lane, a, ga);
        if (two) { if (j + 2 < count) transpose_load(W, N, gain, nblk, first + (j + 2) * stride, lane, a, ga);
            transpose_finish(K, WT, hg_, rm, scr, nblk, first + (j + 1) * stride, lane, b, gb); }
    }
}

__device__ __forceinline__ int t5_bucket(int rel) {
    const int n = rel < 0 ? -rel : rel;
    int v = n;
    if (n >= 8) { const int j = 31 - __builtin_clz((unsigned)(n * n)) - 6; v = 8 + j; v = v > 15 ? 15 : v; }
    return (rel > 0 ? 16 : 0) + v;
}

constexpr int W_I1 = 16 * (cfg::NIN / 32), W_IB = 16 * 32, W_IO = 16 * 32, W_IG = 16 * (cfg::DFF / 32), W_IU = W_IG, W_ID = (cfg::DFF / 64) * 32, W_NITEMS = W_I1 + W_IB + W_IO + W_IG + W_IU + W_ID;
__device__ __forceinline__ void w_run(CArgs ap, int l, int r, int count, int stride, LAS float* scr, int lane) {
    unsigned char* ws = ap->ws;
    if (r < W_I1) { transpose_run(ap->in[5] + (size_t)l * 1024 * cfg::NIN, 1024, cfg::NIN, (bf16*)(ws + cfg::WS_W1), ap->in[4] + l * 1024, RmW1{}, scr, r, count, stride, lane); return; } r -= W_I1;
    if (r < W_IB) { transpose_run(ap->in[12] + (size_t)l * 1024 * 1024, 1024, 1024, (bf16*)(ws + cfg::WS_WB), nullptr, RmId{}, scr, r, count, stride, lane); return; } r -= W_IB;
    if (r < W_IO) { transpose_run(ap->in[13] + (size_t)l * 1024 * 1024, 1024, 1024, (bf16*)(ws + cfg::WS_WO), nullptr, RmId{}, scr, r, count, stride, lane); return; } r -= W_IO;
    if (r < W_IG) { transpose_run(ap->in[15] + (size_t)l * 1024 * cfg::DFF, 1024, cfg::DFF, (bf16*)(ws + cfg::WS_WGU), ap->in[14] + l * 1024, RmGU{0}, scr, r, count, stride, lane); return; } r -= W_IG;
    if (r < W_IU) { transpose_run(ap->in[16] + (size_t)l * 1024 * cfg::DFF, 1024, cfg::DFF, (bf16*)(ws + cfg::WS_WGU), ap->in[14] + l * 1024, RmGU{1}, scr, r, count, stride, lane); return; } r -= W_IU;
    transpose_run(ap->in[17] + (size_t)l * cfg::DFF * 1024, cfg::DFF, 1024, (bf16*)(ws + cfg::WS_WD), nullptr, RmId{}, scr, r, count, stride, lane);
}
__device__ __forceinline__ void w_gains(CArgs ap, int l, int lane) { float* qkg = (float*)(ap->ws + cfg::WS_TAB + cfg::TAB_QKG); qkg[lane] = ap->in[7][l * 64 + lane]; qkg[64 + lane] = ap->in[8][l * 64 + lane]; }
__device__ __forceinline__ void phase_w(CArgs ap, int l, LAS unsigned char* lds, int gw, int NGW, int wave, int lane) {
    LAS float* scr = (LAS float*)(lds + wave * 16384);
    if (gw == 0) w_gains(ap, l, lane);
    if (gw < W_I1) w_run(ap, l, gw, (W_I1 - gw + NGW - 1) / NGW, NGW, scr, lane);
}

__device__ __forceinline__ void phase_init(CArgs ap, int gw, int NGW, int lane, int tid) {
    unsigned char* ws = ap->ws;
    bf16* hb = (bf16*)(ws + cfg::WS_HB); float* ssq = (float*)(ws + cfg::WS_SSQ);
    typedef float f4 __attribute__((ext_vector_type(4)));
    for (int m0 = gw; m0 < T; m0 += 3 * NGW) {
        f4 v[3][4];
#pragma unroll
        for (int u = 0; u < 3; ++u) {
            const int m = m0 + u * NGW < T ? m0 + u * NGW : T - 1; const int b = m / L, pos = m - b * L;
            const float* src = pos < cfg::MEND ? ap->in[1] + (size_t)(pos < cfg::FRONT ? 0 : pos - cfg::FRONT) * 1024 : ap->in[0] + (size_t)(b * cfg::SEQ + pos - cfg::MEND) * 1024;
#pragma unroll
            for (int j = 0; j < 4; ++j) v[u][j] = ((const f4*)src)[64 * j + lane];
        }
#pragma unroll
        for (int u = 0; u < 3; ++u) {
            const int m = m0 + u * NGW;
            if (m < T) {
                const int b = m / L, pos = m - b * L;
                if (pos < cfg::FRONT) {
#pragma unroll
                    for (int j = 0; j < 4; ++j) v[u][j] = (f4){0.f, 0.f, 0.f, 0.f}; }
                float s = 0.f;
#pragma unroll
                for (int j = 0; j < 4; ++j) s += (v[u][j][0] * v[u][j][0] + v[u][j][1] * v[u][j][1]) + (v[u][j][2] * v[u][j][2] + v[u][j][3] * v[u][j][3]);
                s = wave_sum(s);
#pragma unroll
                for (int j = 0; j < 4; ++j) { v2u w; w.x = pk2(v[u][j][0], v[u][j][1]); w.y = pk2(v[u][j][2], v[u][j][3]); ((v2u*)(hb + (size_t)m * 1024))[64 * j + lane] = w; }
                if (lane < 16) ssq[(size_t)m * 16 + lane] = lane == 0 ? s : 0.f;
            }
        }
    }
    {
        float* tab = (float*)(ws + cfg::WS_TAB);
        float* rt = tab + cfg::TAB_RT / 4; float* luta = tab + cfg::TAB_LUTA / 4; float* lutc = tab + cfg::TAB_LUTC / 4; float* lbt = tab + cfg::TAB_LB / 4; float* lam = tab + cfg::TAB_LAM / 4;
        for (int j = (int)blockIdx.x * 512 + tid; j < 1040 + 1028 + 1024 + 2; j += (int)gridDim.x * 512) {
            if (j < 1040) { const int idx = j, v = idx / 16 - 1, i = idx % 16; const float inv = powf(10000.0f, -(float)i / 16.0f); const float ang = (float)v * inv; rt[idx * 2] = cosf(ang); rt[idx * 2 + 1] = sinf(ang); }
            else if (j < 2068) { const int idx = j - 1040, rel = idx / 4 - 128, hh = idx % 4, bk = t5_bucket(rel);
                luta[idx] = ap->in[2][bk * 8 + hh] * cfg::LOG2E; lutc[idx] = ap->in[2][bk * 8 + 4 + hh] * cfg::LOG2E; }
            else if (j < 3092) { const int idx = j - 2068, l_ = idx >> 9, dir = (idx >> 8) & 1, k = idx & 255;
                const float a0 = ap->in[3][(dir * 2 + 0) * 256 + k], a1 = ap->in[3][(dir * 2 + 1) * 256 + k];
                lbt[idx] = l_ == 0 ? 0.0f : 1.0f / (1.0f + expf(a0 - a1)); }
            else { const int t_ = j - 3092; const float* lp = ap->in[9] + t_ * 128; float s1 = 0.f, s2 = 0.f; for (int d = 0; d < 32; ++d) { s1 += lp[d] * lp[32 + d]; s2 += lp[64 + d] * lp[96 + d]; }
                const float init = 0.8f - 0.6f * expf(-0.3f * (float)t_); lam[t_ * 2] = expf(s1) - expf(s2) + init; lam[t_ * 2 + 1] = init; }
        }
    }
}

template <int MODE>
__device__ __forceinline__ void naive_attn_item(CArgs ap, int l, int item, float* lds, int tid) {
    unsigned char* ws = ap->ws;
    const float* tab = (const float*)(ws + cfg::WS_TAB);
    const float* lut = tab + (MODE == 0 ? cfg::TAB_LUTA : cfg::TAB_LUTC) / 4;
    const unsigned char* mb = ws + cfg::WS_QKV + (size_t)MODE * cfg::QKV_MIX;
    const bf16* Qg = (const bf16*)mb; const bf16* Kg = (const bf16*)(mb + (size_t)T * 512); const bf16* Vg = (const bf16*)(mb + (size_t)T * 768);
    bf16* Y = (bf16*)ap->out;
    constexpr int QD = (MODE == 2) ? 32 : 64;
    int b, qb, hp = 0;
    if (MODE == 2) { hp = item & 1; qb = (item >> 1) % 33; b = (item >> 1) / 33; } else { qb = item % 33; b = item / 33; }
    const int gc = tid >> 7, i = tid & 127;
    int h, kvh, kofs;
    if (MODE == 2) { const int g = gc >> 1, c = gc & 1; h = 2 * hp + g; kvh = hp; kofs = kvh * 64 + 32 * c; }
    else { h = gc; kvh = h >> 1; kofs = kvh * 64; }
    const int pos = qb * 128 + i, m = b * L + pos;
    float* Ks = lds; float* Vs = lds + 64 * 128;
    float q[QD], o[64];
    { const bf16* qp = Qg + (size_t)m * 256 + h * 64 + (MODE == 2 ? 32 * (gc & 1) : 0);
#pragma unroll
      for (int d = 0; d < QD; d += 2) { const unsigned w = *(const unsigned*)(qp + d); q[d] = bflo(w); q[d + 1] = bfhi(w); } }
#pragma unroll
    for (int d = 0; d < 64; ++d) o[d] = 0.f;
    float mx = -1e30f, lsum = 0.f;
    int ktlo, nwin, ntiles;
    if (MODE == 0) { ktlo = 2 * qb - 2; if (ktlo < 2) ktlo = 2; int kthi = 2 * qb + 3; if (kthi > 65) kthi = 65; nwin = kthi - ktlo + 1; ntiles = nwin + 1; }
    else { ktlo = 1; nwin = 65; ntiles = 65; }
    for (int it = 0; it < ntiles; ++it) {
        const int kt = it < nwin ? ktlo + it : 1; const bool window = (MODE == 0) && it < nwin;
        __syncthreads();
        { const int j = tid >> 3, cc = (tid & 7) * 16; const size_t ro = (size_t)(b * L + kt * 64 + j) * 128 + cc;
          const v4u k0 = *(const v4u*)(Kg + ro), k1 = *(const v4u*)(Kg + ro + 8), v0 = *(const v4u*)(Vg + ro), v1 = *(const v4u*)(Vg + ro + 8);
          float* kd = Ks + j * 128 + cc; float* vd = Vs + j * 128 + cc;
#pragma unroll
          for (int e = 0; e < 4; ++e) { kd[2 * e] = bflo(k0[e]); kd[2 * e + 1] = bfhi(k0[e]); kd[8 + 2 * e] = bflo(k1[e]); kd[9 + 2 * e] = bfhi(k1[e]);
                                        vd[2 * e] = bflo(v0[e]); vd[2 * e + 1] = bfhi(v0[e]); vd[8 + 2 * e] = bflo(v1[e]); vd[9 + 2 * e] = bfhi(v1[e]); } }
        __syncthreads();
        for (int j = 0; j < 64; ++j) {
            const int kpos = kt * 64 + j;
            if (kpos < cfg::FRONT) continue;
            const int rel = kpos - pos;
            bool ok = true; float s = 0.f;
            if (MODE != 1) { const int cl = rel < -128 ? -128 : (rel > 128 ? 128 : rel); s = lut[(cl + 128) * 4 + h]; }
            if (window) ok = (rel >= -128) && (rel <= 128);
            const float* kr = Ks + j * 128 + kofs;
#pragma unroll
            for (int d = 0; d < QD; ++d) s += q[d] * kr[d];
            if (ok) {
                if (s > mx) { const float f = fexp2(mx - s); lsum *= f;
#pragma unroll
                    for (int d = 0; d < 64; ++d) o[d] *= f;
                    mx = s; }
                const float p = fexp2(s - mx); lsum += p;
                const float* vr = Vs + j * 128 + kvh * 64;
#pragma unroll
                for (int d = 0; d < 64; ++d) o[d] += p * vr[d];
            }
        }
    }
    if (MODE == 0) {
        const float s = ap->in[6][l * 4 + h] * cfg::LOG2E;
        if (s > mx) { const float f = fexp2(mx - s); lsum *= f;
#pragma unroll
            for (int d = 0; d < 64; ++d) o[d] *= f;
            mx = s; }
        lsum += fexp2(s - mx);
    }
    const float inv = 1.0f / lsum;
    if (MODE != 2) {
        bf16* yp = Y + (size_t)m * 1024 + (MODE == 0 ? 0 : 256) + h * 64;
#pragma unroll
        for (int d = 0; d < 64; d += 2) *(unsigned*)(yp + d) = pk2(o[d] * inv, o[d + 1] * inv);
    } else {
        const int g = gc >> 1, c = gc & 1;
        float* Ox = lds;
        __syncthreads();
        if (c == 1) { float* op = Ox + (size_t)(g * 128 + i) * 65;
#pragma unroll
            for (int d = 0; d < 64; ++d) op[d] = o[d] * inv; }
        __syncthreads();
        if (c == 0) {
            const float lam = tab[cfg::TAB_LAM / 4 + 2 * l], lam_init = tab[cfg::TAB_LAM / 4 + 2 * l + 1];
            const float* op = Ox + (size_t)(g * 128 + i) * 65; const float* sg = ap->in[10] + l * 64;
            float ss = 0.f;
#pragma unroll
            for (int d = 0; d < 64; ++d) { o[d] = o[d] * inv - lam * op[d]; ss += o[d] * o[d]; }
            const float r = __builtin_amdgcn_rsqf(ss * (1.0f / 64.0f) + cfg::RMS_EPS) * (1.0f - lam_init);
            bf16* yp = Y + (size_t)m * 1024 + 512 + h * 64;
#pragma unroll
            for (int d = 0; d < 64; d += 2) *(unsigned*)(yp + d) = pk2(o[d] * r * sg[d], o[d + 1] * r * sg[d + 1]);
        }
    }
}

__device__ __forceinline__ void hgrn_chain_item(CArgs ap, int l, int item, float* lds, int tid) {
    unsigned char* ws = ap->ws;
    const int dir = item & 1, h = (item >> 1) & 3, b = item >> 3;
    const float* lbt = (const float*)(ws + cfg::WS_TAB) + cfg::TAB_LB / 4 + (l * 2 + dir) * 256 + h * 64;
    const bf16* DQ = (const bf16*)(ws + cfg::WS_D); const bf16* Z = (const bf16*)(ws + cfg::WS_D + (size_t)(1 + dir) * cfg::D_ARR); const bf16* DI = (const bf16*)(ws + cfg::WS_D + 3 * cfg::D_ARR);
    bf16* O = (bf16*)(ws + cfg::WS_OFB + (size_t)dir * cfg::D_ARR);
    float* fS = lds; float* kS = lds + 1024; float* qS = lds + 2048; float* vS = lds + 3072; float* po = lds + 4096;
    const int kg = tid >> 6, v = tid & 63;
    float S[8];
#pragma unroll
    for (int i2 = 0; i2 < 8; ++i2) S[i2] = 0.f;
    constexpr int NB = L / 16;
    unsigned short zr[2], qr[2], vr[2];
    const int stt[2] = {tid >> 6, (tid >> 6) + 8}; const int sk = tid & 63;
#define HG_LOAD(bi) do { _Pragma("unroll") for (int e = 0; e < 2; ++e) { const int s_ = 16 * (bi) + stt[e]; const int pos_ = dir ? L - 1 - s_ : s_; const size_t off_ = (size_t)(b * L + pos_) * 256 + h * 64 + sk; \
        zr[e] = Z[off_]; qr[e] = DQ[off_]; vr[e] = DI[off_]; } } while (0)
#define HG_STAGE(bi) do { _Pragma("unroll") for (int e = 0; e < 2; ++e) { const int s_ = 16 * (bi) + stt[e]; const int pos_ = dir ? L - 1 - s_ : s_; \
        const float z_ = bf2f(zr[e]), ez_ = __expf(-z_), sg_ = 1.0f / (1.0f + ez_), sn_ = ez_ * sg_, lb_ = lbt[sk]; \
        fS[stt[e] * 64 + sk] = lb_ + (1.0f - lb_) * sg_; kS[stt[e] * 64 + sk] = pos_ >= cfg::FRONT ? (1.0f - lb_) * sn_ : 0.0f; qS[stt[e] * 64 + sk] = bf2f(qr[e]); vS[stt[e] * 64 + sk] = bf2f(vr[e]); } } while (0)
    __syncthreads();
    HG_LOAD(0); HG_STAGE(0);
    __syncthreads();
    typedef float f4 __attribute__((ext_vector_type(4)));
    for (int bi = 0; bi < NB; ++bi) {
        if (bi + 1 < NB) HG_LOAD(bi + 1);
#pragma unroll
        for (int tt = 0; tt < 16; ++tt) {
            const f4 f0 = *(const f4*)(fS + tt * 64 + kg * 8), f1 = *(const f4*)(fS + tt * 64 + kg * 8 + 4);
            const f4 k0 = *(const f4*)(kS + tt * 64 + kg * 8), k1 = *(const f4*)(kS + tt * 64 + kg * 8 + 4);
            const f4 q0 = *(const f4*)(qS + tt * 64 + kg * 8), q1 = *(const f4*)(qS + tt * 64 + kg * 8 + 4);
            const float vv = vS[tt * 64 + v];
            float acc = 0.f;
#pragma unroll
            for (int i2 = 0; i2 < 4; ++i2) { S[i2] = f0[i2] * S[i2] + k0[i2] * vv; acc += q0[i2] * S[i2]; }
#pragma unroll
            for (int i2 = 0; i2 < 4; ++i2) { S[4 + i2] = f1[i2] * S[4 + i2] + k1[i2] * vv; acc += q1[i2] * S[4 + i2]; }
            po[(tt * 8 + kg) * 64 + v] = acc;
        }
        __syncthreads();
#pragma unroll
        for (int e = 0; e < 2; ++e) { const int s_ = 16 * bi + stt[e]; const int pos_ = dir ? L - 1 - s_ : s_;
            float sum = 0.f;
#pragma unroll
            for (int g8 = 0; g8 < 8; ++g8) sum += po[(stt[e] * 8 + g8) * 64 + sk];
            O[(size_t)(b * L + pos_) * 256 + h * 64 + sk] = (bf16)f2bf(sum); }
        if (bi + 1 < NB) HG_STAGE(bi + 1);
        __syncthreads();
    }
#undef HG_LOAD
#undef HG_STAGE
}

__device__ __forceinline__ void phase_hgrn_post(CArgs ap, int l, int gw, int NGW, int lane) {
    unsigned char* ws = ap->ws;
    const bf16* OF = (const bf16*)(ws + cfg::WS_OFB); const bf16* OB = (const bf16*)(ws + cfg::WS_OFB + cfg::D_ARR); const bf16* DG = (const bf16*)(ws + cfg::WS_D + 4 * cfg::D_ARR);
    bf16* Y = (bf16*)ap->out;
    const float* og = ap->in[11] + l * 64 + ((4 * lane) & 63);
    for (int m = gw; m < T; m += NGW) {
        const size_t off = (size_t)m * 256 + 4 * lane;
        const v2u f = *(const v2u*)(OF + off), bb = *(const v2u*)(OB + off), g = *(const v2u*)(DG + off);
        float o[4] = {bflo(f.x) + bflo(bb.x), bfhi(f.x) + bfhi(bb.x), bflo(f.y) + bflo(bb.y), bfhi(f.y) + bfhi(bb.y)};
        const float gg[4] = {bflo(g.x), bfhi(g.x), bflo(g.y), bfhi(g.y)};
        float ss = (o[0] * o[0] + o[1] * o[1]) + (o[2] * o[2] + o[3] * o[3]);
        ss += __shfl_xor(ss, 1); ss += __shfl_xor(ss, 2); ss += __shfl_xor(ss, 4); ss += __shfl_xor(ss, 8);
        const float r = __builtin_amdgcn_rsqf(ss * (1.0f / 64.0f) + cfg::RMS_EPS);
        float y[4];
#pragma unroll
        for (int j = 0; j < 4; ++j) y[j] = o[j] * r * og[j] * (gg[j] / (1.0f + __expf(-gg[j])));
        v2u w; w.x = pk2(y[0], y[1]); w.y = pk2(y[2], y[3]);
        *(v2u*)(Y + (size_t)m * 1024 + 768 + 4 * lane) = w;
    }
}

__device__ __forceinline__ void phase_final(CArgs ap, int gw, int NGW, int lane) {
    typedef float f4 __attribute__((ext_vector_type(4)));
    const f4* gl = (const f4*)ap->in[18]; const bf16* hb = (const bf16*)(ap->ws + cfg::WS_HB);
    f4 g[4];
#pragma unroll
    for (int j = 0; j < 4; ++j) g[j] = gl[64 * j + lane];
    constexpr int NR = cfg::BATCH * cfg::SEQ;
    for (int r = gw; r < NR; r += NGW) {
        const int b = r / cfg::SEQ, s_ = r - b * cfg::SEQ; const v2u* src = (const v2u*)(hb + (size_t)(b * cfg::L + cfg::MEND + s_) * 1024);
        f4 v[4];
#pragma unroll
        for (int j = 0; j < 4; ++j) { const v2u w = src[64 * j + lane]; v[j] = (f4){bflo(w.x), bfhi(w.x), bflo(w.y), bfhi(w.y)}; }
        float s = 0.f;
#pragma unroll
        for (int j = 0; j < 4; ++j) s += (v[j][0] * v[j][0] + v[j][1] * v[j][1]) + (v[j][2] * v[j][2] + v[j][3] * v[j][3]);
        const float rs = __builtin_amdgcn_rsqf(wave_sum(s) * (1.0f / 1024.0f) + cfg::RMS_EPS);
        f4* row = (f4*)(ap->out + (size_t)r * 1024);
#pragma unroll
        for (int j = 0; j < 4; ++j) row[64 * j + lane] = v[j] * rs * g[j];
    }
}

constexpr int PH_PER_LAYER = 9, PH_FINAL = 18, N_PHASES = 19;
__global__ void __launch_bounds__(NWAVES * 64, 2) enc_fwd(Args a_unused) {
    extern __shared__ __attribute__((aligned(16))) unsigned char lds[];
    LAS unsigned char* ldsl = (LAS unsigned char*)lds;
    const int G = gridDim.x, bx = blockIdx.x, NGW = G * NWAVES;
    const int wave0 = __builtin_amdgcn_readfirstlane(threadIdx.x >> 6);
#define TIDS() unsigned z_ = 0u; asm volatile("" : "+v"(z_)); int tid = (wave0 << 6) | (int)__builtin_amdgcn_mbcnt_hi(~0u, __builtin_amdgcn_mbcnt_lo(~0u, z_));     \
    int bxl = bx; asm volatile("" : "+s"(bxl)); const int lane = tid & 63, wave = __builtin_amdgcn_readfirstlane(tid >> 6), gw = bxl * NWAVES + wave; (void)lane; (void)gw
    int lo, hi; { CArgs ap = phase_args(); lo = ap->ph_lo; hi = ap->ph_hi; }
#define IN(k) (lo <= (k) && (k) < hi)
#define HG_PTRS() const float* lbt_ = (const float*)(ws + cfg::WS_TAB + cfg::TAB_LB) + l * 512; \
    hg::Ptrs HP{(const bf16*)(ws + cfg::WS_D), (const bf16*)(ws + cfg::WS_D + cfg::D_ARR), (const bf16*)(ws + cfg::WS_D + 2 * cfg::D_ARR), (const bf16*)(ws + cfg::WS_D + 3 * cfg::D_ARR), (const bf16*)(ws + cfg::WS_D + 4 * cfg::D_ARR), \
                lbt_, lbt_ + 256, (float*)(ws + cfg::WS_OFB), (float*)(ws + cfg::WS_TAB + 65536)}
    for (int u = threadIdx.x; u < (cfg::LDS_BYTES - 131072) / 4; u += NWAVES * 64) ((LAS unsigned*)(ldsl + 131072))[u] = 0u;
    __syncthreads();
#if MK_SPLIT
#define GRID_BAR(k) do {} while (0)
#else
    cg::grid_group grid = cg::this_grid();
#if USE_XCD_BAR
    { CArgs ap = phase_args(); (void)xcd_barrier_post((unsigned*)ap->ws + CW_BAR, (volatile LAS unsigned*)(ldsl + MISC_OFF) + 8); }
#define GRID_BAR(k) do { { CArgs ap_ = phase_args(); XcdBarrier b_; b_.bar = (unsigned*)ap_->ws + CW_BAR; b_.x = xb_xcc_id(); { unsigned z_ = 0u; asm volatile("" : "+v"(z_)); b_.t0 = (wave0 == 0) && (__builtin_amdgcn_mbcnt_hi(~0u, __builtin_amdgcn_mbcnt_lo(~0u, z_)) == 0u); } b_.st = (volatile LAS unsigned*)(ldsl + MISC_OFF) + 8; xcd_barrier(b_); } } while (0)
#else
#define GRID_BAR(k) grid.sync()
#endif
#endif
#define SEAM(k) do { if (IN(k) && IN((k) + 1)) GRID_BAR(k); } while (0)
    for (int l = 0; l < cfg::DEPTH; ++l) {
        const int p0 = l * PH_PER_LAYER;
        if (l == 0 && IN(p0 + 0) && !(DIS & 1)) for (int rep_ = 0; rep_ < 1 + ((PROBE_REP >> 0) & 1); ++rep_) { if (rep_) GRID_BAR(1); TIDS(); CArgs ap = phase_args(); phase_w(ap, l, ldsl, gw, NGW, wave, lane); phase_init(ap, gw, NGW, lane, tid); }
        if (l == 0) SEAM(p0 + 0);
        if (IN(p0 + 1) && !(DIS & 2)) for (int rep_ = 0; rep_ < 1 + ((PROBE_REP >> 1) & 1); ++rep_) { if (rep_) GRID_BAR(1);
            TIDS(); CArgs ap = phase_args(); unsigned char* ws = ap->ws;
            pg8::Gemm g{(const bf16*)(ws + cfg::WS_HB), (const bf16*)(ws + cfg::WS_W1), T, cfg::NIN, 1024}; pg8::StaticOrder S; S.init(T, cfg::NIN, G, bxl);
            pg8::build_rstd_tables(S, (const float*)(ws + cfg::WS_SSQ), (LAS float*)(ldsl + pg8::RSTD_LDS_OFF), tid);
            pg8::Epi1 E{ws};
            pg8::gemm_phase<pg8::Epi1, pg8::StaticOrder, true, true>(ldsl, g, S, E, tid);
        }
        SEAM(p0 + 1);
        if (IN(p0 + 2) && !(DIS & 4)) for (int rep_ = 0; rep_ < 1 + ((PROBE_REP >> 2) & 1); ++rep_) { if (rep_) GRID_BAR(1);
            TIDS(); CArgs ap = phase_args(); unsigned char* ws = ap->ws;
#if NAIVE_ATTN
            constexpr int NI = 32 + 132 + 132 + 264;
            for (int it = bxl; it < NI; it += G) {
                __syncthreads();
                if (it < 32) hgrn_chain_item(ap, l, it, (float*)lds, tid);
                else if (it < 164) naive_attn_item<0>(ap, l, it - 32, (float*)lds, tid);
                else if (it < 296) naive_attn_item<1>(ap, l, it - 164, (float*)lds, tid);
                else naive_attn_item<2>(ap, l, it - 296, (float*)lds, tid);
            }
#else
            constexpr int CV1 = W_I1 / 64, CV2 = (W_NITEMS - W_I1) / 64;
            const int NCV = (l == 0) ? CV1 + CV2 : CV2;
            const int NH = 272, Q_SC = NH, Q_C = Q_SC + 32, Q_B = Q_C + 528, Q_CV = Q_B + 264, Q_A = Q_CV + NCV, Q_S3 = Q_A + 264, NI = Q_S3 + 272;
            volatile LAS unsigned* nxt = (volatile LAS unsigned*)(ldsl + MISC_OFF) + 16;
            const bool t0 = (tid == 0);
            unsigned nx = 0u; const unsigned one_ = 1u;
            if (t0) { CArgs ap3 = phase_args(); unsigned* hp_ = (unsigned*)ap3->ws + CW_SCHED + 64 * l + 128 * rep_; asm volatile("global_atomic_add %0, %1, %2, off sc0" : "=v"(nx) : "v"(hp_), "v"(one_) : "memory"); }
            { float* lutl = (float*)(lds + att::LDS_LUT); const float* tab = (const float*)(ws + cfg::WS_TAB);
              for (int i = tid; i < 1028; i += 512) { const int d_ = (i & 3) * 260 + (i >> 2); lutl[d_] = tab[cfg::TAB_LUTC / 4 + i]; lutl[1088 + d_] = tab[cfg::TAB_LUTA / 4 + i]; }
              if (tid < 64) { CArgs ap4 = phase_args(); lutl[2176 + tid] = ap4->in[10][l * 64 + tid]; lutl[2240 + tid] = ap4->in[11][l * 64 + tid]; if (tid < 4) lutl[2304 + tid] = ap4->in[6][l * 4 + tid]; } }
            for (;;) {
                if (t0) { asm volatile("s_waitcnt vmcnt(0)" : "+v"(nx) :: "memory"); *nxt = nx; }
                __syncthreads();
                int it = __builtin_amdgcn_readfirstlane((int)*nxt); asm volatile("" : "+s"(it));
                __syncthreads();
                if (it >= NI) break;
                if (t0) { CArgs ap3 = phase_args(); unsigned* hp_ = (unsigned*)ap3->ws + CW_SCHED + 64 * l + 128 * rep_; asm volatile("global_atomic_add %0, %1, %2, off sc0" : "=v"(nx) : "v"(hp_), "v"(one_) : "memory"); }
                int tq = tid; asm volatile("" : "+v"(tq));
                CArgs ap2 = phase_args(); unsigned char* ws = ap2->ws;
                unsigned* dep = (unsigned*)ws + CW_DEP + (l * 16) * 128 + rep_ * 4096;
#if PROBE_REP
                if (rep_ && !((PROBE_QMASK >> (it < NH ? 0 : it < Q_C ? 5 : it < Q_B ? 2 : it < Q_CV ? 1 : it < Q_A ? 4 : it < Q_S3 ? 3 : 6)) & 1)) continue;
#endif
                unsigned* sig = nullptr;
                if (it < NH) { HG_PTRS(); hg::s1_item(HP, it, (unsigned char*)lds, tq); sig = dep + hg::hg_item_bh(it) * 128; }
                else if (it >= Q_C && it < Q_B) { const float* tabf = (const float*)(ws + cfg::WS_TAB); att::Ctx C{ws + cfg::WS_QKV + 2 * cfg::QKV_MIX, (bf16*)ap2->out, nullptr, (const float*)(lds + att::LDS_LUT) + 2176, tabf[cfg::TAB_LAM / 4 + 2 * l], 1.0f - tabf[cfg::TAB_LAM / 4 + 2 * l + 1]}; ATT_UNIT<2>(C, it - Q_C, (char*)lds, tq); }
                else if (it < Q_C) { const int chain = it - Q_SC, bh = chain >> 1; dep_wait(dep + bh * 128, 17u, t0); HG_PTRS(); hg::scan_chain(HP, chain, tq); sig = dep + bh * 128 + 64; }
                else if (it < Q_CV) { att::Ctx C{ws + cfg::WS_QKV + 1 * cfg::QKV_MIX, (bf16*)ap2->out, nullptr, nullptr, 0.f, 0.f}; ATT_UNIT<1>(C, it - Q_B, (char*)lds, tq); }
                else if (it < Q_A) { const int wv = __builtin_amdgcn_readfirstlane(tq >> 6), ci = it - Q_CV; LAS float* scr = (LAS float*)(ldsl + wv * 16384); if (it == Q_CV && l == 0 && tq < 64) w_gains(ap2, 1, tq);
                    const bool nextW1 = (l == 0) && ci < CV1; const int lw = nextW1 ? 1 : l, r0 = (nextW1 ? ci * 64 : W_I1 + (ci - (l == 0 ? CV1 : 0)) * 64) + wv * 8;
                    w_run(ap2, lw, r0, 8, 1, scr, tq & 63); }
                else if (it < Q_S3) { att::Ctx C{ws + cfg::WS_QKV, (bf16*)ap2->out, (const float*)(lds + att::LDS_LUT) + 2304, nullptr, 0.f, 0.f}; att::attn_unit<0>(C, it - Q_A, (char*)lds, tq); }
                else { const int i3 = it - Q_S3; HG_PTRS(); hg::s3_item(HP, (const float*)(lds + att::LDS_LUT) + 2240, (bf16*)ap2->out, i3, (unsigned char*)lds, tq, [&]() { if (!(PROBE_REP && rep_ && !((PROBE_QMASK >> 5) & 1))) dep_wait(dep + hg::hg_item_bh(i3) * 128 + 64, 2u, t0); }); }
                asm volatile("" : "+s"(sig));
                dep_signal(sig, t0);
            }
#endif
        }
        SEAM(p0 + 2);
#if NAIVE_ATTN
        if (IN(p0 + 3) && !(DIS & 8)) { TIDS(); CArgs ap = phase_args(); phase_hgrn_post(ap, l, gw, NGW, lane); }
        SEAM(p0 + 3);
#endif
        if (IN(p0 + 5) && !(DIS & 16)) for (int rep_ = 0; rep_ < 1 + ((PROBE_REP >> 5) & 1); ++rep_) { if (rep_) GRID_BAR(1);
            TIDS(); CArgs ap = phase_args(); unsigned char* ws = ap->ws;
            pg8::tail_branch((const bf16*)ap->out  , (const bf16*)(ws + cfg::WS_WB), ws + cfg::WS_GATE, (bf16*)(ws + cfg::WS_MERGED), bxl, wave, lane, (float*)lds);
            pg8::Gemm g{(const bf16*)ap->out  , (const bf16*)(ws + cfg::WS_WB), pg8::TAIL_ROW0, 1024, 1024}; pg8::StaticOrder S; S.init(pg8::TAIL_ROW0, 1024, G, bxl);
            pg8::EpiHorner E{ws};
            pg8::gemm_phase<pg8::EpiHorner, pg8::StaticOrder, true, true>(ldsl, g, S, E, tid);
        }
        SEAM(p0 + 5);
        if (IN(p0 + 6) && !(DIS & 32)) for (int rep_ = 0; rep_ < 1 + ((PROBE_REP >> 6) & 1); ++rep_) { if (rep_) GRID_BAR(1);
            TIDS(); CArgs ap = phase_args(); unsigned char* ws = ap->ws;
            pg8::tail_res((const bf16*)(ws + cfg::WS_MERGED), (const bf16*)(ws + cfg::WS_WO), 1024, ap->out, (bf16*)(ws + cfg::WS_HB), (float*)(ws + cfg::WS_SSQ), 1, nullptr, nullptr, bxl, wave, lane, (float*)lds);
            pg8::Gemm g{(const bf16*)(ws + cfg::WS_MERGED), (const bf16*)(ws + cfg::WS_WO), pg8::TAIL_ROW0, 1024, 1024}; pg8::StaticOrder S; S.init(pg8::TAIL_ROW0, 1024, G, bxl);
            pg8::EpiRes E{ws, 1};
            pg8::gemm_phase<pg8::EpiRes, pg8::StaticOrder, true, true>(ldsl, g, S, E, tid);
        }
        SEAM(p0 + 6);
        if (IN(p0 + 7) && !(DIS & 64)) for (int rep_ = 0; rep_ < 1 + ((PROBE_REP >> 7) & 1); ++rep_) { if (rep_) GRID_BAR(1);
            TIDS(); CArgs ap = phase_args(); unsigned char* ws = ap->ws;
            pg8::Gemm g{(const bf16*)(ws + cfg::WS_HB), (const bf16*)(ws + cfg::WS_WGU), T, cfg::NGU, 1024}; pg8::StaticOrder S; S.init(T, cfg::NGU, G, bxl);
            pg8::build_rstd_tables(S, (const float*)(ws + cfg::WS_SSQ), (LAS float*)(ldsl + pg8::RSTD_LDS_OFF), tid);
            pg8::EpiGLU E{ws};
            pg8::gemm_phase<pg8::EpiGLU, pg8::StaticOrder, true, true>(ldsl, g, S, E, tid);
        }
        SEAM(p0 + 7);
        if (IN(p0 + 8) && !(DIS & 128)) for (int rep_ = 0; rep_ < 1 + ((PROBE_REP >> 8) & 1); ++rep_) { if (rep_) GRID_BAR(1);
            TIDS(); CArgs ap = phase_args(); unsigned char* ws = ap->ws;
            const bool fuse_final = (l + 1 == cfg::DEPTH) && (G == 256);
            pg8::tail_res((const bf16*)(ws + cfg::WS_FF), (const bf16*)(ws + cfg::WS_WD), cfg::DFF, ap->out, (bf16*)(ws + cfg::WS_HB), (float*)(ws + cfg::WS_SSQ), (l + 1 < cfg::DEPTH), fuse_final ? ap->in[18] : nullptr, (unsigned*)ws + cfg::CW_FIN + 1024, bxl, wave, lane, (float*)lds);
            pg8::Gemm g{(const bf16*)(ws + cfg::WS_FF), (const bf16*)(ws + cfg::WS_WD), pg8::TAIL_ROW0, 1024, cfg::DFF}; pg8::StaticOrder S; S.init(pg8::TAIL_ROW0, 1024, G, bxl);
            if (fuse_final) { pg8::EpiResFinal E{ap->out, ws, ap->in[18]}; pg8::gemm_phase<pg8::EpiResFinal, pg8::StaticOrder, false, true>(ldsl, g, S, E, tid); }
            else { pg8::EpiRes E{ws, (l + 1 < cfg::DEPTH) ? 1 : 0}; pg8::gemm_phase<pg8::EpiRes, pg8::StaticOrder, true, true>(ldsl, g, S, E, tid); }
        }
        if (!((l + 1 == cfg::DEPTH) && (G == 256))) SEAM(p0 + 8);
    }
    if (IN(PH_FINAL) && G != 256) { TIDS(); CArgs ap = phase_args(); phase_final(ap, gw, NGW, lane); }
#undef IN
#undef SEAM
}

extern "C" void kernel_launch(void* const* d_in, const int* in_sizes, int n_in, void* d_out, int out_size, void* d_ws, size_t ws_size, hipStream_t stream) {
    static int grid = 0;
    if (grid == 0) {
        if (n_in != 19 || ws_size < cfg::WS_END || out_size != cfg::BATCH * cfg::SEQ * cfg::DM) { fprintf(stderr, "kernel_launch: unexpected problem (n_in %d, ws %zu, out %d)\n", n_in, ws_size, out_size); grid = -1; return; }
        int dev = 0, cus = 0, per_cu = 0;
        hipGetDevice(&dev); hipDeviceGetAttribute(&cus, hipDeviceAttributeMultiprocessorCount, dev);
        hipFuncSetAttribute((const void*)enc_fwd, hipFuncAttributeMaxDynamicSharedMemorySize, cfg::LDS_BYTES);
        hipOccupancyMaxActiveBlocksPerMultiprocessor(&per_cu, (const void*)enc_fwd, NWAVES * 64, cfg::LDS_BYTES);
        if (per_cu < 1) { fprintf(stderr, "kernel_launch: occupancy query says %d blocks per CU\n", per_cu); per_cu = 1; }
        (void)hipGetLastError();
        grid = cus;
        if (cus != 256) fprintf(stderr, "kernel_launch: %d CUs; this kernel's thin-tail task map assumes 256 workgroups\n", cus);
    }
    if (grid < 0) return;
    (void)hipMemsetAsync(d_ws, 0, CTL_ZERO_BYTES, stream);
    Args a{};
    for (int i = 0; i < 19; ++i) a.in[i] = (const float*)d_in[i];
    a.out = (float*)d_out; a.ws = (unsigned char*)d_ws;
#if MK_SPLIT
    for (int p = 0; p < N_PHASES; ++p) { a.ph_lo = p; a.ph_hi = p + 1; hipLaunchKernelGGL(enc_fwd, dim3(grid), dim3(NWAVES * 64), cfg::LDS_BYTES, stream, a); }
#else
    a.ph_lo = 0; a.ph_hi = N_PHASES;
    void* args[] = {&a};
    hipError_t e = hipLaunchCooperativeKernel((const void*)enc_fwd, dim3(grid), dim3(NWAVES * 64), args, cfg::LDS_BYTES, stream);
    if (e != hipSuccess) fprintf(stderr, "kernel_launch: cooperative launch failed: %s (grid %d)\n", hipGetErrorString(e), grid);
#endif
}
```

```cpp
#include <hip/hip_runtime.h>
#include <hip/hip_cooperative_groups.h>
#include <cstdio>
#include <cstdint>
namespace cg = cooperative_groups;

namespace cfg {
constexpr int BATCH = 4, SEQ = 4096, DM = 1024, L = 4224, T = BATCH * L, FRONT = 112, NMETA = 16, MEND = 128;
constexpr int NIN = 6912, DFF = 2816, NGU = 2 * DFF, DEPTH = 2;
constexpr float LOG2E = 1.4426950408889634f;
constexpr float QSCALE64 = 0.125f * LOG2E;
constexpr float QSCALE32 = 0.17677669529663687f * LOG2E;
constexpr float RMS_EPS = 1e-6f;
constexpr size_t MiB = 1u << 20;
constexpr size_t WS_TAB = 1 * MiB;
constexpr size_t TAB_RT = 0, TAB_LUTA = 16384, TAB_LUTC = 32768, TAB_LB = 49152, TAB_LAM = 57344, TAB_QKG = 57600;
constexpr size_t WS_W1 = 2 * MiB;
constexpr size_t WS_WB = WS_W1 + (size_t)NIN * DM * 2;
constexpr size_t WS_WO = WS_WB + (size_t)DM * DM * 2;
constexpr size_t WS_WGU = WS_WO + (size_t)DM * DM * 2;
constexpr size_t WS_WD = WS_WGU + (size_t)NGU * DM * 2;
constexpr size_t WS_HB = 36 * MiB;
constexpr size_t WS_QKV = 69 * MiB;
constexpr size_t QKV_MIX = (size_t)T * 512 * 2;
constexpr size_t WS_MERGED = WS_QKV;
constexpr size_t WS_D = WS_QKV + 3 * QKV_MIX;
constexpr size_t D_ARR = (size_t)T * 256 * 2;
constexpr size_t WS_GATE = WS_D + 5 * D_ARR;
constexpr size_t WS_OFB = WS_GATE + (size_t)T * 4096;
constexpr size_t WS_SSQ = WS_OFB + 2 * D_ARR;
constexpr size_t WS_HSIDE = 244 * MiB;
constexpr size_t WS_FF = WS_QKV;
constexpr size_t WS_END = WS_HSIDE + (size_t)BATCH * 128 * DM * 4;
static_assert(WS_WD + (size_t)DM * DFF * 2 <= WS_HB, "weights fit below HB");
static_assert(WS_HB + (size_t)T * DM * 2 <= WS_QKV, "HB fits");
static_assert(WS_FF + (size_t)T * DFF * 2 <= WS_GATE, "FF overlay fits below GATE");
static_assert(WS_SSQ + (size_t)T * 16 * 4 <= WS_HSIDE, "SSQ fits");
static_assert(WS_END <= 256 * MiB, "workspace fits 256 MiB");
constexpr int CW_FIN = 9216;
constexpr int LDS_BYTES = 147456;
}

typedef unsigned short bf16;
#define GAS __attribute__((address_space(1)))
#define LAS __attribute__((address_space(3)))
typedef unsigned v4u __attribute__((ext_vector_type(4)));
typedef unsigned v2u __attribute__((ext_vector_type(2)));
typedef float f32x2_g __attribute__((ext_vector_type(2))); typedef __bf16 bf16x2_g __attribute__((ext_vector_type(2)));
__device__ __forceinline__ unsigned pk2(float lo, float hi) { f32x2_g v = {lo, hi}; bf16x2_g b = __builtin_convertvector(v, bf16x2_g); return __builtin_bit_cast(unsigned, b); }
__device__ __forceinline__ unsigned f2bf(float f) { return pk2(f, 0.0f); }
__device__ __forceinline__ float bf2f(unsigned short h) { return __builtin_bit_cast(float, (unsigned)h << 16); }
__device__ __forceinline__ float bflo(unsigned w) { return __builtin_bit_cast(float, w << 16); }
__device__ __forceinline__ float bfhi(unsigned w) { return __builtin_bit_cast(float, w & 0xffff0000u); }
__device__ __forceinline__ float fexp2(float x) { return __builtin_amdgcn_exp2f(x); }
__device__ __forceinline__ float sigmoidf_(float x) { return 1.0f / (1.0f + __expf(-x)); }

namespace pg8 {
#define PG8_LAS __attribute__((address_space(3)))
typedef unsigned short bf16_t;
typedef short bf16x8 __attribute__((ext_vector_type(8)));
typedef float f32x4 __attribute__((ext_vector_type(4)));
typedef unsigned u32x4 __attribute__((ext_vector_type(4)));
constexpr int BM = 256, BK = 64, HALF = 128, HTB = HALF * BK * 2  , STAGE_BYTES = 8 * HTB, NXCD = 8, WGM = 8;

__host__ __device__ __forceinline__ int lds_byte(int r, int c) { const int st = (r >> 4) * 2 + (c >> 5), rr = r & 15, cc = c & 31, ob = rr * 64 + cc * 2; return st * 1024 + (ob ^ (((ob >> 9) & 1) << 5)); }
__host__ __device__ __forceinline__ void stage_rc(int b, int& R, int& C) { const int st = b / 1024, sb = b % 1024, swz = sb ^ (((sb >> 9) & 1) << 5); R = (st >> 1) * 16 + swz / 64; C = (st & 1) * 32 + (swz % 64) / 2; }
__host__ __device__ __forceinline__ int perm32(int rho) { const int n = rho >> 4, i = rho & 15; return 8 * (i >> 2) + 4 * n + (i & 3); }

struct Unit { int pm, pn; };
struct Gemm { const bf16_t* A; const bf16_t* Bt; int M, N, K; };

struct StaticOrder {
    int nM, nN, nwg, G, c;
    __host__ __device__ void init(int M, int N, int G_, int c_) { nM = M / BM; nN = N / BM; nwg = nM * nN; G = G_; c = c_; }
    __host__ __device__ bool next(int i, Unit& u) const {
        const long L = (long)i * G + c; if (L >= nwg) return false;
        int wgid = (int)L; { const int q = nwg / NXCD, r = nwg % NXCD, xcd = wgid % NXCD, off = wgid / NXCD; wgid = (xcd < r ? xcd * (q + 1) : r * (q + 1) + (xcd - r) * q) + off; }
        const int nig = WGM * nN, gid = wgid / nig, fm = gid * WGM, gsz = (nM - fm) < WGM ? (nM - fm) : WGM;
        u.pm = fm + ((wgid % nig) % gsz); u.pn = (wgid % nig) / gsz; return true;
    }
    __device__ __forceinline__ void a_ready(const Unit&) const {}
    __device__ __forceinline__ void done(const Unit&) const {}
};


__device__ __forceinline__ unsigned cvt_pk_bf16(float lo, float hi) { unsigned r; asm volatile("v_cvt_pk_bf16_f32 %0, %1, %2" : "=v"(r) : "v"(lo), "v"(hi)); return r; }
typedef unsigned u32x2 __attribute__((ext_vector_type(2)));
__device__ __forceinline__ float row_rstd(const float* ssq, int r) {
    const f32x4* p = (const f32x4*)(ssq + (size_t)r * 16);
    const f32x4 a = p[0], b = p[1], c = p[2], d = p[3];
    const float s = (((a[0] + a[1]) + (a[2] + a[3])) + ((b[0] + b[1]) + (b[2] + b[3]))) + (((c[0] + c[1]) + (c[2] + c[3])) + ((d[0] + d[1]) + (d[2] + d[3])));
    return __builtin_amdgcn_rsqf(s * (1.0f / 1024.0f) + cfg::RMS_EPS);
}
__device__ __forceinline__ void rows_rstd(const float* ssq, int rbase, float (&rs)[2][4]) {
#pragma unroll
    for (int ai = 0; ai < 2; ++ai) {
        f32x4 t[4][4];
#pragma unroll
        for (int m = 0; m < 4; ++m) { const f32x4* p = (const f32x4*)(ssq + (size_t)(rbase + ai * HALF + m * 16) * 16);
#pragma unroll
            for (int q = 0; q < 4; ++q) t[m][q] = p[q]; }
#pragma unroll
        for (int m = 0; m < 4; ++m) { float s = 0.f;
#pragma unroll
            for (int q = 0; q < 4; ++q) s += (t[m][q][0] + t[m][q][1]) + (t[m][q][2] + t[m][q][3]);
            rs[ai][m] = __builtin_amdgcn_rsqf(s * (1.0f / 1024.0f) + cfg::RMS_EPS); }
        asm volatile("" : "+v"(rs[ai][0]), "+v"(rs[ai][1]), "+v"(rs[ai][2]), "+v"(rs[ai][3]));
    }
}
__device__ __forceinline__ void st_bf16x4(bf16_t* p, f32x4 v) { u32x2 w; w.x = cvt_pk_bf16(v[0], v[1]); w.y = cvt_pk_bf16(v[2], v[3]); *(u32x2*)p = w; }
__device__ __forceinline__ void st_bf16x4_pair(bf16_t* p, f32x4 v0, f32x4 v1, int fq) {
    const unsigned a0 = cvt_pk_bf16(v0[0], v0[1]), a1 = cvt_pk_bf16(v0[2], v0[3]), b0 = cvt_pk_bf16(v1[0], v1[1]), b1 = cvt_pk_bf16(v1[2], v1[3]);
    const auto s0 = __builtin_amdgcn_permlane16_swap(a0, b0, false, false); const auto s1 = __builtin_amdgcn_permlane16_swap(a1, b1, false, false);
    u32x4 o; o.x = s0[0]; o.y = s1[0]; o.z = s0[1]; o.w = s1[1];
    *(u32x4*)((fq & 1) ? p + 16 - 4 : p) = o;
}

constexpr int RSTD_LDS_OFF = 131072 + 1024, RSTD_SLOTS = 8;
template <class Sched>
__device__ __forceinline__ void build_rstd_tables(const Sched& S, const float* ssq, PG8_LAS float* tab, int tid) {
    const int row = tid >> 1, half = tid & 1; Unit u; PG8_LAS int* pmt = (PG8_LAS int*)(tab + RSTD_SLOTS * 256);
    if (tid < RSTD_SLOTS) pmt[tid] = -1;
    __syncthreads();
    int ns = 0, last = -1;
    for (int i = 0; ns < RSTD_SLOTS && S.next(i, u); ++i) {
        if (u.pm == last) continue;
        last = u.pm;
        const f32x4* p = (const f32x4*)(ssq + (size_t)(u.pm * BM + row) * 16 + 8 * half); const f32x4 a = p[0], b = p[1];
        float s = ((a[0] + a[1]) + (a[2] + a[3])) + ((b[0] + b[1]) + (b[2] + b[3]));
        s += __shfl_xor(s, 1);
        if (half == 0) tab[ns * 256 + row] = __builtin_amdgcn_rsqf(s * (1.0f / 1024.0f) + cfg::RMS_EPS);
        if (tid == 0) pmt[ns] = u.pm;
        ++ns;
    }
    __syncthreads();
}
__device__ __forceinline__ void rows_rstd_lds(const PG8_LAS float* tab, int pm, int wr, int fr, float (&rs)[2][4]) {
    const PG8_LAS int* pmt = (const PG8_LAS int*)(tab + RSTD_SLOTS * 256);
    int slot = 0;
#pragma unroll
    for (int j = 1; j < RSTD_SLOTS; ++j) if (pmt[j] == pm) slot = j;
#pragma unroll
    for (int ai = 0; ai < 2; ++ai)
#pragma unroll
        for (int m = 0; m < 4; ++m) rs[ai][m] = tab[slot * 256 + ai * HALF + wr * 64 + m * 16 + fr];
}

struct Epi1 {
    static constexpr bool PERM = false, AFTER_DRAIN = false, HOOK = false;
    unsigned char* ws;
    __device__ __forceinline__ void hook(f32x4 (&)[2][2][4][2], const Unit&, int, int, int, int, int) const {}
    __device__ __forceinline__ void operator()(const f32x4 (&acc)[2][2][4][2], const Unit& u, int wr, int wc, int fr, int fq) const {
        const int pn = u.pn;
        const PG8_LAS float* tab = (const PG8_LAS float*)RSTD_LDS_OFF;
        float rsv[2][4]; rows_rstd_lds(tab, u.pm, wr, fr, rsv);
        if (pn < 6) {
            const float* rt = (const float*)(ws + cfg::WS_TAB + cfg::TAB_RT); const float* gq = (const float*)(ws + cfg::WS_TAB + cfg::TAB_QKG); const float* gk = gq + 64;
            const int mixer = pn >> 1;
            unsigned char* mb = ws + cfg::WS_QKV + (size_t)mixer * cfg::QKV_MIX;
            bf16_t* base; int pitch, colofs; float scale = 1.0f; int mode = 0; const float* g = gq;
            if (!(pn & 1)) { base = (bf16_t*)mb; pitch = 256; colofs = wc * 64; scale = (mixer == 2) ? cfg::QSCALE32 : cfg::QSCALE64; mode = (mixer == 1); }
            else if (wc < 2) { base = (bf16_t*)(mb + (size_t)cfg::T * 512); pitch = 128; colofs = wc * 64; mode = (mixer == 1); g = gk; }
            else { base = (bf16_t*)(mb + (size_t)cfg::T * 768); pitch = 128; colofs = (wc - 2) * 64; }
            f32x4 gain[2][2];
            if (mode) {
#pragma unroll
                for (int bj = 0; bj < 2; ++bj)
#pragma unroll
                    for (int n = 0; n < 2; ++n) gain[bj][n] = *(const f32x4*)(g + 32 * bj + 16 * n + 4 * fq);
            }
#pragma unroll
            for (int ai = 0; ai < 2; ++ai)
#pragma unroll
                for (int m = 0; m < 4; ++m) {
                    const int r = u.pm * BM + ai * HALF + wr * 64 + m * 16 + fr;
                    const float rs = rsv[ai][m];
                    f32x4 x[2][2];
#pragma unroll
                    for (int bj = 0; bj < 2; ++bj)
#pragma unroll
                        for (int n = 0; n < 2; ++n) x[bj][n] = acc[ai][bj][m][n] * rs;
                    if (mode) {
                        float ss = 0.f;
#pragma unroll
                        for (int bj = 0; bj < 2; ++bj)
#pragma unroll
                            for (int n = 0; n < 2; ++n) { const f32x4 v = x[bj][n]; ss += (v[0] * v[0] + v[1] * v[1]) + (v[2] * v[2] + v[3] * v[3]); }
                        ss += __shfl_xor(ss, 16); ss += __shfl_xor(ss, 32);
                        const float r2 = __builtin_amdgcn_rsqf(ss * (1.0f / 64.0f) + cfg::RMS_EPS);
                        const int b = r / cfg::L, pos = r - b * cfg::L;
                        int tv[2];
                        if (pos < cfg::FRONT) { tv[0] = 1; tv[1] = 1; }
                        else if (pos < cfg::MEND) { tv[0] = 0; tv[1] = pos - cfg::FRONT + 1; }
                        else { const int s = pos - cfg::MEND; tv[0] = (s >> 6) + 1; tv[1] = (s & 63) + 1; }
#pragma unroll
                        for (int bj = 0; bj < 2; ++bj) {
                            const f32x4* cs = (const f32x4*)(rt + (size_t)(tv[bj] * 16 + 4 * fq) * 2);
                            const f32x4 cs0 = cs[0], cs1 = cs[1];
                            const f32x4 y1 = x[bj][0] * gain[bj][0] * r2, y2 = x[bj][1] * gain[bj][1] * r2;
                            f32x4 o1, o2;
                            o1[0] = y1[0] * cs0[0] - y2[0] * cs0[1]; o2[0] = y2[0] * cs0[0] + y1[0] * cs0[1];
                            o1[1] = y1[1] * cs0[2] - y2[1] * cs0[3]; o2[1] = y2[1] * cs0[2] + y1[1] * cs0[3];
                            o1[2] = y1[2] * cs1[0] - y2[2] * cs1[1]; o2[2] = y2[2] * cs1[0] + y1[2] * cs1[1];
                            o1[3] = y1[3] * cs1[2] - y2[3] * cs1[3]; o2[3] = y2[3] * cs1[2] + y1[3] * cs1[3];
                            x[bj][0] = o1; x[bj][1] = o2;
                        }
                    }
                    bf16_t* rowp = base + (size_t)r * pitch + colofs + 4 * fq;
#pragma unroll
                    for (int bj = 0; bj < 2; ++bj)
                        st_bf16x4_pair(rowp + 32 * bj, x[bj][0] * scale, x[bj][1] * scale, fq);
                }
        } else if (pn < 11) {
            const int arr = pn - 6;
            bf16_t* base = (bf16_t*)(ws + cfg::WS_D + (size_t)arr * cfg::D_ARR);
            const float scale = (arr == 0) ? 0.125f : 1.0f;
#pragma unroll
            for (int ai = 0; ai < 2; ++ai)
#pragma unroll
                for (int m = 0; m < 4; ++m) {
                    const int r = u.pm * BM + ai * HALF + wr * 64 + m * 16 + fr;
                    const float rs = rsv[ai][m] * scale;
                    bf16_t* rowp = base + (size_t)r * 256 + wc * 32 + 4 * fq;
#pragma unroll
                    for (int bj = 0; bj < 2; ++bj)
                        st_bf16x4_pair(rowp + 128 * bj, acc[ai][bj][m][0] * rs, acc[ai][bj][m][1] * rs, fq);
                }
        } else {
            const int br = (pn - 11) >> 2, pnD = (pn - 11) & 3;
            unsigned* base = (unsigned*)(ws + cfg::WS_GATE + (size_t)((u.pm * 4 + pnD) * 4 + br) * 65536) + (wr * 4 + wc) * 2048 + (fq * 16 + fr) * 4;
#pragma unroll
            for (int ai = 0; ai < 2; ++ai)
#pragma unroll
                for (int m = 0; m < 4; ++m) {
                    const float rs = rsv[ai][m] * -cfg::LOG2E;
                    u32x4 wq;
#pragma unroll
                    for (int bj = 0; bj < 2; ++bj)
#pragma unroll
                        for (int n = 0; n < 2; ++n) {
                            const f32x4 v = acc[ai][bj][m][n] * rs; unsigned w = 0;
#pragma unroll
                            for (int j = 0; j < 4; ++j) { const float g256 = __builtin_amdgcn_rcpf(__builtin_fmaf(__builtin_amdgcn_exp2f(v[j]), 1.0f / 256.0f, 1.0f / 256.0f));
                                w = __builtin_amdgcn_cvt_pk_u8_f32(g256 - 0.5f, (unsigned)j, w); }
                            wq[bj * 2 + n] = w;
                        }
                    *(u32x4*)(base + (ai * 4 + m) * 256) = wq;
                }
        }
    }
};

struct EpiHorner {
    static constexpr bool PERM = false, AFTER_DRAIN = false, HOOK = true;
    unsigned char* ws;
    static __device__ __forceinline__ f32x4 deqr(unsigned w) {
        f32x4 g; g[0] = (float)(w & 255u); g[1] = (float)((w >> 8) & 255u); g[2] = (float)((w >> 16) & 255u); g[3] = (float)(w >> 24);
        return g + 0.5f;
    }
    static __device__ __forceinline__ f32x4 deq(unsigned w) {
        f32x4 g; g[0] = __builtin_fmaf((float)(w & 255u), 1.0f / 256.0f, 0.5f / 256.0f); g[1] = __builtin_fmaf((float)((w >> 8) & 255u), 1.0f / 256.0f, 0.5f / 256.0f);
        g[2] = __builtin_fmaf((float)((w >> 16) & 255u), 1.0f / 256.0f, 0.5f / 256.0f); g[3] = __builtin_fmaf((float)(w >> 24), 1.0f / 256.0f, 0.5f / 256.0f);
        return g;
    }
    __device__ __forceinline__ void hook(f32x4 (&acc)[2][2][4][2], const Unit& u, int t, int wr, int wc, int fr, int fq) const {
        const int nb = (t >> 2) - 1; const unsigned char* gate = ws + cfg::WS_GATE;
        const unsigned* g0p = (const unsigned*)(gate + (size_t)((u.pm * 4 + u.pn) * 4 + nb) * 65536) + (wr * 4 + wc) * 2048 + (fq * 16 + fr) * 4;
        unsigned w0[2][4][2][2], w1[2][4][2][2];
#pragma unroll
        for (int ai = 0; ai < 2; ++ai)
#pragma unroll
            for (int m = 0; m < 4; ++m) { const u32x4 q0 = *(const u32x4*)(g0p + (ai * 4 + m) * 256), q1 = *(const u32x4*)(g0p + (ai * 4 + m) * 256 + 16384);
#pragma unroll
                for (int bj = 0; bj < 2; ++bj)
#pragma unroll
                    for (int n = 0; n < 2; ++n) { w0[ai][m][bj][n] = q0[bj * 2 + n]; w1[ai][m][bj][n] = q1[bj * 2 + n]; } }
        __builtin_amdgcn_sched_barrier(0);
#pragma unroll
        for (int ai = 0; ai < 2; ++ai)
#pragma unroll
            for (int m = 0; m < 4; ++m)
#pragma unroll
                for (int bj = 0; bj < 2; ++bj)
#pragma unroll
                    for (int n = 0; n < 2; ++n) { const f32x4 g0 = deq(w0[ai][m][bj][n]), g1 = deq(w1[ai][m][bj][n]);
                        f32x4 rr; rr[0] = g0[0] * __builtin_amdgcn_rcpf(g1[0]); rr[1] = g0[1] * __builtin_amdgcn_rcpf(g1[1]); rr[2] = g0[2] * __builtin_amdgcn_rcpf(g1[2]); rr[3] = g0[3] * __builtin_amdgcn_rcpf(g1[3]);
                        acc[ai][bj][m][n] *= rr; }
        __builtin_amdgcn_sched_barrier(0);
    }
    __device__ __forceinline__ void operator()(const f32x4 (&acc)[2][2][4][2], const Unit& u, int wr, int wc, int fr, int fq) const {
        const unsigned char* gate = ws + cfg::WS_GATE; bf16_t* out = (bf16_t*)(ws + cfg::WS_MERGED);
        const unsigned* g3p = (const unsigned*)(gate + (size_t)((u.pm * 4 + u.pn) * 4 + 3) * 65536) + (wr * 4 + wc) * 2048 + (fq * 16 + fr) * 4;
        unsigned w3[2][4][2][2];
#pragma unroll
        for (int ai = 0; ai < 2; ++ai)
#pragma unroll
            for (int m = 0; m < 4; ++m) { const u32x4 q3 = *(const u32x4*)(g3p + (ai * 4 + m) * 256);
#pragma unroll
                for (int bj = 0; bj < 2; ++bj)
#pragma unroll
                    for (int n = 0; n < 2; ++n) w3[ai][m][bj][n] = q3[bj * 2 + n]; }
#pragma unroll
        for (int ai = 0; ai < 2; ++ai)
#pragma unroll
            for (int m = 0; m < 4; ++m) {
                const int r = u.pm * BM + ai * HALF + wr * 64 + m * 16 + fr;
                bf16_t* rowp = out + (size_t)r * 1024 + u.pn * 256 + wc * 32 + 4 * fq;
#pragma unroll
                for (int bj = 0; bj < 2; ++bj)
                    st_bf16x4_pair(rowp + 128 * bj, acc[ai][bj][m][0] * deq(w3[ai][m][bj][0]), acc[ai][bj][m][1] * deq(w3[ai][m][bj][1]), fq);
            }
    }
};

__device__ __forceinline__ f32x4 ld_bf16x4(const bf16_t* p) { const u32x2 w = *(const u32x2*)p; f32x4 v; v[0] = __builtin_bit_cast(float, w.x << 16); v[1] = __builtin_bit_cast(float, w.x & 0xffff0000u); v[2] = __builtin_bit_cast(float, w.y << 16); v[3] = __builtin_bit_cast(float, w.y & 0xffff0000u); return v; }
struct EpiRes {
    static constexpr bool PERM = true, AFTER_DRAIN = false, HOOK = false;
    unsigned char* ws; int feed;
    __device__ __forceinline__ void hook(f32x4 (&)[2][2][4][2], const Unit&, int, int, int, int, int) const {}
    __device__ __forceinline__ void operator()(const f32x4 (&acc)[2][2][4][2], const Unit& u, int wr, int wc, int fr, int fq) const {
        bf16_t* hb = (bf16_t*)(ws + cfg::WS_HB); float* ssq = (float*)(ws + cfg::WS_SSQ);
        const int c0 = u.pn * 256 + wc * 32 + 8 * fq;
        u32x4 hv[2][4][2];
#pragma unroll
        for (int ai = 0; ai < 2; ++ai)
#pragma unroll
            for (int m = 0; m < 4; ++m) { const bf16_t* br = hb + (size_t)(u.pm * BM + ai * HALF + wr * 64 + m * 16 + fr) * 1024 + c0;
#pragma unroll
                for (int bj = 0; bj < 2; ++bj) hv[ai][m][bj] = *(const u32x4*)(br + 128 * bj); }
        __builtin_amdgcn_sched_barrier(0);
#pragma unroll
        for (int ai = 0; ai < 2; ++ai) {
#pragma unroll
            for (int m = 0; m < 4; ++m) {
                const int r = u.pm * BM + ai * HALF + wr * 64 + m * 16 + fr;
                bf16_t* br = hb + (size_t)r * 1024 + c0;
                float ss = 0.f;
#pragma unroll
                for (int bj = 0; bj < 2; ++bj) {
                    const u32x4 w = hv[ai][m][bj]; f32x4 v0, v1;
                    v0[0] = __builtin_bit_cast(float, w.x << 16); v0[1] = __builtin_bit_cast(float, w.x & 0xffff0000u); v0[2] = __builtin_bit_cast(float, w.y << 16); v0[3] = __builtin_bit_cast(float, w.y & 0xffff0000u);
                    v1[0] = __builtin_bit_cast(float, w.z << 16); v1[1] = __builtin_bit_cast(float, w.z & 0xffff0000u); v1[2] = __builtin_bit_cast(float, w.w << 16); v1[3] = __builtin_bit_cast(float, w.w & 0xffff0000u);
                    v0 += acc[ai][bj][m][0]; v1 += acc[ai][bj][m][1];
                    u32x4 o; o.x = cvt_pk_bf16(v0[0], v0[1]); o.y = cvt_pk_bf16(v0[2], v0[3]); o.z = cvt_pk_bf16(v1[0], v1[1]); o.w = cvt_pk_bf16(v1[2], v1[3]);
                    *(u32x4*)(br + 128 * bj) = o;
                    ss += ((v0[0] * v0[0] + v0[1] * v0[1]) + (v0[2] * v0[2] + v0[3] * v0[3])) + ((v1[0] * v1[0] + v1[1] * v1[1]) + (v1[2] * v1[2] + v1[3] * v1[3]));
                }
                ss += __shfl_xor(ss, 16); ss += __shfl_xor(ss, 32);
                if (feed && fq == 0) ssq[(size_t)r * 16 + u.pn * 4 + wc] = ss;
            }
        }
    }
};

struct EpiResFinal {
    static constexpr bool PERM = false, AFTER_DRAIN = true, HOOK = false;
    float* hout; unsigned char* ws; const float* lnf;
    __device__ __forceinline__ void hook(f32x4 (&)[2][2][4][2], const Unit&, int, int, int, int, int) const {}
    __device__ __forceinline__ void fused(f32x4 (&acc)[2][2][4][2], const Unit& u, int wr, int wc, int fr, int fq, PG8_LAS unsigned char* lds, int wid, int lane) const {
        const bf16_t* hb = (const bf16_t*)(ws + cfg::WS_HB); float* ssq = (float*)(ws + cfg::WS_SSQ); unsigned* cnt = (unsigned*)ws + cfg::CW_FIN + 16 * u.pm;
        const int c0 = u.pn * 256 + wc * 32 + 4 * fq;
#pragma unroll
        for (int ai = 0; ai < 2; ++ai) {
            f32x4 hv[4][2][2];
#pragma unroll
            for (int m = 0; m < 4; ++m) { const bf16_t* br = hb + (size_t)(u.pm * BM + ai * HALF + wr * 64 + m * 16 + fr) * 1024 + c0;
#pragma unroll
                for (int bj = 0; bj < 2; ++bj)
#pragma unroll
                    for (int n = 0; n < 2; ++n) hv[m][bj][n] = ld_bf16x4(br + 128 * bj + 16 * n); }
#pragma unroll
            for (int m = 0; m < 4; ++m) {
                const int r = u.pm * BM + ai * HALF + wr * 64 + m * 16 + fr;
                float ss = 0.f;
#pragma unroll
                for (int bj = 0; bj < 2; ++bj)
#pragma unroll
                    for (int n = 0; n < 2; ++n) { const f32x4 v = hv[m][bj][n] + acc[ai][bj][m][n]; acc[ai][bj][m][n] = v; ss += (v[0] * v[0] + v[1] * v[1]) + (v[2] * v[2] + v[3] * v[3]); }
                ss += __shfl_xor(ss, 16); ss += __shfl_xor(ss, 32);
                if (fq == 0) __hip_atomic_store(ssq + (size_t)r * 16 + u.pn * 4 + wc, ss, __ATOMIC_RELAXED, __HIP_MEMORY_SCOPE_AGENT);
            }
        }
        asm volatile("s_waitcnt vmcnt(0)" ::: "memory");
        if (lane == 0) { const unsigned one = 1u; asm volatile("global_atomic_add %0, %1, off" :: "v"(cnt), "v"(one) : "memory"); }
        if (wid == 0) {
            if (lane == 0) { unsigned sp = 0; while (__hip_atomic_load(cnt, __ATOMIC_RELAXED, __HIP_MEMORY_SCOPE_AGENT) < 32u) { __builtin_amdgcn_s_sleep(2); if (++sp > (1u << 18)) break; } }
            __builtin_amdgcn_fence(__ATOMIC_ACQUIRE, "agent"); asm volatile("s_waitcnt vmcnt(0)" ::: "memory");
        }
        asm volatile("s_waitcnt lgkmcnt(0)\n\ts_barrier" ::: "memory");
        f32x4 g[2][2];
#pragma unroll
        for (int bj = 0; bj < 2; ++bj)
#pragma unroll
            for (int n = 0; n < 2; ++n) g[bj][n] = *(const f32x4*)(lnf + c0 + 128 * bj + 16 * n);
#pragma unroll
        for (int ai = 0; ai < 2; ++ai) {
            float rs[4];
#pragma unroll
            for (int mh = 0; mh < 4; mh += 2) { f32x4 t[2][4];
#pragma unroll
              for (int m = 0; m < 2; ++m) { const f32x4* p = (const f32x4*)(ssq + (size_t)(u.pm * BM + ai * HALF + wr * 64 + (mh + m) * 16 + fr) * 16);
#pragma unroll
                  for (int q = 0; q < 4; ++q) t[m][q] = p[q]; }
#pragma unroll
              for (int m = 0; m < 2; ++m) { float s = 0.f;
#pragma unroll
                  for (int q = 0; q < 4; ++q) s += (t[m][q][0] + t[m][q][1]) + (t[m][q][2] + t[m][q][3]);
                  rs[mh + m] = __builtin_amdgcn_rsqf(s * (1.0f / 1024.0f) + cfg::RMS_EPS); } }
#pragma unroll
            for (int m = 0; m < 4; ++m) { const int r = u.pm * BM + ai * HALF + wr * 64 + m * 16 + fr, b = r / cfg::L, pos = r - b * cfg::L;
                float* hr = (pos >= cfg::MEND ? hout + (size_t)(b * cfg::SEQ + pos - cfg::MEND) * cfg::DM : (float*)(ws + cfg::WS_HSIDE) + (size_t)(b * 128 + pos) * cfg::DM) + c0;
#pragma unroll
                for (int bj = 0; bj < 2; ++bj)
#pragma unroll
                    for (int n = 0; n < 2; ++n) *(f32x4*)(hr + 128 * bj + 16 * n) = acc[ai][bj][m][n] * rs[m] * g[bj][n]; }
        }
    }
};

struct EpiGLU {
    static constexpr bool PERM = true, AFTER_DRAIN = false, HOOK = false;
    unsigned char* ws;
    __device__ __forceinline__ void hook(f32x4 (&)[2][2][4][2], const Unit&, int, int, int, int, int) const {}
    __device__ __forceinline__ void operator()(const f32x4 (&acc)[2][2][4][2], const Unit& u, int wr, int wc, int fr, int fq) const {
        const PG8_LAS float* tab = (const PG8_LAS float*)RSTD_LDS_OFF; bf16_t* ff = (bf16_t*)(ws + cfg::WS_FF);
        float rsv[2][4]; rows_rstd_lds(tab, u.pm, wr, fr, rsv);
#pragma unroll
        for (int ai = 0; ai < 2; ++ai)
#pragma unroll
            for (int m = 0; m < 4; ++m) {
                const int r = u.pm * BM + ai * HALF + wr * 64 + m * 16 + fr;
                const float rs = rsv[ai][m], rsn = rs * -cfg::LOG2E, rs2 = rs * rs;
                u32x4 w;
#pragma unroll
                for (int n = 0; n < 2; ++n) {
                    const f32x4 t = acc[ai][0][m][n] * rsn, gu = (acc[ai][0][m][n] * acc[ai][1][m][n]) * rs2; f32x4 o;
#pragma unroll
                    for (int j = 0; j < 4; ++j) o[j] = gu[j] * __builtin_amdgcn_rcpf(1.0f + __builtin_amdgcn_exp2f(t[j]));
                    if (n == 0) { w.x = cvt_pk_bf16(o[0], o[1]); w.y = cvt_pk_bf16(o[2], o[3]); } else { w.z = cvt_pk_bf16(o[0], o[1]); w.w = cvt_pk_bf16(o[2], o[3]); }
                }
                *(u32x4*)(ff + (size_t)r * cfg::DFF + u.pn * 128 + wc * 32 + 8 * fq) = w;
            }
    }
};


constexpr int TAIL_ROW0 = 16384, TAIL_TASKS = 256;
template <int NSTEP>
__device__ __forceinline__ void tail_chunk(const bf16_t* ap, const bf16_t* bp, int ld, f32x4 (&acc)[2][4]) {
    bf16x8 a[NSTEP][2], b[NSTEP][4];
#pragma unroll
    for (int s = 0; s < NSTEP; ++s) { a[s][0] = *(const bf16x8*)(ap + 32 * s); a[s][1] = *(const bf16x8*)(ap + (size_t)16 * ld + 32 * s);
#pragma unroll
        for (int cb = 0; cb < 4; ++cb) b[s][cb] = *(const bf16x8*)(bp + (size_t)(16 * cb) * ld + 32 * s); }
    __builtin_amdgcn_sched_barrier(0);
#pragma unroll
    for (int s = 0; s < NSTEP; ++s)
#pragma unroll
        for (int h = 0; h < 2; ++h)
#pragma unroll
            for (int cb = 0; cb < 4; ++cb) acc[h][cb] = __builtin_amdgcn_mfma_f32_16x16x32_bf16(a[s][h], b[s][cb], acc[h][cb], 0, 0, 0);
}
template <int NSTEP>
__device__ __forceinline__ void tail_ld(const bf16_t* ap, const bf16_t* bp, int ld, bf16x8 (&a)[3][2], bf16x8 (&b)[3][4]) {
#pragma unroll
    for (int s = 0; s < NSTEP; ++s) { a[s][0] = *(const bf16x8*)(ap + 32 * s); a[s][1] = *(const bf16x8*)(ap + (size_t)16 * ld + 32 * s);
#pragma unroll
        for (int cb = 0; cb < 4; ++cb) b[s][cb] = *(const bf16x8*)(bp + (size_t)(16 * cb) * ld + 32 * s); }
}
template <int NSTEP>
__device__ __forceinline__ void tail_mm(const bf16x8 (&a)[3][2], const bf16x8 (&b)[3][4], f32x4 (&acc)[2][4]) {
#pragma unroll
    for (int s = 0; s < NSTEP; ++s)
#pragma unroll
        for (int h = 0; h < 2; ++h)
#pragma unroll
            for (int cb = 0; cb < 4; ++cb) acc[h][cb] = __builtin_amdgcn_mfma_f32_16x16x32_bf16(a[s][h], b[s][cb], acc[h][cb], 0, 0, 0);
}
__device__ __forceinline__ void tail_reduce(f32x4 (&acc)[2][4], float* part, int wave, int lane) {
    if (wave) { float* mine = part + (wave - 1) * 2048 + lane;
#pragma unroll
        for (int h = 0; h < 2; ++h)
#pragma unroll
            for (int cb = 0; cb < 4; ++cb)
#pragma unroll
                for (int r = 0; r < 4; ++r) mine[((h * 4 + cb) * 4 + r) * 64] = acc[h][cb][r]; }
    __syncthreads();
    if (!wave) {
#pragma unroll 2
        for (int o = 0; o < 7; ++o)
#pragma unroll
            for (int h = 0; h < 2; ++h)
#pragma unroll
                for (int cb = 0; cb < 4; ++cb)
#pragma unroll
                    for (int r = 0; r < 4; ++r) acc[h][cb][r] += part[o * 2048 + ((h * 4 + cb) * 4 + r) * 64 + lane];
    }
}
__device__ __forceinline__ void tail_res(const bf16_t* A, const bf16_t* Bt, int K, float* hout, bf16_t* hb, float* ssq, int feed, const float* lnf, unsigned* cntT, int bx, int wave, int lane, float* part) {
    const int task = bx, rb = task >> 4, cg = task & 15, row0 = TAIL_ROW0 + 32 * rb, col0 = 64 * cg, c = lane & 15, q4 = lane >> 4;
    f32x4 acc[2][4];
#pragma unroll
    for (int h = 0; h < 2; ++h)
#pragma unroll
        for (int cb = 0; cb < 4; ++cb) acc[h][cb] = (f32x4){0.f, 0.f, 0.f, 0.f};
    unsigned short hbv[2][4][4] = {};
    float lnv[4] = {0.f, 0.f, 0.f, 0.f};
    if (wave == 0 && task < TAIL_TASKS) {
#pragma unroll
        for (int h = 0; h < 2; ++h)
#pragma unroll
            for (int r = 0; r < 4; ++r)
#pragma unroll
                for (int cb = 0; cb < 4; ++cb) hbv[h][r][cb] = hb[(size_t)(row0 + 16 * h + 4 * q4 + r) * 1024 + col0 + c + 16 * cb];
        if (lnf) {
#pragma unroll
            for (int cb = 0; cb < 4; ++cb) lnv[cb] = lnf[col0 + c + 16 * cb]; }
    }
    if (task < TAIL_TASKS) {
        const int Ke = K >> 3; const bf16_t* ap = A + (size_t)(row0 + c) * K + wave * Ke + 8 * q4; const bf16_t* bp = Bt + (size_t)(col0 + c) * K + wave * Ke + 8 * q4;
        if (Ke == 128) tail_chunk<4>(ap, bp, K, acc);
        else {
            bf16x8 a0[3][2], b0[3][4], a1[3][2], b1[3][4];
            tail_ld<3>(ap, bp, K, a0, b0); tail_ld<3>(ap + 96, bp + 96, K, a1, b1); __builtin_amdgcn_sched_barrier(0);
            tail_mm<3>(a0, b0, acc); __builtin_amdgcn_sched_barrier(0);
            tail_ld<3>(ap + 192, bp + 192, K, a0, b0); __builtin_amdgcn_sched_barrier(0);
            tail_mm<3>(a1, b1, acc); __builtin_amdgcn_sched_barrier(0);
            tail_ld<2>(ap + 288, bp + 288, K, a1, b1); __builtin_amdgcn_sched_barrier(0);
            tail_mm<3>(a0, b0, acc); tail_mm<2>(a1, b1, acc);
        }
    }
    tail_reduce(acc, part, wave, lane);
    if (wave == 0 && task < TAIL_TASKS && lnf) {
        float hvv[2][4][4];
#pragma unroll
        for (int h = 0; h < 2; ++h)
#pragma unroll
            for (int r = 0; r < 4; ++r) { const int row = row0 + 16 * h + 4 * q4 + r; float ss = 0.f;
#pragma unroll
                for (int cb = 0; cb < 4; ++cb) { const float hv = __builtin_bit_cast(float, (unsigned)hbv[h][r][cb] << 16) + acc[h][cb][r]; hvv[h][r][cb] = hv; ss += hv * hv; }
                ss += __shfl_xor(ss, 1); ss += __shfl_xor(ss, 2); ss += __shfl_xor(ss, 4); ss += __shfl_xor(ss, 8);
                if (c == 0) __hip_atomic_store(ssq + (size_t)row * 16 + cg, ss, __ATOMIC_RELAXED, __HIP_MEMORY_SCOPE_AGENT); }
        asm volatile("s_waitcnt vmcnt(0)" ::: "memory");
        unsigned* cn = cntT + 16 * rb;
        if (lane == 0) { const unsigned one = 1u; asm volatile("global_atomic_add %0, %1, off" :: "v"(cn), "v"(one) : "memory");
            unsigned sp = 0; while (__hip_atomic_load(cn, __ATOMIC_RELAXED, __HIP_MEMORY_SCOPE_AGENT) < 16u) { __builtin_amdgcn_s_sleep(2); if (++sp > (1u << 18)) break; } }
        __builtin_amdgcn_fence(__ATOMIC_ACQUIRE, "agent"); asm volatile("s_waitcnt vmcnt(0)" ::: "memory");
#pragma unroll
        for (int h = 0; h < 2; ++h)
#pragma unroll
            for (int r = 0; r < 4; ++r) { const int row = row0 + 16 * h + 4 * q4 + r; const f32x4* p = (const f32x4*)(ssq + (size_t)row * 16); const f32x4 a = p[0], b = p[1], cc = p[2], d = p[3];
                const float s = (((a[0] + a[1]) + (a[2] + a[3])) + ((b[0] + b[1]) + (b[2] + b[3]))) + (((cc[0] + cc[1]) + (cc[2] + cc[3])) + ((d[0] + d[1]) + (d[2] + d[3])));
                const float rs = __builtin_amdgcn_rsqf(s * (1.0f / 1024.0f) + cfg::RMS_EPS); float* hr = hout + (size_t)(row - 3 * cfg::L - cfg::MEND + 3 * cfg::SEQ) * cfg::DM + col0 + c;
#pragma unroll
                for (int cb = 0; cb < 4; ++cb) hr[16 * cb] = hvv[h][r][cb] * rs * lnv[cb]; }
    } else if (wave == 0 && task < TAIL_TASKS) {
#pragma unroll
        for (int h = 0; h < 2; ++h)
#pragma unroll
            for (int r = 0; r < 4; ++r) { const int row = row0 + 16 * h + 4 * q4 + r; bf16_t* br = hb + (size_t)row * 1024 + col0 + c; float ss = 0.f;
#pragma unroll
                for (int cb = 0; cb < 4; ++cb) { const float hv = __builtin_bit_cast(float, (unsigned)hbv[h][r][cb] << 16) + acc[h][cb][r]; br[16 * cb] = (bf16_t)f2bf(hv); ss += hv * hv; }
                ss += __shfl_xor(ss, 1); ss += __shfl_xor(ss, 2); ss += __shfl_xor(ss, 4); ss += __shfl_xor(ss, 8);
                if (feed && c == 0) ssq[(size_t)row * 16 + cg] = ss; }
    }
    __syncthreads();
}
__device__ __forceinline__ void tail_branch(const bf16_t* Y, const bf16_t* Wbt, const unsigned char* gate, bf16_t* out, int bx, int wave, int lane, float* part) {
    const int task = bx, n = wave >> 1, kh = wave & 1;
    const int rb = task >> 4, cg = task & 15, row0 = TAIL_ROW0 + 32 * rb, col0 = 64 * cg, c = lane & 15, q4 = lane >> 4;
    f32x4 acc[2][4];
#pragma unroll
    for (int h = 0; h < 2; ++h)
#pragma unroll
        for (int cb = 0; cb < 4; ++cb) acc[h][cb] = (f32x4){0.f, 0.f, 0.f, 0.f};
    if (task < TAIL_TASKS) {
        unsigned char gbv[2][4][4];
#pragma unroll
        for (int h = 0; h < 2; ++h)
#pragma unroll
            for (int r = 0; r < 4; ++r) { const int row = row0 + 16 * h + 4 * q4 + r, rr = row & 255;
#pragma unroll
                for (int cb = 0; cb < 4; ++cb) { const int col = col0 + 16 * cb + c, cc = col & 255;
                    const int w_ = ((rr >> 6) & 1) * 4 + ((cc >> 5) & 3), idx = (((w_ * 2 + (rr >> 7)) * 4 + ((rr >> 4) & 3)) * 64 + ((cc >> 2) & 3) * 16 + (rr & 15)) * 4 + (cc >> 7) * 2 + ((cc >> 4) & 1);
                    gbv[h][r][cb] = gate[(size_t)(((row >> 8) * 4 + (col >> 8)) * 4 + n) * 65536 + (size_t)idx * 4 + (cc & 3)]; } }
        tail_chunk<4>(Y + (size_t)(row0 + c) * 1024 + 256 * n + 128 * kh + 8 * q4, Wbt + (size_t)(col0 + c) * 1024 + 256 * n + 128 * kh + 8 * q4, 1024, acc);
#pragma unroll
        for (int h = 0; h < 2; ++h)
#pragma unroll
            for (int r = 0; r < 4; ++r)
#pragma unroll
                for (int cb = 0; cb < 4; ++cb) acc[h][cb][r] *= __builtin_fmaf((float)gbv[h][r][cb], 1.0f / 256.0f, 0.5f / 256.0f);
    }
    tail_reduce(acc, part, wave, lane);
    if (wave == 0 && task < TAIL_TASKS) {
#pragma unroll
        for (int h = 0; h < 2; ++h)
#pragma unroll
            for (int r = 0; r < 4; ++r) { bf16_t* op = out + (size_t)(row0 + 16 * h + 4 * q4 + r) * 1024 + col0 + c;
#pragma unroll
                for (int cb = 0; cb < 4; ++cb) op[16 * cb] = (bf16_t)f2bf(acc[h][cb][r]); }
    }
    __syncthreads();
}
template <class Epi, class Sched, bool ALIGN_EPI = false, bool SP2 = false>
__device__ __forceinline__ void gemm_phase(PG8_LAS unsigned char* lds, const Gemm g, const Sched& S, const Epi& E, int tid_in) {
    int tid_l = tid_in; asm volatile("" : "+v"(tid_l));
    const int tid = tid_l, wid = __builtin_amdgcn_readfirstlane(tid >> 6), lane = tid & 63, wr = wid >> 2, wc = wid & 3, fr = lane & 15, fq = lane >> 4;
    const int K = g.K, nt = K / BK;
    unsigned voffA[2], voffB[2];
#pragma unroll
    for (int i = 0; i < 2; ++i) { int R, C; stage_rc(tid * 16 + i * 8192, R, C); const int Rb = Epi::PERM ? ((R & ~31) + perm32(R & 31)) : R;
        voffA[i] = (unsigned)(R * K + C) * 2u; voffB[i] = (unsigned)(Rb * K + C) * 2u; }
    const size_t kstep = (size_t)(BK * 2);
    const size_t hstep = (size_t)HALF * K * 2;
    const size_t tstep = 2 * hstep;
    const unsigned ldsw = (unsigned)wid * 1024u;
    const int aoff = lds_byte(wr * 64 + fr, fq * 8), boff = lds_byte(wc * 32 + fr, fq * 8);
#define PG8_SA(b, h) (((b) * 2 + (h)) * HTB)
#define PG8_SB(b, h) ((4 + (b) * 2 + (h)) * HTB)
#define PG8_STAGE(bufoff, gbase, voff) do { _Pragma("unroll") for (int _i = 0; _i < 2; ++_i) \
        __builtin_amdgcn_global_load_lds((const unsigned*)((const char*)(gbase) + (voff)[_i]), (PG8_LAS unsigned*)(lds + (bufoff) + ldsw + _i * 8192), 16, 0, 0); } while (0)
#define PG8_LDA(dst, b, h) do { _Pragma("unroll") for (int m = 0; m < 4; ++m) _Pragma("unroll") for (int k = 0; k < 2; ++k) dst[m][k] = *(const PG8_LAS bf16x8*)(lds + PG8_SA(b, h) + aoff + m * 2048 + k * 1024); } while (0)
#define PG8_LDB(dst, b, h) do { _Pragma("unroll") for (int n = 0; n < 2; ++n) _Pragma("unroll") for (int k = 0; k < 2; ++k) dst[n][k] = *(const PG8_LAS bf16x8*)(lds + PG8_SB(b, h) + boff + n * 2048 + k * 1024); } while (0)
#define PG8_MMA(ai, bj, At, Bt) do { __builtin_amdgcn_s_setprio(1); _Pragma("unroll") for (int m = 0; m < 4; ++m) _Pragma("unroll") for (int n = 0; n < 2; ++n) _Pragma("unroll") for (int k = 0; k < 2; ++k) \
        acc[ai][bj][m][n] = __builtin_amdgcn_mfma_f32_16x16x32_bf16(Bt[n][k], At[m][k], acc[ai][bj][m][n], 0, 0, 0); __builtin_amdgcn_s_setprio(0); } while (0)
#define PG8_WAIT_V(n) asm volatile("s_waitcnt vmcnt(" #n ")" ::: "memory")
#define PG8_WAIT_L(n) asm volatile("s_waitcnt lgkmcnt(" #n ")" ::: "memory")
#define PG8_BAR __builtin_amdgcn_s_barrier()
#define PG8_SCHED __builtin_amdgcn_sched_barrier(0)
    Unit cur, nxt; int ui = 0;
    if (!S.next(0, cur)) return;
    f32x4 acc[2][2][4][2];
#pragma unroll
    for (int a = 0; a < 2; ++a)
#pragma unroll
        for (int b = 0; b < 2; ++b)
#pragma unroll
            for (int m = 0; m < 4; ++m)
#pragma unroll
                for (int n = 0; n < 2; ++n) acc[a][b][m][n] = (f32x4){0.f, 0.f, 0.f, 0.f};
    bf16x8 At[4][2], B0[2][2], B1[2][2];
    const char* cA = (const char*)g.A + (size_t)cur.pm * tstep; const char* cB = (const char*)g.Bt + (size_t)cur.pn * tstep;
    S.a_ready(cur);
    if constexpr (SP2) {
        PG8_STAGE(PG8_SB(0, 0), cB, voffB); PG8_STAGE(PG8_SB(0, 1), cB + hstep, voffB); PG8_STAGE(PG8_SA(0, 0), cA, voffA); PG8_STAGE(PG8_SA(0, 1), cA + hstep, voffA);
        if (wr == 1) PG8_BAR;
        PG8_WAIT_V(2); PG8_BAR;
        PG8_STAGE(PG8_SB(1, 0), cB + kstep, voffB); PG8_STAGE(PG8_SA(1, 0), cA + kstep, voffA); PG8_STAGE(PG8_SB(1, 1), cB + hstep + kstep, voffB);
        PG8_WAIT_V(6); PG8_BAR;
    } else {
        PG8_STAGE(PG8_SB(0, 0), cB, voffB); PG8_STAGE(PG8_SA(0, 0), cA, voffA); PG8_STAGE(PG8_SB(0, 1), cB + hstep, voffB); PG8_STAGE(PG8_SA(0, 1), cA + hstep, voffA);
        if (wr == 1) PG8_BAR;
        PG8_WAIT_V(4); PG8_BAR;
        PG8_STAGE(PG8_SB(1, 0), cB + kstep, voffB); PG8_STAGE(PG8_SA(1, 0), cA + kstep, voffA); PG8_STAGE(PG8_SB(1, 1), cB + hstep + kstep, voffB);
        PG8_WAIT_V(6); PG8_BAR;
    }
    for (;;) {
        const bool has_next = S.next(ui + 1, nxt);
        const char* nA = has_next ? (const char*)g.A + (size_t)nxt.pm * tstep : cA; const char* nB = has_next ? (const char*)g.Bt + (size_t)nxt.pn * tstep : cB;
        for (int t = 0; t < nt; t += 2) {
            const bool last = (t == nt - 2);
            if constexpr (Epi::HOOK) { if (t != 0 && (t & 3) == 0) E.hook(acc, cur, t, wr, wc, fr, fq); }
            const char* a1 = cA + (size_t)(t + 1) * kstep;
            const char* a2 = last ? nA : cA + (size_t)(t + 2) * kstep; const char* b2 = last ? nB : cB + (size_t)(t + 2) * kstep;
            const char* a3 = a2 + kstep; const char* b3 = b2 + kstep;
            if (last && has_next) S.a_ready(nxt);
            if constexpr (SP2) {
            PG8_LDB(B0, 0, 0); PG8_LDB(B1, 0, 1); PG8_SCHED; PG8_LDA(At, 0, 0); PG8_STAGE(PG8_SA(1, 1), a1 + hstep, voffA);
            PG8_WAIT_V(8); PG8_WAIT_L(0); PG8_BAR; PG8_MMA(0, 0, At, B0); PG8_MMA(0, 1, At, B1); PG8_BAR; PG8_SCHED;
            PG8_LDA(At, 0, 1); PG8_STAGE(PG8_SB(0, 0), b2, voffB); PG8_STAGE(PG8_SB(0, 1), b2 + hstep, voffB); PG8_STAGE(PG8_SA(0, 0), a2, voffA);
            PG8_WAIT_V(8); PG8_WAIT_L(0); PG8_BAR; PG8_MMA(1, 0, At, B0); PG8_MMA(1, 1, At, B1); PG8_BAR; PG8_SCHED;
            PG8_LDB(B0, 1, 0); PG8_LDB(B1, 1, 1); PG8_SCHED; PG8_LDA(At, 1, 0); PG8_STAGE(PG8_SA(0, 1), a2 + hstep, voffA);
            PG8_WAIT_V(8); PG8_WAIT_L(0); PG8_BAR; PG8_MMA(0, 0, At, B0); PG8_MMA(0, 1, At, B1); PG8_BAR; PG8_SCHED;
            PG8_LDA(At, 1, 1); PG8_STAGE(PG8_SB(1, 0), b3, voffB); PG8_STAGE(PG8_SB(1, 1), b3 + hstep, voffB); PG8_STAGE(PG8_SA(1, 0), a3, voffA);
            PG8_WAIT_V(8); PG8_WAIT_L(0); PG8_BAR; PG8_MMA(1, 0, At, B0); PG8_MMA(1, 1, At, B1); PG8_BAR; PG8_SCHED;
            } else {
            PG8_LDB(B0, 0, 0); PG8_SCHED; PG8_LDA(At, 0, 0); PG8_STAGE(PG8_SA(1, 1), a1 + hstep, voffA);
            PG8_WAIT_L(8); PG8_BAR; PG8_WAIT_L(0); PG8_MMA(0, 0, At, B0); PG8_BAR; PG8_SCHED;
            PG8_LDB(B1, 0, 1); PG8_STAGE(PG8_SB(0, 0), b2, voffB);
            PG8_BAR; PG8_WAIT_L(0); PG8_MMA(0, 1, At, B1); PG8_BAR;
            PG8_LDA(At, 0, 1); PG8_STAGE(PG8_SA(0, 0), a2, voffA);
            PG8_BAR; PG8_WAIT_L(0); PG8_MMA(1, 0, At, B0); PG8_BAR; PG8_SCHED;
            PG8_STAGE(PG8_SB(0, 1), b2 + hstep, voffB);
            PG8_WAIT_V(6); PG8_BAR; PG8_MMA(1, 1, At, B1); PG8_BAR;
            PG8_LDB(B0, 1, 0); PG8_SCHED; PG8_LDA(At, 1, 0); PG8_STAGE(PG8_SA(0, 1), a2 + hstep, voffA);
            PG8_WAIT_L(8); PG8_BAR; PG8_WAIT_L(0); PG8_MMA(0, 0, At, B0); PG8_BAR; PG8_SCHED;
            PG8_LDB(B1, 1, 1); PG8_STAGE(PG8_SB(1, 0), b3, voffB);
            PG8_BAR; PG8_WAIT_L(0); PG8_MMA(0, 1, At, B1); PG8_BAR;
            PG8_LDA(At, 1, 1); PG8_STAGE(PG8_SA(1, 0), a3, voffA);
            PG8_BAR; PG8_WAIT_L(0); PG8_MMA(1, 0, At, B0); PG8_BAR; PG8_SCHED;
            PG8_STAGE(PG8_SB(1, 1), b3 + hstep, voffB);
            PG8_WAIT_V(6); PG8_BAR; PG8_MMA(1, 1, At, B1); PG8_BAR;
            }
        }
        if constexpr (ALIGN_EPI) { if (wr == 0) PG8_BAR; }
        if constexpr (!Epi::AFTER_DRAIN) { E(acc, cur, wr, wc, fr, fq); S.done(cur); }
        if (!has_next) break;
#pragma unroll
        for (int a = 0; a < 2; ++a)
#pragma unroll
            for (int b = 0; b < 2; ++b)
#pragma unroll
                for (int m = 0; m < 4; ++m)
#pragma unroll
                    for (int n = 0; n < 2; ++n) acc[a][b][m][n] = (f32x4){0.f, 0.f, 0.f, 0.f};
        cur = nxt; cA = nA; cB = nB; ++ui;
        if constexpr (ALIGN_EPI) { if (wr == 1) PG8_BAR; }
    }
    PG8_WAIT_V(0);
    if constexpr (!ALIGN_EPI) { if (wr == 0) PG8_BAR; }
    PG8_BAR;
    if constexpr (Epi::AFTER_DRAIN) { E.fused(acc, cur, wr, wc, fr, fq, lds, wid, lane); S.done(cur); }
#undef PG8_SA
#undef PG8_SB
#undef PG8_STAGE
#undef PG8_LDA
#undef PG8_LDB
#undef PG8_MMA
#undef PG8_WAIT_V
#undef PG8_WAIT_L
#undef PG8_BAR
#undef PG8_SCHED
}
}

namespace att {
typedef short bf16x8 __attribute__((ext_vector_type(8)));
typedef short s16x4 __attribute__((ext_vector_type(4)));
typedef float f32x16 __attribute__((ext_vector_type(16)));
typedef unsigned u32x4 __attribute__((ext_vector_type(4)));
typedef float f32x4 __attribute__((ext_vector_type(4)));
constexpr int SLOTB = 8192, LDS_K = 0, LDS_V = 3 * SLOTB, LDS_WS = 6 * SLOTB, LDS_OST = LDS_WS + 8 * 256, OST_W = 8448, LDS_END = LDS_OST + 8 * OST_W, LDS_LUT = 131072 + 1024;
static_assert(LDS_END <= 131072 && LDS_LUT + 2 * 4352 <= cfg::LDS_BYTES, "attention LDS map");
__device__ __forceinline__ int crow(int r, int hi) { return (r & 3) + 8 * (r >> 2) + 4 * hi; }
__device__ __forceinline__ void glds16(const void* gsrc, unsigned lds_dst) { unsigned keep;
    asm volatile("s_mov_b32 %0, m0\n\ts_mov_b32 m0, %2\n\ts_nop 0\n\tglobal_load_lds_dwordx4 %1, off\n\ts_mov_b32 m0, %0" : "=&s"(keep) : "v"(gsrc), "s"(lds_dst) : "memory"); }
typedef float f32x2_t __attribute__((ext_vector_type(2))); typedef __bf16 bf16x2_t __attribute__((ext_vector_type(2)));
__device__ __forceinline__ unsigned cvtpk_s(float lo, float hi) { f32x2_t v = {lo, hi}; bf16x2_t b = __builtin_convertvector(v, bf16x2_t); return __builtin_bit_cast(unsigned, b); }
#define ATT_WAIT_BAR(N) asm volatile("s_waitcnt vmcnt(" #N ") lgkmcnt(0)\n\ts_barrier" ::: "memory")
#define ATT_MFMA(a, b, c) __builtin_amdgcn_mfma_f32_32x32x16_bf16(a, b, c, 0, 0, 0)

__device__ __forceinline__ void pv(f32x16* o, int vb, bf16x8 pa0, bf16x8 pa1, bf16x8 pa2, bf16x8 pa3) {
#pragma unroll
    for (int d0 = 0; d0 < 2; ++d0) { s16x4 lo[4], hi[4];
#pragma unroll
        for (int ks = 0; ks < 4; ++ks) {
            asm volatile("ds_read_b64_tr_b16 %0,%1 offset:%c2" : "=&v"(lo[ks]) : "v"(vb), "i"(d0 * 4096 + ks * 1024) : "memory");
            asm volatile("ds_read_b64_tr_b16 %0,%1 offset:%c2" : "=&v"(hi[ks]) : "v"(vb), "i"(d0 * 4096 + ks * 1024 + 512) : "memory"); }
        asm volatile("s_waitcnt lgkmcnt(0)" ::: "memory"); __builtin_amdgcn_sched_barrier(0);
#define ATT_PK(k) (bf16x8){lo[k][0], lo[k][1], lo[k][2], lo[k][3], hi[k][0], hi[k][1], hi[k][2], hi[k][3]}
        o[d0] = ATT_MFMA(pa0, ATT_PK(0), o[d0]);
        o[d0] = ATT_MFMA(pa1, ATT_PK(1), o[d0]);
        o[d0] = ATT_MFMA(pa2, ATT_PK(2), o[d0]);
        o[d0] = ATT_MFMA(pa3, ATT_PK(3), o[d0]);
#undef ATT_PK
    }
}

struct Ctx { const unsigned char* mix; bf16* Y; const float* sink; const float* subg; float lam, lam_scale; };

template <int MODE>
__device__ __forceinline__ void attn_unit(const Ctx& C, int item, char* shm, int tid) {
    using cfg::L; using cfg::T;
    constexpr int NK = (MODE == 2) ? 2 : 4;
    const int lane = tid & 63, r32 = lane & 31, hi = lane >> 5; const int wid = __builtin_amdgcn_readfirstlane(tid >> 6);
    const bf16* Qg = (const bf16*)C.mix; const bf16* Kg = (const bf16*)(C.mix + (size_t)T * 512); const bf16* Vg = (const bf16*)(C.mix + (size_t)T * 768);
    const int kvh = item & 1; int b, qpos0, h, kc0 = 0;
    if (MODE == 2) { const int qi = (item >> 1) % 66; b = (item >> 1) / 66; const int g = wid >> 2, c = (wid >> 1) & 1, rb = wid & 1; h = 2 * kvh + g; qpos0 = 64 * qi + 32 * rb; kc0 = 2 * c; }
    else { const int qb = (item >> 1) % 33; b = (item >> 1) / 33; h = 2 * kvh + (wid >> 2); qpos0 = 128 * qb + 32 * (wid & 3); }
    const int qpos = qpos0 + r32; const long mrow = (long)b * L + qpos;
    int kt_lo, nwin, NT;
    if (MODE == 0) { const int qb = qpos0 >> 7; kt_lo = 2 * qb - 2; if (kt_lo < 2) kt_lo = 2; int kt_hi = 2 * qb + 3; if (kt_hi > 65) kt_hi = 65; nwin = kt_hi - kt_lo + 1; NT = nwin + 1; }
    else { kt_lo = 1; nwin = 65; NT = 65; }
#define ATT_KT(t) ((t) < nwin ? kt_lo + (t) : 1)
    const unsigned lds0 = (unsigned)(uintptr_t)shm;
    float* wsf = (float*)(shm + LDS_WS) + wid * 64;
    const float* lutS = (const float*)(shm + LDS_LUT) + (MODE == 0 ? 1088 : 0);
    const bf16* Kh = Kg + (size_t)b * L * 128 + kvh * 64; const bf16* Vh = Vg + (size_t)b * L * 128 + kvh * 64;
    const bf16* ksrc = Kh + (long)lane * 128 + wid * 8;
    const bf16* vsrc = Vh + (long)(16 * (wid & 3) + (lane >> 2)) * 128 + (wid >> 2) * 32 + (lane & 3) * 8;
    const unsigned kdst = lds0 + LDS_K + wid * 1024, vdst = lds0 + LDS_V + wid * 1024;
#define ATT_DMA(t, slot) do { const long ko_ = (long)ATT_KT(t) * 64 * 128; glds16(ksrc + ko_, (unsigned)__builtin_amdgcn_readfirstlane(kdst + (slot))); glds16(vsrc + ko_, (unsigned)__builtin_amdgcn_readfirstlane(vdst + (slot))); } while (0)
    const int vb0 = (int)(lds0 + LDS_V) + ((lane >> 4) & 1) * 32 + (lane & 3) * 8 + (4 * hi + ((lane & 15) >> 2)) * 64;
    bf16x8 qr[NK];
    { const bf16* qp = Qg + mrow * 256 + h * 64 + 16 * kc0 + 8 * hi;
#pragma unroll
      for (int d0 = 0; d0 < NK; ++d0) qr[d0] = *(const bf16x8*)(qp + 16 * d0); }
    ATT_DMA(0, 0); if (NT > 1) ATT_DMA(1, SLOTB);
    float m_run = -1e30f, l_run = 0.f; f32x16 o[2];
#pragma unroll
    for (int r = 0; r < 16; ++r) { o[0][r] = 0.f; o[1][r] = 0.f; }
    int sl_cur = 0, sl_nn = 2 * SLOTB;
    for (int t = 0; t < NT; ++t) {
        if (t + 1 < NT) ATT_WAIT_BAR(2); else ATT_WAIT_BAR(0);
        if (t + 2 < NT) ATT_DMA(t + 2, sl_nn);
        const int kt = ATT_KT(t), k0 = kt * 64;
        float cinit = 0.f; bool near = false;
        if (MODE == 2) { if (k0 + 63 - qpos0 <= -128) cinit = lutS[h * 260]; else if (k0 - qpos0 - 31 >= 128) cinit = lutS[h * 260 + 256]; else near = true; }
        if (MODE == 0) near = true;
        f32x16 p0, p1;
        { const char* kb = shm + LDS_K + sl_cur + hi * 1024 + r32 * 16 + kc0 * 2048;
          f32x16 cz;
#pragma unroll
          for (int r = 0; r < 16; ++r) cz[r] = cinit;
#pragma unroll
          for (int d0 = 0; d0 < NK; ++d0) { const bf16x8 b0 = *(const bf16x8*)(kb + d0 * 2048), b1 = *(const bf16x8*)(kb + d0 * 2048 + 512);
              if (d0 == 0) { p0 = ATT_MFMA(b0, qr[0], cz); p1 = ATT_MFMA(b1, qr[0], cz); } else { p0 = ATT_MFMA(b0, qr[d0], p0); p1 = ATT_MFMA(b1, qr[d0], p1); } } }
        if (near) {
#pragma unroll
            for (int r = 0; r < 16; ++r) { const int j = crow(r, hi);
                int rel0 = k0 + j - qpos, rel1 = rel0 + 32;
                const int c0 = rel0 < -128 ? -128 : (rel0 > 128 ? 128 : rel0), c1 = rel1 < -128 ? -128 : (rel1 > 128 ? 128 : rel1);
                p0[r] += lutS[h * 260 + c0 + 128]; p1[r] += lutS[h * 260 + c1 + 128];
                if (MODE == 0 && kt != 1) { if (rel0 < -128 || rel0 > 128) p0[r] = -INFINITY; if (rel1 < -128 || rel1 > 128) p1[r] = -INFINITY; } }
        }
        if (kt == 1) {
#pragma unroll
            for (int r = 0; r < 16; ++r) { p0[r] = -INFINITY; if (r < 8) p1[r] = -INFINITY; }
        }
        float rm = fmaxf(p0[0], p1[0]);
#pragma unroll
        for (int r = 1; r < 16; ++r) rm = fmaxf(rm, fmaxf(p0[r], p1[r]));
        { auto rr = __builtin_amdgcn_permlane32_swap(__float_as_uint(rm), __float_as_uint(rm), false, false); rm = fmaxf(__uint_as_float(rr[0]), __uint_as_float(rr[1])); }
        bool resc = false;
        if (__any(rm > m_run + 8.0f)) { const float mn = fmaxf(m_run, rm); const float alpha = fexp2(m_run - mn); m_run = mn; l_run *= alpha; if (hi == 0) wsf[r32] = alpha; resc = true; }
        float sacc = 0.f;
#pragma unroll
        for (int r = 0; r < 16; ++r) { p0[r] = fexp2(p0[r] - m_run); p1[r] = fexp2(p1[r] - m_run); sacc += p0[r] + p1[r]; }
        l_run += sacc;
        if (resc) {
            asm volatile("s_waitcnt lgkmcnt(0)" ::: "memory");
#pragma unroll
            for (int r = 0; r < 16; ++r) { const float f = wsf[crow(r, hi)]; o[0][r] *= f; o[1][r] *= f; }
        }
        u32x4 pw0 = {cvtpk_s(p0[0], p0[1]), cvtpk_s(p0[2], p0[3]), cvtpk_s(p0[4], p0[5]), cvtpk_s(p0[6], p0[7])};
        u32x4 pw1 = {cvtpk_s(p0[8], p0[9]), cvtpk_s(p0[10], p0[11]), cvtpk_s(p0[12], p0[13]), cvtpk_s(p0[14], p0[15])};
        u32x4 pw2 = {cvtpk_s(p1[0], p1[1]), cvtpk_s(p1[2], p1[3]), cvtpk_s(p1[4], p1[5]), cvtpk_s(p1[6], p1[7])};
        u32x4 pw3 = {cvtpk_s(p1[8], p1[9]), cvtpk_s(p1[10], p1[11]), cvtpk_s(p1[12], p1[13]), cvtpk_s(p1[14], p1[15])};
        pv(o, vb0 + sl_cur, __builtin_bit_cast(bf16x8, pw0), __builtin_bit_cast(bf16x8, pw1), __builtin_bit_cast(bf16x8, pw2), __builtin_bit_cast(bf16x8, pw3));
        sl_nn = sl_cur; sl_cur = (sl_cur == 2 * SLOTB) ? 0 : sl_cur + SLOTB;
    }
    { auto rr = __builtin_amdgcn_permlane32_swap(__float_as_uint(l_run), __float_as_uint(l_run), false, false); l_run = __uint_as_float(rr[0]) + __uint_as_float(rr[1]); }
    if (MODE == 0) l_run += fexp2(C.sink[h] * cfg::LOG2E - m_run);
    if (hi == 0) wsf[32 + r32] = l_run;
    asm volatile("s_waitcnt lgkmcnt(0)" ::: "memory");
    float rli[16];
#pragma unroll
    for (int r = 0; r < 16; ++r) rli[r] = __builtin_amdgcn_rcpf(wsf[32 + crow(r, hi)]);
    if (MODE != 2) {
        bf16* Ow = C.Y + ((long)b * L + qpos0) * 1024 + (MODE == 0 ? 0 : 256) + h * 64;
        unsigned short* stg = (unsigned short*)(shm + LDS_OST + wid * OST_W);
#pragma unroll
        for (int r = 0; r < 16; ++r) { const int orow = crow(r, hi);
#pragma unroll
            for (int d0 = 0; d0 < 2; ++d0) stg[orow * 64 + d0 * 32 + r32] = (unsigned short)f2bf(o[d0][r] * rli[r]); }
        asm volatile("s_waitcnt lgkmcnt(0)" ::: "memory");
#pragma unroll
        for (int i = 0; i < 4; ++i) { const int row = i * 8 + (lane >> 3), ch = lane & 7; const u32x4 v = *(const u32x4*)(stg + row * 64 + ch * 8); *(u32x4*)(Ow + (long)row * 1024 + ch * 8) = v; }
    } else {
        const int g = wid >> 2, c = (wid >> 1) & 1, rb = wid & 1;
        float* buf = (float*)(shm + LDS_OST + (g * 2 + rb) * OST_W);
        if (c == 1) {
#pragma unroll
            for (int r = 0; r < 16; ++r) { const int orow = crow(r, hi);
#pragma unroll
                for (int d0 = 0; d0 < 2; ++d0) buf[orow * 66 + d0 * 32 + r32] = o[d0][r] * rli[r]; }
        }
        asm volatile("s_waitcnt lgkmcnt(0)\n\ts_barrier" ::: "memory");
        if (c == 0) {
#pragma unroll
            for (int r = 0; r < 16; ++r) { const int orow = crow(r, hi);
#pragma unroll
                for (int d0 = 0; d0 < 2; ++d0) { float* e = buf + orow * 66 + d0 * 32 + r32; *e = o[d0][r] * rli[r] - C.lam * *e; } }
            asm volatile("s_waitcnt lgkmcnt(0)" ::: "memory");
            const int row = lane >> 1, half = lane & 1; const float* src = buf + row * 66 + half * 32;
            float x[32]; float ss = 0.f;
#pragma unroll
            for (int d = 0; d < 32; ++d) { x[d] = src[d]; ss += x[d] * x[d]; }
            ss += __shfl_xor(ss, 1);
            const float rn = __builtin_amdgcn_rsqf(ss * (1.0f / 64.0f) + cfg::RMS_EPS) * C.lam_scale;
            const float* sg = C.subg + half * 32;
            bf16* yp = C.Y + ((long)b * L + qpos0 + row) * 1024 + 512 + h * 64 + half * 32;
#pragma unroll
            for (int d = 0; d < 32; d += 8) { u32x4 w;
                w.x = pk2(x[d] * rn * sg[d], x[d + 1] * rn * sg[d + 1]); w.y = pk2(x[d + 2] * rn * sg[d + 2], x[d + 3] * rn * sg[d + 3]);
                w.z = pk2(x[d + 4] * rn * sg[d + 4], x[d + 5] * rn * sg[d + 5]); w.w = pk2(x[d + 6] * rn * sg[d + 6], x[d + 7] * rn * sg[d + 7]);
                *(u32x4*)(yp + d) = w; }
        }
    }
    asm volatile("s_waitcnt lgkmcnt(0)\n\ts_barrier" ::: "memory");
#undef ATT_DMA
#undef ATT_KT
}
}

namespace att {
typedef __attribute__((address_space(3))) const char* lds_cptr;
typedef short v4i16_t __attribute__((ext_vector_type(4)));
__device__ __forceinline__ s16x4 vtr(lds_cptr p) { return __builtin_bit_cast(s16x4, __builtin_amdgcn_ds_read_tr16_b64_v4i16((__attribute__((address_space(3))) v4i16_t*)p)); }
__device__ __forceinline__ bf16x8 kld(lds_cptr p) { return *(const __attribute__((address_space(3))) bf16x8*)p; }
#define SBAR() __builtin_amdgcn_sched_barrier(0)

template <int MODE>
__device__ __forceinline__ void attn_unit_p(const Ctx& C, int item, char* shm, int tid) {
    using cfg::L; using cfg::T;
    constexpr int NK = (MODE == 2) ? 2 : 4;
    const int lane = tid & 63, r32 = lane & 31, hi = lane >> 5; const int wid = __builtin_amdgcn_readfirstlane(tid >> 6);
    const bf16* Qg = (const bf16*)C.mix; const bf16* Kg = (const bf16*)(C.mix + (size_t)T * 512); const bf16* Vg = (const bf16*)(C.mix + (size_t)T * 768);
    const int kvh = item & 1; int b, qpos0, h, kc0 = 0;
    if (MODE == 2) { const int qi = (item >> 1) % 66; b = (item >> 1) / 66; const int g = wid >> 2, c = (wid >> 1) & 1, rb = wid & 1; h = 2 * kvh + g; qpos0 = 64 * qi + 32 * rb; kc0 = 2 * c; }
    else { const int qb = (item >> 1) % 33; b = (item >> 1) / 33; h = 2 * kvh + (wid >> 2); qpos0 = 128 * qb + 32 * (wid & 3); }
    const int qpos = qpos0 + r32; const long mrow = (long)b * L + qpos;
    int kt_lo = 1, NT = 65;
    if (MODE == 0) { const int qb = qpos0 >> 7; kt_lo = 2 * qb - 2; if (kt_lo < 2) kt_lo = 2; int kt_hi = 2 * qb + 3; if (kt_hi > 65) kt_hi = 65; NT = kt_hi - kt_lo + 2; }
#define ATT_KT(t) (MODE == 0 ? ((t) == 0 ? 1 : kt_lo + (t) - 1) : 1 + (t))
    const unsigned lds0 = (unsigned)(uintptr_t)shm;
    float* wsf = (float*)(shm + LDS_WS) + wid * 64;
    const float* lutS = (const float*)(shm + LDS_LUT) + (MODE == 0 ? 1088 : 0);
    const bf16* Kh = Kg + (size_t)b * L * 128 + kvh * 64; const bf16* Vh = Vg + (size_t)b * L * 128 + kvh * 64;
    const bf16* ksrc = Kh + (long)lane * 128 + wid * 8;
    const bf16* vsrc = Vh + (long)(16 * (wid & 3) + (lane >> 2)) * 128 + (wid >> 2) * 32 + (lane & 3) * 8;
    const unsigned kdst = lds0 + LDS_K + wid * 1024, vdst = lds0 + LDS_V + wid * 1024;
#define DMA_K(t, slot) glds16(ksrc + (long)ATT_KT(t) * 64 * 128, (unsigned)__builtin_amdgcn_readfirstlane(kdst + (slot)))
#define DMA_V(t, slot) glds16(vsrc + (long)ATT_KT(t) * 64 * 128, (unsigned)__builtin_amdgcn_readfirstlane(vdst + (slot)))
    const int vb0 = (int)(lds0 + LDS_V) + ((lane >> 4) & 1) * 32 + (lane & 3) * 8 + (4 * hi + ((lane & 15) >> 2)) * 64;
    const lds_cptr shm3 = (lds_cptr)shm; const lds_cptr kp0 = shm3 + LDS_K + hi * 1024 + r32 * 16 + kc0 * 2048;
    const lds_cptr vp0 = shm3 + LDS_V + ((lane >> 4) & 1) * 32 + (lane & 3) * 8 + (4 * hi + ((lane & 15) >> 2)) * 64;
    bf16x8 kf[2 * NK];
    DMA_K(0, 0); DMA_V(0, 0); DMA_K(1, SLOTB);
    bf16x8 qr[NK];
    { const bf16* qp = Qg + mrow * 256 + h * 64 + 16 * kc0 + 8 * hi;
#pragma unroll
      for (int d0 = 0; d0 < NK; ++d0) qr[d0] = *(const bf16x8*)(qp + 16 * d0); }
    float mhat = 0.f, l_reg = 0.f; f32x16 o[2]; f32x16 negm;
#pragma unroll
    for (int r = 0; r < 16; ++r) { o[0][r] = 0.f; o[1][r] = 0.f; negm[r] = 0.f; }
    asm volatile("" : "+v"(negm));
    bool resc = false;
    f32x16 czp; float czb = 0.f;
#pragma unroll
    for (int r = 0; r < 16; ++r) czp[r] = 0.f;
    const float fbLo = (MODE == 2) ? lutS[h * 260] : 0.f, fbHi = (MODE == 2) ? lutS[h * 260 + 256] : 0.f;
#define FARB(t) ((MODE != 2) ? 0.f : ((ATT_KT(t) * 64 + 63 - qpos0 <= -128) ? fbLo : ((ATT_KT(t) * 64 - qpos0 - 31 >= 128) ? fbHi : 0.f)))
#define HOOK(P0, P1, t) do { const int kt_ = ATT_KT(t), k0_ = kt_ * 64; \
        const bool near_ = (MODE == 0) || (MODE == 2 && !(k0_ + 63 - qpos0 <= -128) && !(k0_ - qpos0 - 31 >= 128)); \
        if (near_) { _Pragma("unroll") for (int r = 0; r < 16; ++r) { const int rel0 = k0_ + crow(r, hi) - qpos, rel1 = rel0 + 32; \
            const int c0_ = rel0 < -128 ? -128 : (rel0 > 128 ? 128 : rel0), c1_ = rel1 < -128 ? -128 : (rel1 > 128 ? 128 : rel1); \
            P0[r] += lutS[h * 260 + c0_ + 128]; P1[r] += lutS[h * 260 + c1_ + 128]; \
            if (MODE == 0 && kt_ != 1) { if (rel0 < -128 || rel0 > 128) P0[r] = -INFINITY; if (rel1 < -128 || rel1 > 128) P1[r] = -INFINITY; } } } \
        if (kt_ == 1) { _Pragma("unroll") for (int r = 0; r < 16; ++r) { P0[r] = -INFINITY; if (r < 8) P1[r] = -INFINITY; } } } while (0)
#define RESC() do { if (resc) { asm volatile("s_waitcnt lgkmcnt(0)" ::: "memory"); \
        _Pragma("unroll") for (int d_ = 0; d_ < 2; ++d_) _Pragma("unroll") for (int r = 0; r < 16; ++r) o[d_][r] *= wsf[crow(r, hi)]; } } while (0)
    f32x16 pA0, pA1, pB0, pB1;
    int sl_prev = 0, sl_cur = 0, sl_next = SLOTB;
#define ROT() do { sl_prev = sl_cur; sl_cur = sl_next; sl_next = (sl_next == 2 * SLOTB) ? 0 : sl_next + SLOTB; } while (0)
    DMA_K(2, 2 * SLOTB);
    ATT_WAIT_BAR(3);
    { f32x16 cz;
#pragma unroll
      for (int r = 0; r < 16; ++r) cz[r] = FARB(0);
#pragma unroll
      for (int d0 = 0; d0 < NK; ++d0) { const bf16x8 b0 = kld(kp0 + d0 * 2048), b1 = kld(kp0 + d0 * 2048 + 512);
          if (d0 == 0) { pA0 = ATT_MFMA(b0, qr[0], cz); pA1 = ATT_MFMA(b1, qr[0], cz); } else { pA0 = ATT_MFMA(b0, qr[d0], pA0); pA1 = ATT_MFMA(b1, qr[d0], pA1); } } }
    HOOK(pA0, pA1, 0);
    { float rm = fmaxf(pA0[0], pA1[0]);
#pragma unroll
      for (int r = 1; r < 16; ++r) rm = fmaxf(rm, fmaxf(pA0[r], pA1[r]));
      { auto rr = __builtin_amdgcn_permlane32_swap(__float_as_uint(rm), __float_as_uint(rm), false, false); rm = fmaxf(__uint_as_float(rr[0]), __uint_as_float(rr[1])); }
      mhat = rm;
#pragma unroll
      for (int r = 0; r < 16; ++r) { pA0[r] = fexp2(pA0[r] - rm); pA1[r] = fexp2(pA1[r] - rm); negm[r] = -mhat; czp[r] = -mhat; }
      asm volatile("" : "+v"(negm)); czb = 0.f; }
    ATT_WAIT_BAR(0);
    if (3 < NT) DMA_K(3, 0); DMA_V(1, SLOTB);
    ROT();
#pragma unroll
    for (int j = 0; j < NK; ++j) { kf[2 * j] = kld(kp0 + sl_cur + j * 2048); kf[2 * j + 1] = kld(kp0 + sl_cur + j * 2048 + 512); }
    ATT_WAIT_BAR(2);
    s16x4 vlo[8], vhi[8]; u32x4 pw0, pw1, pw2, pw3;
#define PKW(P, B) cvtpk_s(P[B], P[B + 1])
#define PAF(k) __builtin_bit_cast(bf16x8, pw##k)
#define VFR(i) (bf16x8){vlo[i][0], vlo[i][1], vlo[i][2], vlo[i][3], vhi[i][0], vhi[i][1], vhi[i][2], vhi[i][3]}
#define PIN(x) asm volatile("" : "+v"(x))
#define MX3(a, b, c) __builtin_fmaxf(__builtin_fmaxf((a), (b)), (c))
#define GAPA(MF, A0, A1, A2, A3, W0, W1, PW) do { MF; sacc += (f32x2_t){A0, A1}; sacc += (f32x2_t){A2, A3}; PIN(sacc); W0; W1; PIN(PW); SBAR(); } while (0)
#define EX(v) __builtin_amdgcn_exp2f(v)
#define GAPB(MF, X, B) do { MF; X[B] = EX(X[B]); X[B + 1] = EX(X[B + 1]); X[B + 2] = EX(X[B + 2]); X[B + 3] = EX(X[B + 3]); PIN(X); SBAR(); } while (0)
#define VRD(i) do { vlo[i] = vtr(vp_ + (((i) >> 2) * 4096 + ((i) & 3) * 1024)); vhi[i] = vtr(vp_ + (((i) >> 2) * 4096 + ((i) & 3) * 1024 + 512)); } while (0)
#define KRD(G, j) do { if ((G) && (j) < NK) { kf[2 * (j)] = kld(kp0 + sl_next + (j) * 2048); kf[2 * (j) + 1] = kld(kp0 + sl_next + (j) * 2048 + 512); SBAR(); } } while (0)
#define QK(n, C0, C1) do { if ((n) < 2 * NK) { if ((n) == 0) C0 = ATT_MFMA(kf[0], qr[0], cz_); else if ((n) == 1) C1 = ATT_MFMA(kf[1], qr[0], cz_); \
        else if (((n) & 1) == 0) C0 = ATT_MFMA(kf[(n) < 2 * NK ? (n) : 0], qr[((n) >> 1) < NK ? ((n) >> 1) : 0], C0); else C1 = ATT_MFMA(kf[(n) < 2 * NK ? (n) : 0], qr[((n) >> 1) < NK ? ((n) >> 1) : 0], C1); } } while (0)
#define STEP(C0, C1, P0, P1, t, GK, GV, GL) do { SBAR(); \
    const lds_cptr vp_ = vp0 + sl_prev; \
    if (MODE == 2) { const float fb_ = FARB(t); if (fb_ != czb) { czb = fb_; _Pragma("unroll") for (int r = 0; r < 16; ++r) czp[r] = negm[r] + fb_; asm volatile("" : "+v"(czp)); } } \
    const f32x16& cz_ = (MODE == 2) ? czp : negm; \
    VRD(0); SBAR(); f32x2_t sacc = {P0[0], P0[1]}; \
    GAPA(QK(0, C0, C1), P0[2], P0[3], P0[4], P0[5],     pw0[0] = PKW(P0, 0), pw0[1] = PKW(P0, 2), pw0); \
    VRD(4); SBAR(); GAPA(QK(1, C0, C1), P0[6], P0[7], P0[8], P0[9],     pw0[2] = PKW(P0, 4), pw0[3] = PKW(P0, 6), pw0); \
    VRD(1); SBAR(); GAPA(QK(2, C0, C1), P0[10], P0[11], P0[12], P0[13], pw1[0] = PKW(P0, 8), pw1[1] = PKW(P0, 10), pw1); \
    VRD(5); SBAR(); GAPA(QK(3, C0, C1), P0[14], P0[15], P1[0], P1[1],   pw1[2] = PKW(P0, 12), pw1[3] = PKW(P0, 14), pw1); \
    VRD(2); SBAR(); GAPA(QK(4, C0, C1), P1[2], P1[3], P1[4], P1[5],     pw2[0] = PKW(P1, 0), pw2[1] = PKW(P1, 2), pw2); \
    VRD(6); SBAR(); GAPA(QK(5, C0, C1), P1[6], P1[7], P1[8], P1[9],     pw2[2] = PKW(P1, 4), pw2[3] = PKW(P1, 6), pw2); \
    VRD(3); SBAR(); GAPA(QK(6, C0, C1), P1[10], P1[11], P1[12], P1[13], pw3[0] = PKW(P1, 8), pw3[1] = PKW(P1, 10), pw3); \
    VRD(7); SBAR(); GAPA(QK(7, C0, C1), P1[14], P1[15], 0.f, 0.f,       pw3[2] = PKW(P1, 12), pw3[3] = PKW(P1, 14), pw3); \
    l_reg += sacc[0] + sacc[1]; \
    if (GK) { DMA_K((t) + 3, sl_cur); } if (GV) { DMA_V((t) + 1, sl_next); } \
    HOOK(C0, C1, t); \
    { float a = MX3(C0[0], C0[1], C1[0]), b_ = MX3(C0[2], C0[3], C1[1]); a = MX3(a, C1[2], C1[3]); \
      _Pragma("unroll") for (int r = 4; r < 16; r += 4) { a = MX3(a, C0[r], C0[r + 1]); b_ = MX3(b_, C0[r + 2], C0[r + 3]); a = MX3(a, C1[r], C1[r + 1]); b_ = MX3(b_, C1[r + 2], C1[r + 3]); } \
      float rm = __builtin_fmaxf(a, b_); { auto rr = __builtin_amdgcn_permlane32_swap(__float_as_uint(rm), __float_as_uint(rm), false, false); rm = __builtin_fmaxf(__uint_as_float(rr[0]), __uint_as_float(rr[1])); } \
      resc = false; \
      if (__builtin_expect(__any(rm > 8.0f), 0)) { const float dl = __builtin_fmaxf(rm, 0.f); mhat += dl; \
        _Pragma("unroll") for (int r = 0; r < 16; ++r) { C0[r] -= dl; C1[r] -= dl; } \
        _Pragma("unroll") for (int r = 0; r < 16; ++r) negm[r] = -mhat; asm volatile("" : "+v"(negm)); \
        if (MODE == 2) { _Pragma("unroll") for (int r = 0; r < 16; ++r) czp[r] = czb - mhat; asm volatile("" : "+v"(czp)); } \
        const float f = __builtin_amdgcn_exp2f(-dl); l_reg *= f; if (hi == 0) wsf[r32] = f; resc = true; } } \
    SBAR(); \
    GAPB(o[0] = ATT_MFMA(PAF(0), VFR(0), o[0]), C0, 0); \
    GAPB(o[1] = ATT_MFMA(PAF(0), VFR(4), o[1]), C0, 4); \
    KRD(GL, 0); GAPB(o[0] = ATT_MFMA(PAF(1), VFR(1), o[0]), C0, 8); \
    KRD(GL, 1); GAPB(o[1] = ATT_MFMA(PAF(1), VFR(5), o[1]), C0, 12); \
    KRD(GL, 2); GAPB(o[0] = ATT_MFMA(PAF(2), VFR(2), o[0]), C1, 0); \
    KRD(GL, 3); GAPB(o[1] = ATT_MFMA(PAF(2), VFR(6), o[1]), C1, 4); \
    GAPB(o[0] = ATT_MFMA(PAF(3), VFR(3), o[0]), C1, 8); \
    GAPB(o[1] = ATT_MFMA(PAF(3), VFR(7), o[1]), C1, 12); \
    } while (0)
#define ENDW(tt) do { if ((tt) + 3 < NT) { ATT_WAIT_BAR(2); } else if ((tt) + 2 < NT) { ATT_WAIT_BAR(1); } else { ATT_WAIT_BAR(0); } } while (0)
#define DRAIN(P0, P1, slot) do { float sacc = P0[0] + P0[1]; _Pragma("unroll") for (int r = 2; r < 16; ++r) sacc += P0[r]; _Pragma("unroll") for (int r = 0; r < 16; ++r) sacc += P1[r]; l_reg += sacc; \
    pw0 = (u32x4){PKW(P0, 0), PKW(P0, 2), PKW(P0, 4), PKW(P0, 6)}; pw1 = (u32x4){PKW(P0, 8), PKW(P0, 10), PKW(P0, 12), PKW(P0, 14)}; pw2 = (u32x4){PKW(P1, 0), PKW(P1, 2), PKW(P1, 4), PKW(P1, 6)}; pw3 = (u32x4){PKW(P1, 8), PKW(P1, 10), PKW(P1, 12), PKW(P1, 14)}; \
    SBAR(); pv(o, vb0 + (slot), PAF(0), PAF(1), PAF(2), PAF(3)); } while (0)
    int t = 1;
    for (; t + 5 < NT; t += 2) {
        STEP(pB0, pB1, pA0, pA1, t, true, true, true);     ATT_WAIT_BAR(2); RESC(); ROT();
        STEP(pA0, pA1, pB0, pB1, t + 1, true, true, true); ATT_WAIT_BAR(2); RESC(); ROT();
    }
    for (; t + 1 < NT; t += 2) {
        STEP(pB0, pB1, pA0, pA1, t, (t + 3 < NT), (t + 1 < NT), (t + 1 < NT));     ENDW(t);     RESC(); ROT();
        STEP(pA0, pA1, pB0, pB1, t + 1, (t + 4 < NT), (t + 2 < NT), (t + 2 < NT)); ENDW(t + 1); RESC(); ROT();
    }
    if (t < NT) { STEP(pB0, pB1, pA0, pA1, t, false, false, false); RESC(); DRAIN(pB0, pB1, sl_cur); }
    else { DRAIN(pA0, pA1, sl_prev); }
#undef PKW
#undef PAF
#undef VFR
#undef PIN
#undef MX3
#undef GAPA
#undef GAPB
#undef EX
#undef VRD
#undef KRD
#undef QK
#undef STEP
#undef ENDW
#undef DRAIN
#undef HOOK
#undef FARB
#undef RESC
#undef ROT
    { auto rr = __builtin_amdgcn_permlane32_swap(__float_as_uint(l_reg), __float_as_uint(l_reg), false, false); l_reg = __uint_as_float(rr[0]) + __uint_as_float(rr[1]); }
    if (MODE == 0) l_reg += fexp2(C.sink[h] * cfg::LOG2E - mhat);
    if (hi == 0) wsf[32 + r32] = l_reg;
    asm volatile("s_waitcnt lgkmcnt(0)" ::: "memory");
    float rli[16];
#pragma unroll
    for (int r = 0; r < 16; ++r) rli[r] = __builtin_amdgcn_rcpf(wsf[32 + crow(r, hi)]);
    if (MODE != 2) {
        bf16* Ow = C.Y + ((long)b * L + qpos0) * 1024 + (MODE == 0 ? 0 : 256) + h * 64;
        unsigned short* stg = (unsigned short*)(shm + LDS_OST + wid * OST_W);
#pragma unroll
        for (int r = 0; r < 16; ++r) { const int orow = crow(r, hi);
#pragma unroll
            for (int d0 = 0; d0 < 2; ++d0) stg[orow * 64 + d0 * 32 + r32] = (unsigned short)f2bf(o[d0][r] * rli[r]); }
        asm volatile("s_waitcnt lgkmcnt(0)" ::: "memory");
#pragma unroll
        for (int i = 0; i < 4; ++i) { const int row = i * 8 + (lane >> 3), ch = lane & 7; const u32x4 v = *(const u32x4*)(stg + row * 64 + ch * 8); *(u32x4*)(Ow + (long)row * 1024 + ch * 8) = v; }
    } else {
        const int g = wid >> 2, c = (wid >> 1) & 1, rb = wid & 1;
        float* buf = (float*)(shm + LDS_OST + (g * 2 + rb) * OST_W);
        if (c == 1) {
#pragma unroll
            for (int r = 0; r < 16; ++r) { const int orow = crow(r, hi);
#pragma unroll
                for (int d0 = 0; d0 < 2; ++d0) buf[orow * 66 + d0 * 32 + r32] = o[d0][r] * rli[r]; }
        }
        asm volatile("s_waitcnt lgkmcnt(0)\n\ts_barrier" ::: "memory");
        if (c == 0) {
#pragma unroll
            for (int r = 0; r < 16; ++r) { const int orow = crow(r, hi);
#pragma unroll
                for (int d0 = 0; d0 < 2; ++d0) { float* e = buf + orow * 66 + d0 * 32 + r32; *e = o[d0][r] * rli[r] - C.lam * *e; } }
            asm volatile("s_waitcnt lgkmcnt(0)" ::: "memory");
            const int row = lane >> 1, half = lane & 1; const float* src = buf + row * 66 + half * 32;
            float x[32]; float ss = 0.f;
#pragma unroll
            for (int d = 0; d < 32; ++d) { x[d] = src[d]; ss += x[d] * x[d]; }
            ss += __shfl_xor(ss, 1);
            const float rn = __builtin_amdgcn_rsqf(ss * (1.0f / 64.0f) + cfg::RMS_EPS) * C.lam_scale;
            const float* sg = C.subg + half * 32;
            bf16* yp = C.Y + ((long)b * L + qpos0 + row) * 1024 + 512 + h * 64 + half * 32;
#pragma unroll
            for (int d = 0; d < 32; d += 8) { u32x4 w;
                w.x = pk2(x[d] * rn * sg[d], x[d + 1] * rn * sg[d + 1]); w.y = pk2(x[d + 2] * rn * sg[d + 2], x[d + 3] * rn * sg[d + 3]);
                w.z = pk2(x[d + 4] * rn * sg[d + 4], x[d + 5] * rn * sg[d + 5]); w.w = pk2(x[d + 6] * rn * sg[d + 6], x[d + 7] * rn * sg[d + 7]);
                *(u32x4*)(yp + d) = w; }
        }
    }
    asm volatile("s_waitcnt lgkmcnt(0)\n\ts_barrier" ::: "memory");
#undef DMA_K
#undef DMA_V
#undef ATT_KT
}
#undef SBAR
}

namespace hg {
typedef float f32x4 __attribute__((ext_vector_type(4)));
typedef short bf16x8 __attribute__((ext_vector_type(8)));
typedef unsigned u32x4 __attribute__((ext_vector_type(4)));
constexpr int B_QT = 0, B_KE = 18432, B_VT = 36864, B_SS = 54272, B_KT = 63488, B_RR = 80896, B_TOT = 83200, B_SX = 85248, B_END = 87552;
static_assert(B_END <= 131072, "HGRN LDS map");
#define HG_MFMA(a, b, c) __builtin_amdgcn_mfma_f32_16x16x32_bf16(a, b, c, 0, 0, 0)
#define WT_STORE(p, v) __hip_atomic_store((p), (v), __ATOMIC_RELAXED, __HIP_MEMORY_SCOPE_AGENT)

struct Ptrs { const bf16* DQ; const bf16* ZF; const bf16* ZB; const bf16* DI; const bf16* DG; const float* lbf; const float* lbb; float* ST; float* AC; };

__device__ __forceinline__ bf16x8 pack8(const float* x) { u32x4 w; w.x = pk2(x[0], x[1]); w.y = pk2(x[2], x[3]); w.z = pk2(x[4], x[5]); w.w = pk2(x[6], x[7]); return __builtin_bit_cast(bf16x8, w); }

struct Raw { unsigned short zf[16], zb[16], q[16], v[16]; };
template <bool S1MODE>
__device__ __forceinline__ void pre_load(const Ptrs& P, int b, int h, int c, int tid, Raw& R) {
    const int I = tid >> 6, k = tid & 63;
#pragma unroll
    for (int i = 0; i < 16; ++i) {
        const size_t off = (size_t)(b * cfg::L + 128 * c + 16 * I + i) * 256 + h * 64 + k;
        R.zf[i] = P.ZF[off]; R.zb[i] = P.ZB[off]; R.v[i] = P.DI[off]; if (!S1MODE) R.q[i] = P.DQ[off];
    }
}
template <bool S1MODE>
__device__ __forceinline__ void pre_compute(const Ptrs& P, int h, int c, int dir, unsigned char* lb_, int tid, const Raw& R) {
    const int I = dir ? 7 - (tid >> 6) : (tid >> 6), k = tid & 63;
#define RN(a, i) (dir ? R.a[15 - (i)] : R.a[i])
    unsigned short* QT = (unsigned short*)(lb_ + B_QT); unsigned short* KE = (unsigned short*)(lb_ + B_KE); unsigned short* VT = (unsigned short*)(lb_ + B_VT);
    unsigned short* KT = (unsigned short*)(lb_ + B_KT); float* RR = (float*)(lb_ + B_RR); float* TOT = (float*)(lb_ + B_TOT);
    const float lb = (dir ? P.lbb : P.lbf)[h * 64 + k];
    float pr = 1.f; float fv[16], kq[16];
#pragma unroll
    for (int i = 0; i < 16; ++i) {
        const int tau = 16 * I + i;
        const float z = __builtin_amdgcn_fmed3f(bf2f(dir ? R.zb[15 - i] : R.zf[i]), -80.0f, 80.0f), ez = __builtin_amdgcn_exp2f(-cfg::LOG2E * z), sg = __builtin_amdgcn_rcpf(1.0f + ez);
        const float fr_ = lb + (1.0f - lb) * sg, f = fmaxf(fr_, 1e-30f);
        pr *= f; fv[i] = f;
        kq[i] = 1.0f - fr_;
        if (!S1MODE) QT[tau * 72 + k] = (unsigned short)pk2(bf2f(RN(q, i)) * pr, 0.f);
    }
    if (c == 0) {
#pragma unroll
        for (int i = 0; i < 16; ++i) { const int tau = 16 * I + i, t = dir ? 127 - tau : tau; if (t < cfg::FRONT) kq[i] = 0.0f; }
    }
    { u32x4 w0, w1;
      w0.x = RN(v, 0) | ((unsigned)RN(v, 1) << 16); w0.y = RN(v, 2) | ((unsigned)RN(v, 3) << 16); w0.z = RN(v, 4) | ((unsigned)RN(v, 5) << 16); w0.w = RN(v, 6) | ((unsigned)RN(v, 7) << 16);
      w1.x = RN(v, 8) | ((unsigned)RN(v, 9) << 16); w1.y = RN(v, 10) | ((unsigned)RN(v, 11) << 16); w1.z = RN(v, 12) | ((unsigned)RN(v, 13) << 16); w1.w = RN(v, 14) | ((unsigned)RN(v, 15) << 16);
      *(u32x4*)(lb_ + B_VT + k * 272 + 32 * I) = w0; *(u32x4*)(lb_ + B_VT + k * 272 + 32 * I + 16) = w1; }
    { float sf = 1.f;
#pragma unroll
      for (int i = 15; i >= 0; --i) { kq[i] *= sf; sf *= fv[i]; } }
    if (!S1MODE) {
#pragma unroll
        for (int i = 0; i < 16; ++i) KE[(16 * I + i) * 72 + k] = (unsigned short)pk2(kq[i], 0.f);
    }
    TOT[I * 64 + k] = pr;
    __syncthreads();
    float dd[8];
#pragma unroll
    for (int J = 0; J < 8; ++J) dd[J] = TOT[J * 64 + k];
    if (S1MODE) {
        float ef = 1.f, all = 1.f;
#pragma unroll
        for (int J = 0; J < 8; ++J) { ef *= (J > I) ? dd[J] : 1.0f; all *= dd[J]; }
        float x[16];
#pragma unroll
        for (int i = 0; i < 16; ++i) x[i] = kq[i] * ef;
        *(bf16x8*)(lb_ + B_KT + k * 272 + 32 * I) = pack8(x); *(bf16x8*)(lb_ + B_KT + k * 272 + 32 * I + 16) = pack8(x + 8);
        if (tid < 64) RR[8 * 64 + k] = all;
        __syncthreads();
    } else {
        float r = 1.f;
#pragma unroll
        for (int J = 0; J < 8; ++J) r *= (J < I) ? dd[J] : 1.0f;
        RR[I * 64 + k] = r;
        __syncthreads();
    }
}
#undef RN
__device__ __forceinline__ int hg_item_bh(int item) { return item < 256 ? item >> 4 : item - 256; }
__device__ __forceinline__ int hg_item_j(int item) { return item < 256 ? item & 15 : 16; }
__device__ __forceinline__ size_t st_item(int b, int h, int c, int dir) { return (size_t)(((b * 4 + h) * 33 + c) * 2 + dir); }

__device__ __forceinline__ void s1_body(const Ptrs& P, int b, int h, int c, unsigned char* lb_, int tid, const Raw& R) {
    const int w = __builtin_amdgcn_readfirstlane(tid >> 6), lane = tid & 63, i = lane & 15, q4 = lane >> 4, kb = w >> 1, vh = w & 1;
#pragma unroll
    for (int dir = 0; dir < 2; ++dir) {
        __syncthreads();
        pre_compute<true>(P, h, c, dir, lb_, tid, R);
        f32x4 c0 = {0.f, 0.f, 0.f, 0.f}, c1 = {0.f, 0.f, 0.f, 0.f};
#pragma unroll
        for (int step = 0; step < 4; ++step) {
            const bf16x8 a = *(const bf16x8*)(lb_ + B_KT + (16 * kb + i) * 272 + 16 * q4 + 64 * step);
            const bf16x8 b0 = *(const bf16x8*)(lb_ + B_VT + (32 * vh + i) * 272 + 16 * q4 + 64 * step), b1 = *(const bf16x8*)(lb_ + B_VT + (32 * vh + 16 + i) * 272 + 16 * q4 + 64 * step);
            c0 = HG_MFMA(a, b0, c0); c1 = HG_MFMA(a, b1, c1); }
        const size_t it = st_item(b, h, c, dir); float* L = P.ST + it * 4096;
#pragma unroll
        for (int r = 0; r < 4; ++r) { const int kk = 16 * kb + 4 * q4 + r; WT_STORE(L + kk * 64 + 32 * vh + i, c0[r]); WT_STORE(L + kk * 64 + 32 * vh + 16 + i, c1[r]); }
        if (tid < 64) WT_STORE(P.AC + it * 64 + tid, ((const float*)(lb_ + B_RR))[8 * 64 + tid]);
    }
}
__device__ __forceinline__ void s1_item(const Ptrs& P, int item, unsigned char* lb_, int tid) {
    const int bh = hg_item_bh(item), j = hg_item_j(item), c0 = 2 * j, h = bh & 3, b = bh >> 2; const bool two = c0 + 1 < 33;
    Raw Ra, Rb; pre_load<true>(P, b, h, c0, tid, Ra); pre_load<true>(P, b, h, two ? c0 + 1 : c0, tid, Rb);
    s1_body(P, b, h, c0, lb_, tid, Ra);
    if (two) s1_body(P, b, h, c0 + 1, lb_, tid, Rb);
}

__device__ __forceinline__ void scan(const Ptrs& P, int gid, int nthreads) {
    for (int e = gid; e < 32 * 4096; e += nthreads) {
        const int chain = e >> 12, el = e & 4095, dir = chain & 1, bh = chain >> 1, k = el >> 6;
        float Lv[33], av[33];
#pragma unroll
        for (int cc = 0; cc < 33; ++cc) { const int c = dir ? 32 - cc : cc; const size_t it = (size_t)((bh * 33 + c) * 2 + dir); Lv[cc] = P.ST[it * 4096 + el]; av[cc] = P.AC[it * 64 + k]; }
        float st = 0.f;
#pragma unroll
        for (int cc = 0; cc < 33; ++cc) { const int c = dir ? 32 - cc : cc; const size_t it = (size_t)((bh * 33 + c) * 2 + dir); P.ST[it * 4096 + el] = st; st = av[cc] * st + Lv[cc]; }
    }
}

__device__ __forceinline__ void scan_chain(const Ptrs& P, int chain, int tid) {
    const int dir = chain & 1, bh = chain >> 1;
    for (int j = 0; j < 8; ++j) {
        const int el = tid + 512 * j, k = el >> 6;
        float Lv[33], av[33];
#pragma unroll
        for (int cc = 0; cc < 33; ++cc) { const int c = dir ? 32 - cc : cc; const size_t it = (size_t)((bh * 33 + c) * 2 + dir); Lv[cc] = P.ST[it * 4096 + el]; av[cc] = P.AC[it * 64 + k]; }
        float st = 0.f;
#pragma unroll
        for (int cc = 0; cc < 33; ++cc) { const int c = dir ? 32 - cc : cc; const size_t it = (size_t)((bh * 33 + c) * 2 + dir); WT_STORE(P.ST + it * 4096 + el, st); st = av[cc] * st + Lv[cc]; }
    }
}

struct S3Pre { Raw R; v2u gq[4]; f32x4 sa[2], sb[2]; };
__device__ __forceinline__ void s3_body(const Ptrs& P, const float* outg, bf16* Y, int b, int h, int c, unsigned char* lb_, int tid, const S3Pre& Q) {
    const int w = __builtin_amdgcn_readfirstlane(tid >> 6), lane = tid & 63, i = lane & 15, q4 = lane >> 4;
    const float* RR = (const float*)(lb_ + B_RR);
    f32x4 acc[4];
#pragma unroll
    for (int vb = 0; vb < 4; ++vb) acc[vb] = (f32x4){0.f, 0.f, 0.f, 0.f};
    const Raw& R = Q.R; const int skk = tid >> 3, sv0 = (tid & 7) * 8;
#pragma unroll
    for (int dir = 0; dir < 2; ++dir) {
        __syncthreads();
        { unsigned short* SS = (unsigned short*)(lb_ + B_SS);
#pragma unroll
          for (int j = 0; j < 4; ++j) { SS[(sv0 + j) * 72 + skk] = (unsigned short)f2bf(Q.sa[dir][j]); SS[(sv0 + 4 + j) * 72 + skk] = (unsigned short)f2bf(Q.sb[dir][j]); } }
        pre_compute<false>(P, h, c, dir, lb_, tid, R);
        const int Ib = dir ? 7 - w : w, ip = dir ? 15 - i : i, trow = 16 * Ib + ip;
        float qv[16], ri[16];
        { const bf16x8 qa = *(const bf16x8*)(lb_ + B_QT + trow * 144 + 16 * q4), qb = *(const bf16x8*)(lb_ + B_QT + trow * 144 + 16 * q4 + 64);
#pragma unroll
          for (int j = 0; j < 8; ++j) { qv[j] = bf2f((unsigned short)qa[j]); qv[8 + j] = bf2f((unsigned short)qb[j]); }
          const f32x4 r0 = *(const f32x4*)(RR + Ib * 64 + 8 * q4), r1 = *(const f32x4*)(RR + Ib * 64 + 8 * q4 + 4), r2 = *(const f32x4*)(RR + Ib * 64 + 32 + 8 * q4), r3 = *(const f32x4*)(RR + Ib * 64 + 32 + 8 * q4 + 4);
#pragma unroll
          for (int j = 0; j < 4; ++j) { ri[j] = r0[j]; ri[4 + j] = r1[j]; ri[8 + j] = r2[j]; ri[12 + j] = r3[j]; } }
        { float x[16];
#pragma unroll
          for (int j = 0; j < 16; ++j) x[j] = qv[j] * ri[j];
          const bf16x8 bq0 = pack8(x), bq1 = pack8(x + 8);
#pragma unroll
          for (int vb = 0; vb < 4; ++vb) { const unsigned char* sp = lb_ + B_SS + (16 * vb + i) * 144 + 16 * q4;
              acc[vb] = HG_MFMA(*(const bf16x8*)sp, bq0, acc[vb]); acc[vb] = HG_MFMA(*(const bf16x8*)(sp + 64), bq1, acc[vb]); } }
        const float* TOTc = (const float*)(lb_ + B_TOT);
        float Fq[16];
        { const f32x4 d0 = *(const f32x4*)(TOTc + Ib * 64 + 8 * q4), d1 = *(const f32x4*)(TOTc + Ib * 64 + 8 * q4 + 4), d2 = *(const f32x4*)(TOTc + Ib * 64 + 32 + 8 * q4), d3 = *(const f32x4*)(TOTc + Ib * 64 + 32 + 8 * q4 + 4);
#pragma unroll
          for (int j = 0; j < 4; ++j) { Fq[j] = __builtin_amdgcn_rcpf(fmaxf(d0[j], 1e-37f)); Fq[4 + j] = __builtin_amdgcn_rcpf(fmaxf(d1[j], 1e-37f)); Fq[8 + j] = __builtin_amdgcn_rcpf(fmaxf(d2[j], 1e-37f)); Fq[12 + j] = __builtin_amdgcn_rcpf(fmaxf(d3[j], 1e-37f)); } }
        for (int J0 = Ib & ~1; J0 >= 0; J0 -= 2) {
            u32x4 pbw = {0u, 0u, 0u, 0u};
#pragma unroll
            for (int hb = 1; hb >= 0; --hb) {
                const int J = J0 + hb;
                if (J <= Ib) {
                    float x[16];
#pragma unroll
                    for (int j = 0; j < 16; ++j) x[j] = qv[j] * Fq[j];
                    const bf16x8 bq0 = pack8(x), bq1 = pack8(x + 8);
                    const unsigned char* kp = lb_ + B_KE + (16 * J + i) * 144 + 16 * q4;
                    f32x4 at = {0.f, 0.f, 0.f, 0.f};
                    at = HG_MFMA(*(const bf16x8*)kp, bq0, at); at = HG_MFMA(*(const bf16x8*)(kp + 64), bq1, at);
                    if (J == Ib) {
#pragma unroll
                        for (int r = 0; r < 4; ++r) if (4 * q4 + r > ip) at[r] = 0.f;
#pragma unroll
                        for (int j = 0; j < 16; ++j) Fq[j] = 1.0f;
                    } else {
                        const f32x4 d0 = *(const f32x4*)(TOTc + J * 64 + 8 * q4), d1 = *(const f32x4*)(TOTc + J * 64 + 8 * q4 + 4), d2 = *(const f32x4*)(TOTc + J * 64 + 32 + 8 * q4), d3 = *(const f32x4*)(TOTc + J * 64 + 32 + 8 * q4 + 4);
#pragma unroll
                        for (int j = 0; j < 4; ++j) { Fq[j] *= d0[j]; Fq[4 + j] *= d1[j]; Fq[8 + j] *= d2[j]; Fq[12 + j] *= d3[j]; }
                    }
                    if (hb == 0) { pbw.x = pk2(at[0], at[1]); pbw.y = pk2(at[2], at[3]); } else { pbw.z = pk2(at[0], at[1]); pbw.w = pk2(at[2], at[3]); }
                }
            }
            const int J1 = (J0 + 1 <= Ib) ? J0 + 1 : J0;
            const bf16x8 pb = __builtin_bit_cast(bf16x8, pbw);
#pragma unroll
            for (int vb = 0; vb < 4; ++vb) { const unsigned char* vp = lb_ + B_VT + (16 * vb + i) * 272 + 8 * q4;
                const v2u a0 = *(const v2u*)(vp + 32 * J0), a1 = *(const v2u*)(vp + 32 * J1);
                const u32x4 aw = {a0.x, a0.y, a1.x, a1.y};
                acc[vb] = HG_MFMA(__builtin_bit_cast(bf16x8, aw), pb, acc[vb]); }
        }
    }
    float ss = 0.f;
#pragma unroll
    for (int vb = 0; vb < 4; ++vb) ss += (acc[vb][0] * acc[vb][0] + acc[vb][1] * acc[vb][1]) + (acc[vb][2] * acc[vb][2] + acc[vb][3] * acc[vb][3]);
    ss += __shfl_xor(ss, 16); ss += __shfl_xor(ss, 32);
    const float rn = __builtin_amdgcn_rsqf(ss * (1.0f / 64.0f) + cfg::RMS_EPS);
    const size_t m = (size_t)b * cfg::L + 128 * c + 16 * w + i;
    v2u wv[4];
#pragma unroll
    for (int vb = 0; vb < 4; ++vb) { const int v = 16 * vb + 4 * q4;
        const v2u g = Q.gq[vb]; const f32x4 og = *(const f32x4*)(outg + v);
        const float gg[4] = {bflo(g.x), bfhi(g.x), bflo(g.y), bfhi(g.y)}; float y[4];
#pragma unroll
        for (int r = 0; r < 4; ++r) y[r] = acc[vb][r] * rn * og[r] * (gg[r] * __builtin_amdgcn_rcpf(1.0f + __builtin_amdgcn_exp2f(-cfg::LOG2E * gg[r])));
        wv[vb].x = pk2(y[0], y[1]); wv[vb].y = pk2(y[2], y[3]); }
#pragma unroll
    for (int vb = 0; vb < 4; vb += 2) {
        const auto s0 = __builtin_amdgcn_permlane16_swap(wv[vb].x, wv[vb + 1].x, false, false); const auto s1 = __builtin_amdgcn_permlane16_swap(wv[vb].y, wv[vb + 1].y, false, false);
        u32x4 o; o.x = s0[0]; o.y = s1[0]; o.z = s0[1]; o.w = s1[1];
        *(u32x4*)(Y + m * 1024 + 768 + h * 64 + 16 * vb + ((q4 & 1) ? 16 + 4 * (q4 - 1) : 4 * q4)) = o; }
}
__device__ __forceinline__ void s3_pre(const Ptrs& P, int b, int h, int c, int tid, S3Pre& Q) {
    const int w = __builtin_amdgcn_readfirstlane(tid >> 6), lane = tid & 63, i = lane & 15, q4 = lane >> 4;
    pre_load<false>(P, b, h, c, tid, Q.R);
    const size_t m = (size_t)b * cfg::L + 128 * c + 16 * w + i;
#pragma unroll
    for (int vb = 0; vb < 4; ++vb) Q.gq[vb] = *(const v2u*)(P.DG + m * 256 + h * 64 + 16 * vb + 4 * q4);
}
__device__ __forceinline__ void s3_states(const Ptrs& P, int b, int h, int c, int tid, S3Pre& Q) {
    const int skk = tid >> 3, sv0 = (tid & 7) * 8;
#pragma unroll
    for (int dir = 0; dir < 2; ++dir) { const float* S = P.ST + st_item(b, h, c, dir) * 4096; Q.sa[dir] = *(const f32x4*)(S + skk * 64 + sv0); Q.sb[dir] = *(const f32x4*)(S + skk * 64 + sv0 + 4); }
}
template <class WaitF>
__device__ __forceinline__ void s3_item(const Ptrs& P, const float* outg, bf16* Y, int item, unsigned char* lb_, int tid, WaitF wait_states) {
    const int bh = hg_item_bh(item), j = hg_item_j(item), c0 = 2 * j, h = bh & 3, b = bh >> 2; const bool two = c0 + 1 < 33; const int c1 = two ? c0 + 1 : c0;
    S3Pre Qa, Qb;
    s3_pre(P, b, h, c0, tid, Qa); pre_load<false>(P, b, h, c1, tid, Qb.R);
    wait_states();
    s3_states(P, b, h, c0, tid, Qa);
    s3_body(P, outg, Y, b, h, c0, lb_, tid, Qa);
    if (two) { { const int w = __builtin_amdgcn_readfirstlane(tid >> 6), lane = tid & 63, i = lane & 15, q4 = lane >> 4; const size_t m = (size_t)b * cfg::L + 128 * c1 + 16 * w + i;
#pragma unroll
          for (int vb = 0; vb < 4; ++vb) Qb.gq[vb] = *(const v2u*)(P.DG + m * 256 + h * 64 + 16 * vb + 4 * q4); }
        s3_states(P, b, h, c1, tid, Qb); s3_body(P, outg, Y, b, h, c1, lb_, tid, Qb); }
}
}

constexpr int NWAVES = 8;
#ifndef DIS
#define DIS 0
#endif
#ifndef MK_SPLIT
#define MK_SPLIT 0
#endif
#define LDS_WAIT() asm volatile("s_waitcnt lgkmcnt(0)" ::: "memory")
#define RLX_AGENT __ATOMIC_RELAXED, __HIP_MEMORY_SCOPE_AGENT
constexpr int CW_SCHED = 0, CW_DEP = 1024, CW_BAR = 12288; constexpr size_t CTL_ZERO_BYTES = 65536;
constexpr int MISC_OFF = 131072 + 320;
#ifndef DEP_SPIN
#define DEP_SPIN 1
#endif
#ifndef DEP_ACQ
#define DEP_ACQ 1
#endif
__device__ __forceinline__ void dep_signal(unsigned* cnt, bool t0) {
    asm volatile("s_waitcnt vmcnt(0)" ::: "memory");
    __syncthreads();
    if (t0 && cnt) { const unsigned one = 1u; asm volatile("global_atomic_add %0, %1, off" :: "v"(cnt), "v"(one) : "memory"); }
}
__device__ __forceinline__ void dep_wait(unsigned* cnt, unsigned want, bool t0) {
    if (t0) { unsigned sp = 0;
        while (DEP_SPIN && __hip_atomic_load(cnt, __ATOMIC_RELAXED, __HIP_MEMORY_SCOPE_AGENT) < want) { __builtin_amdgcn_s_sleep(4); if (++sp > (1u << 18)) break; }
        if (DEP_ACQ) { __builtin_amdgcn_fence(__ATOMIC_ACQUIRE, "agent"); asm volatile("s_waitcnt vmcnt(0)" ::: "memory"); } }
    __syncthreads();
}
#ifndef PROBE_QMASK
#define PROBE_QMASK 127
#endif
#ifndef PROBE_REP
#define PROBE_REP 0
#endif
#ifndef USE_XCD_BAR
#define USE_XCD_BAR 1
#endif
#ifndef ATT_PIPE
#define ATT_PIPE 1
#endif
#if ATT_PIPE
#define ATT_UNIT att::attn_unit_p
#else
#define ATT_UNIT att::attn_unit
#endif
#ifndef NAIVE_ATTN
#define NAIVE_ATTN 0
#endif
#define XB_TMO      128
#define XB_XCNT(j)  (256  + 64 * (j))
#define XB_XSUB(j)  (1280 + 64 * (j))
#define XB_XGEN(j)  (2304 + 64 * (j))
#define XB_TOP      3328
#define XB_TOPGEN   3392
#define XCD_BAR_WORDS 3456
#define XB_SPIN_CAP (1u << 18)

__device__ __forceinline__ unsigned xb_ld(unsigned* p)              { return __hip_atomic_load(p, __ATOMIC_RELAXED, __HIP_MEMORY_SCOPE_AGENT); }
__device__ __forceinline__ unsigned xb_add(unsigned* p, unsigned v) { return __hip_atomic_fetch_add(p, v, __ATOMIC_RELAXED, __HIP_MEMORY_SCOPE_AGENT); }
__device__ __forceinline__ unsigned xb_xcc_id() { return (unsigned)__builtin_amdgcn_s_getreg((3 << 11) | 20) & 0xFu; }
#define XB_SPIN(cond, bar) do { unsigned _sp = 0; while (cond) { __builtin_amdgcn_s_sleep(1); \
    if ((++_sp & 255u) == 0u) { if (xb_ld(&(bar)[XB_TMO])) break; if (_sp > XB_SPIN_CAP) { atomicAdd(&(bar)[XB_TMO], 1u); break; } } } } while (0)

struct XcdBarrier {
    unsigned* bar; unsigned x; int t0;
    volatile LAS unsigned* st;
};

__device__ __forceinline__ XcdBarrier xcd_barrier_post(unsigned* bar, volatile LAS unsigned* st) {
    XcdBarrier b; b.bar = bar; b.x = xb_xcc_id(); b.st = st;
    if (threadIdx.x == 0) (void)xb_add(&bar[XB_XCNT(b.x)], 1u);
    return b;
}
__device__ __forceinline__ void xcd_barrier_complete(unsigned* bar, unsigned x, unsigned& nloc, unsigned& nx) {
    const unsigned G = gridDim.x * gridDim.y * gridDim.z;
    unsigned sum, cnt, mine, sp = 0u;
    for (;;) {
        sum = 0u; cnt = 0u; mine = 0u;
#pragma unroll
        for (unsigned j = 0; j < 16; ++j) { const unsigned c = xb_ld(&bar[XB_XCNT(j)]); sum += c; cnt += (c > 0u) ? 1u : 0u; mine = (j == x) ? c : mine; }
        if (sum == G) break;
        __builtin_amdgcn_s_sleep(1);
        if ((++sp & 255u) == 0u) { if (xb_ld(&bar[XB_TMO])) break; if (sp > XB_SPIN_CAP) { atomicAdd(&bar[XB_TMO], 1u); break; } }
    }
    nloc = mine > 0u ? mine : 1u; nx = cnt > 0u ? cnt : 1u;
}

__device__ __forceinline__ void xcd_barrier(const XcdBarrier& b) {
    asm volatile("s_waitcnt vmcnt(0)" ::: "memory");
    __syncthreads();
    if (b.t0) {
        unsigned* bar = b.bar;
        __builtin_amdgcn_s_waitcnt(0);
        unsigned nloc = b.st[0], nx = b.st[1];
        if (nloc == 0u) { xcd_barrier_complete(bar, b.x, nloc, nx); b.st[0] = nloc; b.st[1] = nx; }
        const unsigned old = xb_add(&bar[XB_XSUB(b.x)], 1u);
        const unsigned gen = old / nloc;
        if (old + 1u == (gen + 1u) * nloc) {
            __builtin_amdgcn_fence(__ATOMIC_RELEASE, "agent");
            asm volatile("s_waitcnt vmcnt(0)" ::: "memory");
            const unsigned og = xb_add(&bar[XB_TOP], 1u);
            const unsigned tg = og / nx;
            if (og + 1u == (tg + 1u) * nx) xb_add(&bar[XB_TOPGEN], 1u);
            else XB_SPIN(xb_ld(&bar[XB_TOPGEN]) == tg, bar);
            __builtin_amdgcn_fence(__ATOMIC_ACQUIRE, "agent");
            xb_add(&bar[XB_XGEN(b.x)], 1u);
            asm volatile("s_waitcnt vmcnt(0)" ::: "memory");
        } else {
            XB_SPIN(xb_ld(&bar[XB_XGEN(b.x)]) == gen, bar);
            __builtin_amdgcn_fence(__ATOMIC_ACQUIRE, "agent");
            asm volatile("s_waitcnt vmcnt(0)" ::: "memory");
        }
    }
    __syncthreads();
}
using cfg::T; using cfg::L;

struct Args { const float* in[19]; float* out; unsigned char* ws; int ph_lo, ph_hi; };
typedef const __attribute__((address_space(4))) Args* CArgs;
__device__ __forceinline__ CArgs phase_args() { CArgs p = (CArgs)__builtin_amdgcn_kernarg_segment_ptr(); asm volatile("" : "+s"(p)); return p; }

__device__ __forceinline__ float wave_sum(float v) {
#pragma unroll
    for (int o = 1; o < 64; o <<= 1) v += __shfl_xor(v, o);
    return v;
}

struct RmId { __device__ __forceinline__ int operator()(int n) const { return n; } };
struct RmW1 { __device__ __forceinline__ int operator()(int n) const { const int pn = n >> 8, cc = n & 255; return pn < 6 ? (pn << 8) + 128 * ((cc & 63) >> 5) + 32 * (cc >> 6) + (cc & 31) : n; } };
struct RmGU { int half; __device__ __forceinline__ int operator()(int j) const { return ((j >> 7) << 8) + half * 128 + (j & 127); } };
typedef float tf4 __attribute__((ext_vector_type(4)));
__device__ __forceinline__ void transpose_load(const float* W, int N, const float* gain, int nblk, int item, int lane, tf4 (&wv)[8], float (&gv)[8]) {
    const int kb = item / nblk, nb = item % nblk, k0 = 64 * kb, n0 = 32 * nb;
#pragma unroll
    for (int i = 0; i < 8; ++i) wv[i] = *(const tf4*)(W + (size_t)(k0 + 8 * i + (lane >> 3)) * N + n0 + 4 * (lane & 7));
    if (gain) {
#pragma unroll
        for (int i = 0; i < 8; ++i) gv[i] = gain[k0 + 8 * i + (lane >> 3)];
    }
}
template <class RowMap>
__device__ __forceinline__ void transpose_finish(int K, bf16* WT, bool hasgain, RowMap rm, LAS float* scr, int nblk, int item, int lane, const tf4 (&wv)[8], const float (&gv)[8]) {
    const int kb = item / nblk, nb = item % nblk, k0 = 64 * kb, n0 = 32 * nb;
#pragma unroll
    for (int i = 0; i < 8; ++i) { const tf4 v = hasgain ? wv[i] * gv[i] : wv[i]; LAS float* d = scr + (8 * i + (lane >> 3)) * 33 + 4 * (lane & 7); d[0] = v[0]; d[1] = v[1]; d[2] = v[2]; d[3] = v[3]; }
    LDS_WAIT(); asm volatile("" ::: "memory");
    const int c = lane & 7;
#pragma unroll
    for (int j = 0; j < 4; ++j) { const int n = (lane >> 3) + 8 * j; const LAS float* s = scr + (8 * c) * 33 + n;
        v4u o; o.x = pk2(s[0 * 33], s[1 * 33]); o.y = pk2(s[2 * 33], s[3 * 33]); o.z = pk2(s[4 * 33], s[5 * 33]); o.w = pk2(s[6 * 33], s[7 * 33]);
        *(v4u*)(WT + (size_t)rm(n0 + n) * K + k0 + 8 * c) = o; }
    LDS_WAIT(); asm volatile("" ::: "memory");
}
template <class RowMap>
__device__ __forceinline__ void transpose_run(const float* W, int K, int N, bf16* WT, const float* gain, RowMap rm, LAS float* scr, int first, int count, int stride, int lane) {
    const int nblk = N / 32; const bool hg_ = gain != nullptr;
    tf4 a[8] = {}, b[8] = {}; float ga[8] = {}, gb[8] = {};
    if (count > 0) transpose_load(W, N, gain, nblk, first, lane, a, ga);
    for (int j = 0; j < count; j += 2) {
        const bool two = j + 1 < count;
        if (two) transpose_load(W, N, gain, nblk, first + (j + 1) * stride, lane, b, gb);
        transpose_finish(K, WT, hg_, rm, scr, nblk, first + j * stride, lane, a, ga);
        if (two) { if (j + 2 < count) transpose_load(W, N, gain, nblk, first + (j + 2) * stride, lane, a, ga);
            transpose_finish(K, WT, hg_, rm, scr, nblk, first + (j + 1) * stride, lane, b, gb); }
    }
}

__device__ __forceinline__ int t5_bucket(int rel) {
    const int n = rel < 0 ? -rel : rel;
    int v = n;
    if (n >= 8) { const int j = 31 - __builtin_clz((unsigned)(n * n)) - 6; v = 8 + j; v = v > 15 ? 15 : v; }
    return (rel > 0 ? 16 : 0) + v;
}

constexpr int W_I1 = 16 * (cfg::NIN / 32), W_IB = 16 * 32, W_IO = 16 * 32, W_IG = 16 * (cfg::DFF / 32), W_IU = W_IG, W_ID = (cfg::DFF / 64) * 32, W_NITEMS = W_I1 + W_IB + W_IO + W_IG + W_IU + W_ID;
__device__ __forceinline__ void w_run(CArgs ap, int l, int r, int count, int stride, LAS float* scr, int lane) {
    unsigned char* ws = ap->ws;
    if (r < W_I1) { transpose_run(ap->in[5] + (size_t)l * 1024 * cfg::NIN, 1024, cfg::NIN, (bf16*)(ws + cfg::WS_W1), ap->in[4] + l * 1024, RmW1{}, scr, r, count, stride, lane); return; } r -= W_I1;
    if (r < W_IB) { transpose_run(ap->in[12] + (size_t)l * 1024 * 1024, 1024, 1024, (bf16*)(ws + cfg::WS_WB), nullptr, RmId{}, scr, r, count, stride, lane); return; } r -= W_IB;
    if (r < W_IO) { transpose_run(ap->in[13] + (size_t)l * 1024 * 1024, 1024, 1024, (bf16*)(ws + cfg::WS_WO), nullptr, RmId{}, scr, r, count, stride, lane); return; } r -= W_IO;
    if (r < W_IG) { transpose_run(ap->in[15] + (size_t)l * 1024 * cfg::DFF, 1024, cfg::DFF, (bf16*)(ws + cfg::WS_WGU), ap->in[14] + l * 1024, RmGU{0}, scr, r, count, stride, lane); return; } r -= W_IG;
    if (r < W_IU) { transpose_run(ap->in[16] + (size_t)l * 1024 * cfg::DFF, 1024, cfg::DFF, (bf16*)(ws + cfg::WS_WGU), ap->in[14] + l * 1024, RmGU{1}, scr, r, count, stride, lane); return; } r -= W_IU;
    transpose_run(ap->in[17] + (size_t)l * cfg::DFF * 1024, cfg::DFF, 1024, (bf16*)(ws + cfg::WS_WD), nullptr, RmId{}, scr, r, count, stride, lane);
}
__device__ __forceinline__ void w_gains(CArgs ap, int l, int lane) { float* qkg = (float*)(ap->ws + cfg::WS_TAB + cfg::TAB_QKG); qkg[lane] = ap->in[7][l * 64 + lane]; qkg[64 + lane] = ap->in[8][l * 64 + lane]; }
__device__ __forceinline__ void phase_w(CArgs ap, int l, LAS unsigned char* lds, int gw, int NGW, int wave, int lane) {
    LAS float* scr = (LAS float*)(lds + wave * 16384);
    if (gw == 0) w_gains(ap, l, lane);
    if (gw < W_I1) w_run(ap, l, gw, (W_I1 - gw + NGW - 1) / NGW, NGW, scr, lane);
}

__device__ __forceinline__ void phase_init(CArgs ap, int gw, int NGW, int lane, int tid) {
    unsigned char* ws = ap->ws;
    bf16* hb = (bf16*)(ws + cfg::WS_HB); float* ssq = (float*)(ws + cfg::WS_SSQ);
    typedef float f4 __attribute__((ext_vector_type(4)));
    for (int m0 = gw; m0 < T; m0 += 3 * NGW) {
        f4 v[3][4];
#pragma unroll
        for (int u = 0; u < 3; ++u) {
            const int m = m0 + u * NGW < T ? m0 + u * NGW : T - 1; const int b = m / L, pos = m - b * L;
            const float* src = pos < cfg::MEND ? ap->in[1] + (size_t)(pos < cfg::FRONT ? 0 : pos - cfg::FRONT) * 1024 : ap->in[0] + (size_t)(b * cfg::SEQ + pos - cfg::MEND) * 1024;
#pragma unroll
            for (int j = 0; j < 4; ++j) v[u][j] = ((const f4*)src)[64 * j + lane];
        }
#pragma unroll
        for (int u = 0; u < 3; ++u) {
            const int m = m0 + u * NGW;
            if (m < T) {
                const int b = m / L, pos = m - b * L;
                if (pos < cfg::FRONT) {
#pragma unroll
                    for (int j = 0; j < 4; ++j) v[u][j] = (f4){0.f, 0.f, 0.f, 0.f}; }
                float s = 0.f;
#pragma unroll
                for (int j = 0; j < 4; ++j) s += (v[u][j][0] * v[u][j][0] + v[u][j][1] * v[u][j][1]) + (v[u][j][2] * v[u][j][2] + v[u][j][3] * v[u][j][3]);
                s = wave_sum(s);
#pragma unroll
                for (int j = 0; j < 4; ++j) { v2u w; w.x = pk2(v[u][j][0], v[u][j][1]); w.y = pk2(v[u][j][2], v[u][j][3]); ((v2u*)(hb + (size_t)m * 1024))[64 * j + lane] = w; }
                if (lane < 16) ssq[(size_t)m * 16 + lane] = lane == 0 ? s : 0.f;
            }
        }
    }
    {
        float* tab = (float*)(ws + cfg::WS_TAB);
        float* rt = tab + cfg::TAB_RT / 4; float* luta = tab + cfg::TAB_LUTA / 4; float* lutc = tab + cfg::TAB_LUTC / 4; float* lbt = tab + cfg::TAB_LB / 4; float* lam = tab + cfg::TAB_LAM / 4;
        for (int j = (int)blockIdx.x * 512 + tid; j < 1040 + 1028 + 1024 + 2; j += (int)gridDim.x * 512) {
            if (j < 1040) { const int idx = j, v = idx / 16 - 1, i = idx % 16; const float inv = powf(10000.0f, -(float)i / 16.0f); const float ang = (float)v * inv; rt[idx * 2] = cosf(ang); rt[idx * 2 + 1] = sinf(ang); }
            else if (j < 2068) { const int idx = j - 1040, rel = idx / 4 - 128, hh = idx % 4, bk = t5_bucket(rel);
                luta[idx] = ap->in[2][bk * 8 + hh] * cfg::LOG2E; lutc[idx] = ap->in[2][bk * 8 + 4 + hh] * cfg::LOG2E; }
            else if (j < 3092) { const int idx = j - 2068, l_ = idx >> 9, dir = (idx >> 8) & 1, k = idx & 255;
                const float a0 = ap->in[3][(dir * 2 + 0) * 256 + k], a1 = ap->in[3][(dir * 2 + 1) * 256 + k];
                lbt[idx] = l_ == 0 ? 0.0f : 1.0f / (1.0f + expf(a0 - a1)); }
            else { const int t_ = j - 3092; const float* lp = ap->in[9] + t_ * 128; float s1 = 0.f, s2 = 0.f; for (int d = 0; d < 32; ++d) { s1 += lp[d] * lp[32 + d]; s2 += lp[64 + d] * lp[96 + d]; }
                const float init = 0.8f - 0.6f * expf(-0.3f * (float)t_); lam[t_ * 2] = expf(s1) - expf(s2) + init; lam[t_ * 2 + 1] = init; }
        }
    }
}

template <int MODE>
__device__ __forceinline__ void naive_attn_item(CArgs ap, int l, int item, float* lds, int tid) {
    unsigned char* ws = ap->ws;
    const float* tab = (const float*)(ws + cfg::WS_TAB);
    const float* lut = tab + (MODE == 0 ? cfg::TAB_LUTA : cfg::TAB_LUTC) / 4;
    const unsigned char* mb = ws + cfg::WS_QKV + (size_t)MODE * cfg::QKV_MIX;
    const bf16* Qg = (const bf16*)mb; const bf16* Kg = (const bf16*)(mb + (size_t)T * 512); const bf16* Vg = (const bf16*)(mb + (size_t)T * 768);
    bf16* Y = (bf16*)ap->out;
    constexpr int QD = (MODE == 2) ? 32 : 64;
    int b, qb, hp = 0;
    if (MODE == 2) { hp = item & 1; qb = (item >> 1) % 33; b = (item >> 1) / 33; } else { qb = item % 33; b = item / 33; }
    const int gc = tid >> 7, i = tid & 127;
    int h, kvh, kofs;
    if (MODE == 2) { const int g = gc >> 1, c = gc & 1; h = 2 * hp + g; kvh = hp; kofs = kvh * 64 + 32 * c; }
    else { h = gc; kvh = h >> 1; kofs = kvh * 64; }
    const int pos = qb * 128 + i, m = b * L + pos;
    float* Ks = lds; float* Vs = lds + 64 * 128;
    float q[QD], o[64];
    { const bf16* qp = Qg + (size_t)m * 256 + h * 64 + (MODE == 2 ? 32 * (gc & 1) : 0);
#pragma unroll
      for (int d = 0; d < QD; d += 2) { const unsigned w = *(const unsigned*)(qp + d); q[d] = bflo(w); q[d + 1] = bfhi(w); } }
#pragma unroll
    for (int d = 0; d < 64; ++d) o[d] = 0.f;
    float mx = -1e30f, lsum = 0.f;
    int ktlo, nwin, ntiles;
    if (MODE == 0) { ktlo = 2 * qb - 2; if (ktlo < 2) ktlo = 2; int kthi = 2 * qb + 3; if (kthi > 65) kthi = 65; nwin = kthi - ktlo + 1; ntiles = nwin + 1; }
    else { ktlo = 1; nwin = 65; ntiles = 65; }
    for (int it = 0; it < ntiles; ++it) {
        const int kt = it < nwin ? ktlo + it : 1; const bool window = (MODE == 0) && it < nwin;
        __syncthreads();
        { const int j = tid >> 3, cc = (tid & 7) * 16; const size_t ro = (size_t)(b * L + kt * 64 + j) * 128 + cc;
          const v4u k0 = *(const v4u*)(Kg + ro), k1 = *(const v4u*)(Kg + ro + 8), v0 = *(const v4u*)(Vg + ro), v1 = *(const v4u*)(Vg + ro + 8);
          float* kd = Ks + j * 128 + cc; float* vd = Vs + j * 128 + cc;
#pragma unroll
          for (int e = 0; e < 4; ++e) { kd[2 * e] = bflo(k0[e]); kd[2 * e + 1] = bfhi(k0[e]); kd[8 + 2 * e] = bflo(k1[e]); kd[9 + 2 * e] = bfhi(k1[e]);
                                        vd[2 * e] = bflo(v0[e]); vd[2 * e + 1] = bfhi(v0[e]); vd[8 + 2 * e] = bflo(v1[e]); vd[9 + 2 * e] = bfhi(v1[e]); } }
        __syncthreads();
        for (int j = 0; j < 64; ++j) {
            const int kpos = kt * 64 + j;
            if (kpos < cfg::FRONT) continue;
            const int rel = kpos - pos;
            bool ok = true; float s = 0.f;
            if (MODE != 1) { const int cl = rel < -128 ? -128 : (rel > 128 ? 128 : rel); s = lut[(cl + 128) * 4 + h]; }
            if (window) ok = (rel >= -128) && (rel <= 128);
            const float* kr = Ks + j * 128 + kofs;
#pragma unroll
            for (int d = 0; d < QD; ++d) s += q[d] * kr[d];
            if (ok) {
                if (s > mx) { const float f = fexp2(mx - s); lsum *= f;
#pragma unroll
                    for (int d = 0; d < 64; ++d) o[d] *= f;
                    mx = s; }
                const float p = fexp2(s - mx); lsum += p;
                const float* vr = Vs + j * 128 + kvh * 64;
#pragma unroll
                for (int d = 0; d < 64; ++d) o[d] += p * vr[d];
            }
        }
    }
    if (MODE == 0) {
        const float s = ap->in[6][l * 4 + h] * cfg::LOG2E;
        if (s > mx) { const float f = fexp2(mx - s); lsum *= f;
#pragma unroll
            for (int d = 0; d < 64; ++d) o[d] *= f;
            mx = s; }
        lsum += fexp2(s - mx);
    }
    const float inv = 1.0f / lsum;
    if (MODE != 2) {
        bf16* yp = Y + (size_t)m * 1024 + (MODE == 0 ? 0 : 256) + h * 64;
#pragma unroll
        for (int d = 0; d < 64; d += 2) *(unsigned*)(yp + d) = pk2(o[d] * inv, o[d + 1] * inv);
    } else {
        const int g = gc >> 1, c = gc & 1;
        float* Ox = lds;
        __syncthreads();
        if (c == 1) { float* op = Ox + (size_t)(g * 128 + i) * 65;
#pragma unroll
            for (int d = 0; d < 64; ++d) op[d] = o[d] * inv; }
        __syncthreads();
        if (c == 0) {
            const float lam = tab[cfg::TAB_LAM / 4 + 2 * l], lam_init = tab[cfg::TAB_LAM / 4 + 2 * l + 1];
            const float* op = Ox + (size_t)(g * 128 + i) * 65; const float* sg = ap->in[10] + l * 64;
            float ss = 0.f;
#pragma unroll
            for (int d = 0; d < 64; ++d) { o[d] = o[d] * inv - lam * op[d]; ss += o[d] * o[d]; }
            const float r = __builtin_amdgcn_rsqf(ss * (1.0f / 64.0f) + cfg::RMS_EPS) * (1.0f - lam_init);
            bf16* yp = Y + (size_t)m * 1024 + 512 + h * 64;
#pragma unroll
            for (int d = 0; d < 64; d += 2) *(unsigned*)(yp + d) = pk2(o[d] * r * sg[d], o[d + 1] * r * sg[d + 1]);
        }
    }
}

__device__ __forceinline__ void hgrn_chain_item(CArgs ap, int l, int item, float* lds, int tid) {
    unsigned char* ws = ap->ws;
    const int dir = item & 1, h = (item >> 1) & 3, b = item >> 3;
    const float* lbt = (const float*)(ws + cfg::WS_TAB) + cfg::TAB_LB / 4 + (l * 2 + dir) * 256 + h * 64;
    const bf16* DQ = (const bf16*)(ws + cfg::WS_D); const bf16* Z = (const bf16*)(ws + cfg::WS_D + (size_t)(1 + dir) * cfg::D_ARR); const bf16* DI = (const bf16*)(ws + cfg::WS_D + 3 * cfg::D_ARR);
    bf16* O = (bf16*)(ws + cfg::WS_OFB + (size_t)dir * cfg::D_ARR);
    float* fS = lds; float* kS = lds + 1024; float* qS = lds + 2048; float* vS = lds + 3072; float* po = lds + 4096;
    const int kg = tid >> 6, v = tid & 63;
    float S[8];
#pragma unroll
    for (int i2 = 0; i2 < 8; ++i2) S[i2] = 0.f;
    constexpr int NB = L / 16;
    unsigned short zr[2], qr[2], vr[2];
    const int stt[2] = {tid >> 6, (tid >> 6) + 8}; const int sk = tid & 63;
#define HG_LOAD(bi) do { _Pragma("unroll") for (int e = 0; e < 2; ++e) { const int s_ = 16 * (bi) + stt[e]; const int pos_ = dir ? L - 1 - s_ : s_; const size_t off_ = (size_t)(b * L + pos_) * 256 + h * 64 + sk; \
        zr[e] = Z[off_]; qr[e] = DQ[off_]; vr[e] = DI[off_]; } } while (0)
#define HG_STAGE(bi) do { _Pragma("unroll") for (int e = 0; e < 2; ++e) { const int s_ = 16 * (bi) + stt[e]; const int pos_ = dir ? L - 1 - s_ : s_; \
        const float z_ = bf2f(zr[e]), ez_ = __expf(-z_), sg_ = 1.0f / (1.0f + ez_), sn_ = ez_ * sg_, lb_ = lbt[sk]; \
        fS[stt[e] * 64 + sk] = lb_ + (1.0f - lb_) * sg_; kS[stt[e] * 64 + sk] = pos_ >= cfg::FRONT ? (1.0f - lb_) * sn_ : 0.0f; qS[stt[e] * 64 + sk] = bf2f(qr[e]); vS[stt[e] * 64 + sk] = bf2f(vr[e]); } } while (0)
    __syncthreads();
    HG_LOAD(0); HG_STAGE(0);
    __syncthreads();
    typedef float f4 __attribute__((ext_vector_type(4)));
    for (int bi = 0; bi < NB; ++bi) {
        if (bi + 1 < NB) HG_LOAD(bi + 1);
#pragma unroll
        for (int tt = 0; tt < 16; ++tt) {
            const f4 f0 = *(const f4*)(fS + tt * 64 + kg * 8), f1 = *(const f4*)(fS + tt * 64 + kg * 8 + 4);
            const f4 k0 = *(const f4*)(kS + tt * 64 + kg * 8), k1 = *(const f4*)(kS + tt * 64 + kg * 8 + 4);
            const f4 q0 = *(const f4*)(qS + tt * 64 + kg * 8), q1 = *(const f4*)(qS + tt * 64 + kg * 8 + 4);
            const float vv = vS[tt * 64 + v];
            float acc = 0.f;
#pragma unroll
            for (int i2 = 0; i2 < 4; ++i2) { S[i2] = f0[i2] * S[i2] + k0[i2] * vv; acc += q0[i2] * S[i2]; }
#pragma unroll
            for (int i2 = 0; i2 < 4; ++i2) { S[4 + i2] = f1[i2] * S[4 + i2] + k1[i2] * vv; acc += q1[i2] * S[4 + i2]; }
            po[(tt * 8 + kg) * 64 + v] = acc;
        }
        __syncthreads();
#pragma unroll
        for (int e = 0; e < 2; ++e) { const int s_ = 16 * bi + stt[e]; const int pos_ = dir ? L - 1 - s_ : s_;
            float sum = 0.f;
#pragma unroll
            for (int g8 = 0; g8 < 8; ++g8) sum += po[(stt[e] * 8 + g8) * 64 + sk];
            O[(size_t)(b * L + pos_) * 256 + h * 64 + sk] = (bf16)f2bf(sum); }
        if (bi + 1 < NB) HG_STAGE(bi + 1);
        __syncthreads();
    }
#undef HG_LOAD
#undef HG_STAGE
}

__device__ __forceinline__ void phase_hgrn_post(CArgs ap, int l, int gw, int NGW, int lane) {
    unsigned char* ws = ap->ws;
    const bf16* OF = (const bf16*)(ws + cfg::WS_OFB); const bf16* OB = (const bf16*)(ws + cfg::WS_OFB + cfg::D_ARR); const bf16* DG = (const bf16*)(ws + cfg::WS_D + 4 * cfg::D_ARR);
    bf16* Y = (bf16*)ap->out;
    const float* og = ap->in[11] + l * 64 + ((4 * lane) & 63);
    for (int m = gw; m < T; m += NGW) {
        const size_t off = (size_t)m * 256 + 4 * lane;
        const v2u f = *(const v2u*)(OF + off), bb = *(const v2u*)(OB + off), g = *(const v2u*)(DG + off);
        float o[4] = {bflo(f.x) + bflo(bb.x), bfhi(f.x) + bfhi(bb.x), bflo(f.y) + bflo(bb.y), bfhi(f.y) + bfhi(bb.y)};
        const float gg[4] = {bflo(g.x), bfhi(g.x), bflo(g.y), bfhi(g.y)};
        float ss = (o[0] * o[0] + o[1] * o[1]) + (o[2] * o[2] + o[3] * o[3]);
        ss += __shfl_xor(ss, 1); ss += __shfl_xor(ss, 2); ss += __shfl_xor(ss, 4); ss += __shfl_xor(ss, 8);
        const float r = __builtin_amdgcn_rsqf(ss * (1.0f / 64.0f) + cfg::RMS_EPS);
        float y[4];
#pragma unroll
        for (int j = 0; j < 4; ++j) y[j] = o[j] * r * og[j] * (gg[j] / (1.0f + __expf(-gg[j])));
        v2u w; w.x = pk2(y[0], y[1]); w.y = pk2(y[2], y[3]);
        *(v2u*)(Y + (size_t)m * 1024 + 768 + 4 * lane) = w;
    }
}

__device__ __forceinline__ void phase_final(CArgs ap, int gw, int NGW, int lane) {
    typedef float f4 __attribute__((ext_vector_type(4)));
    const f4* gl = (const f4*)ap->in[18]; const bf16* hb = (const bf16*)(ap->ws + cfg::WS_HB);
    f4 g[4];
#pragma unroll
    for (int j = 0; j < 4; ++j) g[j] = gl[64 * j + lane];
    constexpr int NR = cfg::BATCH * cfg::SEQ;
    for (int r = gw; r < NR; r += NGW) {
        const int b = r / cfg::SEQ, s_ = r - b * cfg::SEQ; const v2u* src = (const v2u*)(hb + (size_t)(b * cfg::L + cfg::MEND + s_) * 1024);
        f4 v[4];
#pragma unroll
        for (int j = 0; j < 4; ++j) { const v2u w = src[64 * j + lane]; v[j] = (f4){bflo(w.x), bfhi(w.x), bflo(w.y), bfhi(w.y)}; }
        float s = 0.f;
#pragma unroll
        for (int j = 0; j < 4; ++j) s += (v[j][0] * v[j][0] + v[j][1] * v[j][1]) + (v[j][2] * v[j][2] + v[j][3] * v[j][3]);
        const float rs = __builtin_amdgcn_rsqf(wave_sum(s) * (1.0f / 1024.0f) + cfg::RMS_EPS);
        f4* row = (f4*)(ap->out + (size_t)r * 1024);
#pragma unroll
        for (int j = 0; j < 4; ++j) row[64 * j + lane] = v[j] * rs * g[j];
    }
}

constexpr int PH_PER_LAYER = 9, PH_FINAL = 18, N_PHASES = 19;
__global__ void __launch_bounds__(NWAVES * 64, 2) enc_fwd(Args a_unused) {
    extern __shared__ __attribute__((aligned(16))) unsigned char lds[];
    LAS unsigned char* ldsl = (LAS unsigned char*)lds;
    const int G = gridDim.x, bx = blockIdx.x, NGW = G * NWAVES;
    const int wave0 = __builtin_amdgcn_readfirstlane(threadIdx.x >> 6);
#define TIDS() unsigned z_ = 0u; asm volatile("" : "+v"(z_)); int tid = (wave0 << 6) | (int)__builtin_amdgcn_mbcnt_hi(~0u, __builtin_amdgcn_mbcnt_lo(~0u, z_));     \
    int bxl = bx; asm volatile("" : "+s"(bxl)); const int lane = tid & 63, wave = __builtin_amdgcn_readfirstlane(tid >> 6), gw = bxl * NWAVES + wave; (void)lane; (void)gw
    int lo, hi; { CArgs ap = phase_args(); lo = ap->ph_lo; hi = ap->ph_hi; }
#define IN(k) (lo <= (k) && (k) < hi)
#define HG_PTRS() const float* lbt_ = (const float*)(ws + cfg::WS_TAB + cfg::TAB_LB) + l * 512; \
    hg::Ptrs HP{(const bf16*)(ws + cfg::WS_D), (const bf16*)(ws + cfg::WS_D + cfg::D_ARR), (const bf16*)(ws + cfg::WS_D + 2 * cfg::D_ARR), (const bf16*)(ws + cfg::WS_D + 3 * cfg::D_ARR), (const bf16*)(ws + cfg::WS_D + 4 * cfg::D_ARR), \
                lbt_, lbt_ + 256, (float*)(ws + cfg::WS_OFB), (float*)(ws + cfg::WS_TAB + 65536)}
    for (int u = threadIdx.x; u < (cfg::LDS_BYTES - 131072) / 4; u += NWAVES * 64) ((LAS unsigned*)(ldsl + 131072))[u] = 0u;
    __syncthreads();
#if MK_SPLIT
#define GRID_BAR(k) do {} while (0)
#else
    cg::grid_group grid = cg::this_grid();
#if USE_XCD_BAR
    { CArgs ap = phase_args(); (void)xcd_barrier_post((unsigned*)ap->ws + CW_BAR, (volatile LAS unsigned*)(ldsl + MISC_OFF) + 8); }
#define GRID_BAR(k) do { { CArgs ap_ = phase_args(); XcdBarrier b_; b_.bar = (unsigned*)ap_->ws + CW_BAR; b_.x = xb_xcc_id(); { unsigned z_ = 0u; asm volatile("" : "+v"(z_)); b_.t0 = (wave0 == 0) && (__builtin_amdgcn_mbcnt_hi(~0u, __builtin_amdgcn_mbcnt_lo(~0u, z_)) == 0u); } b_.st = (volatile LAS unsigned*)(ldsl + MISC_OFF) + 8; xcd_barrier(b_); } } while (0)
#else
#define GRID_BAR(k) grid.sync()
#endif
#endif
#define SEAM(k) do { if (IN(k) && IN((k) + 1)) GRID_BAR(k); } while (0)
    for (int l = 0; l < cfg::DEPTH; ++l) {
        const int p0 = l * PH_PER_LAYER;
        if (l == 0 && IN(p0 + 0) && !(DIS & 1)) for (int rep_ = 0; rep_ < 1 + ((PROBE_REP >> 0) & 1); ++rep_) { if (rep_) GRID_BAR(1); TIDS(); CArgs ap = phase_args(); phase_w(ap, l, ldsl, gw, NGW, wave, lane); phase_init(ap, gw, NGW, lane, tid); }
        if (l == 0) SEAM(p0 + 0);
        if (IN(p0 + 1) && !(DIS & 2)) for (int rep_ = 0; rep_ < 1 + ((PROBE_REP >> 1) & 1); ++rep_) { if (rep_) GRID_BAR(1);
            TIDS(); CArgs ap = phase_args(); unsigned char* ws = ap->ws;
            pg8::Gemm g{(const bf16*)(ws + cfg::WS_HB), (const bf16*)(ws + cfg::WS_W1), T, cfg::NIN, 1024}; pg8::StaticOrder S; S.init(T, cfg::NIN, G, bxl);
            pg8::build_rstd_tables(S, (const float*)(ws + cfg::WS_SSQ), (LAS float*)(ldsl + pg8::RSTD_LDS_OFF), tid);
            pg8::Epi1 E{ws};
            pg8::gemm_phase<pg8::Epi1, pg8::StaticOrder, true, true>(ldsl, g, S, E, tid);
        }
        SEAM(p0 + 1);
        if (IN(p0 + 2) && !(DIS & 4)) for (int rep_ = 0; rep_ < 1 + ((PROBE_REP >> 2) & 1); ++rep_) { if (rep_) GRID_BAR(1);
            TIDS(); CArgs ap = phase_args(); unsigned char* ws = ap->ws;
#if NAIVE_ATTN
            constexpr int NI = 32 + 132 + 132 + 264;
            for (int it = bxl; it < NI; it += G) {
                __syncthreads();
                if (it < 32) hgrn_chain_item(ap, l, it, (float*)lds, tid);
                else if (it < 164) naive_attn_item<0>(ap, l, it - 32, (float*)lds, tid);
                else if (it < 296) naive_attn_item<1>(ap, l, it - 164, (float*)lds, tid);
                else naive_attn_item<2>(ap, l, it - 296, (float*)lds, tid);
            }
#else
            constexpr int CV1 = W_I1 / 64, CV2 = (W_NITEMS - W_I1) / 64;
            const int NCV = (l == 0) ? CV1 + CV2 : CV2;
            const int NH = 272, Q_SC = NH, Q_C = Q_SC + 32, Q_B = Q_C + 528, Q_CV = Q_B + 264, Q_A = Q_CV + NCV, Q_S3 = Q_A + 264, NI = Q_S3 + 272;
            volatile LAS unsigned* nxt = (volatile LAS unsigned*)(ldsl + MISC_OFF) + 16;
            const bool t0 = (tid == 0);
            unsigned nx = 0u; const unsigned one_ = 1u;
            if (t0) { CArgs ap3 = phase_args(); unsigned* hp_ = (unsigned*)ap3->ws + CW_SCHED + 64 * l + 128 * rep_; asm volatile("global_atomic_add %0, %1, %2, off sc0" : "=v"(nx) : "v"(hp_), "v"(one_) : "memory"); }
            { float* lutl = (float*)(lds + att::LDS_LUT); const float* tab = (const float*)(ws + cfg::WS_TAB);
              for (int i = tid; i < 1028; i += 512) { const int d_ = (i & 3) * 260 + (i >> 2); lutl[d_] = tab[cfg::TAB_LUTC / 4 + i]; lutl[1088 + d_] = tab[cfg::TAB_LUTA / 4 + i]; }
              if (tid < 64) { CArgs ap4 = phase_args(); lutl[2176 + tid] = ap4->in[10][l * 64 + tid]; lutl[2240 + tid] = ap4->in[11][l * 64 + tid]; if (tid < 4) lutl[2304 + tid] = ap4->in[6][l * 4 + tid]; } }
            for (;;) {
                if (t0) { asm volatile("s_waitcnt vmcnt(0)" : "+v"(nx) :: "memory"); *nxt = nx; }
                __syncthreads();
                int it = __builtin_amdgcn_readfirstlane((int)*nxt); asm volatile("" : "+s"(it));
                __syncthreads();
                if (it >= NI) break;
                if (t0) { CArgs ap3 = phase_args(); unsigned* hp_ = (unsigned*)ap3->ws + CW_SCHED + 64 * l + 128 * rep_; asm volatile("global_atomic_add %0, %1, %2, off sc0" : "=v"(nx) : "v"(hp_), "v"(one_) : "memory"); }
                int tq = tid; asm volatile("" : "+v"(tq));
                CArgs ap2 = phase_args(); unsigned char* ws = ap2->ws;
                unsigned* dep = (unsigned*)ws + CW_DEP + (l * 16) * 128 + rep_ * 4096;
#if PROBE_REP
                if (rep_ && !((PROBE_QMASK >> (it < NH ? 0 : it < Q_C ? 5 : it < Q_B ? 2 : it < Q_CV ? 1 : it < Q_A ? 4 : it < Q_S3 ? 3 : 6)) & 1)) continue;
#endif
                unsigned* sig = nullptr;
                if (it < NH) { HG_PTRS(); hg::s1_item(HP, it, (unsigned char*)lds, tq); sig = dep + hg::hg_item_bh(it) * 128; }
                else if (it >= Q_C && it < Q_B) { const float* tabf = (const float*)(ws + cfg::WS_TAB); att::Ctx C{ws + cfg::WS_QKV + 2 * cfg::QKV_MIX, (bf16*)ap2->out, nullptr, (const float*)(lds + att::LDS_LUT) + 2176, tabf[cfg::TAB_LAM / 4 + 2 * l], 1.0f - tabf[cfg::TAB_LAM / 4 + 2 * l + 1]}; ATT_UNIT<2>(C, it - Q_C, (char*)lds, tq); }
                else if (it < Q_C) { const int chain = it - Q_SC, bh = chain >> 1; dep_wait(dep + bh * 128, 17u, t0); HG_PTRS(); hg::scan_chain(HP, chain, tq); sig = dep + bh * 128 + 64; }
                else if (it < Q_CV) { att::Ctx C{ws + cfg::WS_QKV + 1 * cfg::QKV_MIX, (bf16*)ap2->out, nullptr, nullptr, 0.f, 0.f}; ATT_UNIT<1>(C, it - Q_B, (char*)lds, tq); }
                else if (it < Q_A) { const int wv = __builtin_amdgcn_readfirstlane(tq >> 6), ci = it - Q_CV; LAS float* scr = (LAS float*)(ldsl + wv * 16384); if (it == Q_CV && l == 0 && tq < 64) w_gains(ap2, 1, tq);
                    const bool nextW1 = (l == 0) && ci < CV1; const int lw = nextW1 ? 1 : l, r0 = (nextW1 ? ci * 64 : W_I1 + (ci - (l == 0 ? CV1 : 0)) * 64) + wv * 8;
                    w_run(ap2, lw, r0, 8, 1, scr, tq & 63); }
                else if (it < Q_S3) { att::Ctx C{ws + cfg::WS_QKV, (bf16*)ap2->out, (const float*)(lds + att::LDS_LUT) + 2304, nullptr, 0.f, 0.f}; att::attn_unit<0>(C, it - Q_A, (char*)lds, tq); }
                else { const int i3 = it - Q_S3; HG_PTRS(); hg::s3_item(HP, (const float*)(lds + att::LDS_LUT) + 2240, (bf16*)ap2->out, i3, (unsigned char*)lds, tq, [&]() { if (!(PROBE_REP && rep_ && !((PROBE_QMASK >> 5) & 1))) dep_wait(dep + hg::hg_item_bh(i3) * 128 + 64, 2u, t0); }); }
                asm volatile("" : "+s"(sig));
                dep_signal(sig, t0);
            }
#endif
        }
        SEAM(p0 + 2);
#if NAIVE_ATTN
        if (IN(p0 + 3) && !(DIS & 8)) { TIDS(); CArgs ap = phase_args(); phase_hgrn_post(ap, l, gw, NGW, lane); }
        SEAM(p0 + 3);
#endif
        if (IN(p0 + 5) && !(DIS & 16)) for (int rep_ = 0; rep_ < 1 + ((PROBE_REP >> 5) & 1); ++rep_) { if (rep_) GRID_BAR(1);
            TIDS(); CArgs ap = phase_args(); unsigned char* ws = ap->ws;
            pg8::tail_branch((const bf16*)ap->out  , (const bf16*)(ws + cfg::WS_WB), ws + cfg::WS_GATE, (bf16*)(ws + cfg::WS_MERGED), bxl, wave, lane, (float*)lds);
            pg8::Gemm g{(const bf16*)ap->out  , (const bf16*)(ws + cfg::WS_WB), pg8::TAIL_ROW0, 1024, 1024}; pg8::StaticOrder S; S.init(pg8::TAIL_ROW0, 1024, G, bxl);
            pg8::EpiHorner E{ws};
            pg8::gemm_phase<pg8::EpiHorner, pg8::StaticOrder, true, true>(ldsl, g, S, E, tid);
        }
        SEAM(p0 + 5);
        if (IN(p0 + 6) && !(DIS & 32)) for (int rep_ = 0; rep_ < 1 + ((PROBE_REP >> 6) & 1); ++rep_) { if (rep_) GRID_BAR(1);
            TIDS(); CArgs ap = phase_args(); unsigned char* ws = ap->ws;
            pg8::tail_res((const bf16*)(ws + cfg::WS_MERGED), (const bf16*)(ws + cfg::WS_WO), 1024, ap->out, (bf16*)(ws + cfg::WS_HB), (float*)(ws + cfg::WS_SSQ), 1, nullptr, nullptr, bxl, wave, lane, (float*)lds);
            pg8::Gemm g{(const bf16*)(ws + cfg::WS_MERGED), (const bf16*)(ws + cfg::WS_WO), pg8::TAIL_ROW0, 1024, 1024}; pg8::StaticOrder S; S.init(pg8::TAIL_ROW0, 1024, G, bxl);
            pg8::EpiRes E{ws, 1};
            pg8::gemm_phase<pg8::EpiRes, pg8::StaticOrder, true, true>(ldsl, g, S, E, tid);
        }
        SEAM(p0 + 6);
        if (IN(p0 + 7) && !(DIS & 64)) for (int rep_ = 0; rep_ < 1 + ((PROBE_REP >> 7) & 1); ++rep_) { if (rep_) GRID_BAR(1);
            TIDS(); CArgs ap = phase_args(); unsigned char* ws = ap->ws;
            pg8::Gemm g{(const bf16*)(ws + cfg::WS_HB), (const bf16*)(ws + cfg::WS_WGU), T, cfg::NGU, 1024}; pg8::StaticOrder S; S.init(T, cfg::NGU, G, bxl);
            pg8::build_rstd_tables(S, (const float*)(ws + cfg::WS_SSQ), (LAS float*)(ldsl + pg8::RSTD_LDS_OFF), tid);
            pg8::EpiGLU E{ws};
            pg8::gemm_phase<pg8::EpiGLU, pg8::StaticOrder, true, true>(ldsl, g, S, E, tid);
        }
        SEAM(p0 + 7);
        if (IN(p0 + 8) && !(DIS & 128)) for (int rep_ = 0; rep_ < 1 + ((PROBE_REP >> 8) & 1); ++rep_) { if (rep_) GRID_BAR(1);
            TIDS(); CArgs ap = phase_args(); unsigned char* ws = ap->ws;
            const bool fuse_final = (l + 1 == cfg::DEPTH) && (G == 256);
            pg8::tail_res((const bf16*)(ws + cfg::WS_FF), (const bf16*)(ws + cfg::WS_WD), cfg::DFF, ap->out, (bf16*)(ws + cfg::WS_HB), (float*)(ws + cfg::WS_SSQ), (l + 1 < cfg::DEPTH), fuse_final ? ap->in[18] : nullptr, (unsigned*)ws + cfg::CW_FIN + 1024, bxl, wave, lane, (float*)lds);
            pg8::Gemm g{(const bf16*)(ws + cfg::WS_FF), (const bf16*)(ws + cfg::WS_WD), pg8::TAIL_ROW0, 1024, cfg::DFF}; pg8::StaticOrder S; S.init(pg8::TAIL_ROW0, 1024, G, bxl);
            if (fuse_final) { pg8::EpiResFinal E{ap->out, ws, ap->in[18]}; pg8::gemm_phase<pg8::EpiResFinal, pg8::StaticOrder, false, true>(ldsl, g, S, E, tid); }
            else { pg8::EpiRes E{ws, (l + 1 < cfg::DEPTH) ? 1 : 0}; pg8::gemm_phase<pg8::EpiRes, pg8::StaticOrder, true, true>(ldsl, g, S, E, tid); }
        }
        if (!((l + 1 == cfg::DEPTH) && (G == 256))) SEAM(p0 + 8);
    }
    if (IN(PH_FINAL) && G != 256) { TIDS(); CArgs ap = phase_args(); phase_final(ap, gw, NGW, lane); }
#undef IN
#undef SEAM
}

extern "C" void kernel_launch(void* const* d_in, const int* in_sizes, int n_in, void* d_out, int out_size, void* d_ws, size_t ws_size, hipStream_t stream) {
    static int grid = 0;
    if (grid == 0) {
        if (n_in != 19 || ws_size < cfg::WS_END || out_size != cfg::BATCH * cfg::SEQ * cfg::DM) { fprintf(stderr, "kernel_launch: unexpected problem (n_in %d, ws %zu, out %d)\n", n_in, ws_size, out_size); grid = -1; return; }
        int dev = 0, cus = 0, per_cu = 0;
        hipGetDevice(&dev); hipDeviceGetAttribute(&cus, hipDeviceAttributeMultiprocessorCount, dev);
        hipFuncSetAttribute((const void*)enc_fwd, hipFuncAttributeMaxDynamicSharedMemorySize, cfg::LDS_BYTES);
        hipOccupancyMaxActiveBlocksPerMultiprocessor(&per_cu, (const void*)enc_fwd, NWAVES * 64, cfg::LDS_BYTES);
        if (per_cu < 1) { fprintf(stderr, "kernel_launch: occupancy query says %d blocks per CU\n", per_cu); per_cu = 1; }
        (void)hipGetLastError();
        grid = cus;
        if (cus != 256) fprintf(stderr, "kernel_launch: %d CUs; this kernel's thin-tail task map assumes 256 workgroups\n", cus);
    }
    if (grid < 0) return;
    (void)hipMemsetAsync(d_ws, 0, CTL_ZERO_BYTES, stream);
    Args a{};
    for (int i = 0; i < 19; ++i) a.in[i] = (const float*)d_in[i];
    a.out = (float*)d_out; a.ws = (unsigned char*)d_ws;
#if MK_SPLIT
    for (int p = 0; p < N_PHASES; ++p) { a.ph_lo = p; a.ph_hi = p + 1; hipLaunchKernelGGL(enc_fwd, dim3(grid), dim3(NWAVES * 64), cfg::LDS_BYTES, stream, a); }
#else
    a.ph_lo = 0; a.ph_hi = N_PHASES;
    void* args[] = {&a};
    hipError_t e = hipLaunchCooperativeKernel((const void*)enc_fwd, dim3(grid), dim3(NWAVES * 64), args, cfg::LDS_BYTES, stream);
    if (e != hipSuccess) fprintf(stderr, "kernel_launch: cooperative launch failed: %s (grid %d)\n", hipGetErrorString(e), grid);
#endif
}
```

```cpp
#include <hip/hip_runtime.h>
#include <hip/hip_cooperative_groups.h>
#include <cstdio>
#include <cstdint>
namespace cg = cooperative_groups;

namespace cfg {
constexpr int BATCH = 4, SEQ = 4096, DM = 1024, L = 4224, T = BATCH * L, FRONT = 112, NMETA = 16, MEND = 128;
constexpr int NIN = 6912, DFF = 2816, NGU = 2 * DFF, DEPTH = 2;
constexpr float LOG2E = 1.4426950408889634f;
constexpr float QSCALE64 = 0.125f * LOG2E;
constexpr float QSCALE32 = 0.17677669529663687f * LOG2E;
constexpr float RMS_EPS = 1e-6f;
constexpr size_t MiB = 1u << 20;
constexpr size_t WS_TAB = 1 * MiB;
constexpr size_t TAB_RT = 0, TAB_LUTA = 16384, TAB_LUTC = 32768, TAB_LB = 49152, TAB_LAM = 57344, TAB_QKG = 57600;
constexpr size_t WS_W1 = 2 * MiB;
constexpr size_t WS_WB = WS_W1 + (size_t)NIN * DM * 2;
constexpr size_t WS_WO = WS_WB + (size_t)DM * DM * 2;
constexpr size_t WS_WGU = WS_WO + (size_t)DM * DM * 2;
constexpr size_t WS_WD = WS_WGU + (size_t)NGU * DM * 2;
constexpr size_t WS_HB = 36 * MiB;
constexpr size_t WS_QKV = 69 * MiB;
constexpr size_t QKV_MIX = (size_t)T * 512 * 2;
constexpr size_t WS_MERGED = WS_QKV;
constexpr size_t WS_D = WS_QKV + 3 * QKV_MIX;
constexpr size_t D_ARR = (size_t)T * 256 * 2;
constexpr size_t WS_GATE = WS_D + 5 * D_ARR;
constexpr size_t WS_OFB = WS_GATE + (size_t)T * 4096;
constexpr size_t WS_SSQ = WS_OFB + 2 * D_ARR;
constexpr size_t WS_HSIDE = 244 * MiB;
constexpr size_t WS_FF = WS_QKV;
constexpr size_t WS_END = WS_HSIDE + (size_t)BATCH * 128 * DM * 4;
static_assert(WS_WD + (size_t)DM * DFF * 2 <= WS_HB, "weights fit below HB");
static_assert(WS_HB + (size_t)T * DM * 2 <= WS_QKV, "HB fits");
static_assert(WS_FF + (size_t)T * DFF * 2 <= WS_GATE, "FF overlay fits below GATE");
static_assert(WS_SSQ + (size_t)T * 16 * 4 <= WS_HSIDE, "SSQ fits");
static_assert(WS_END <= 256 * MiB, "workspace fits 256 MiB");
constexpr int CW_FIN = 9216;
constexpr int LDS_BYTES = 147456;
}

typedef unsigned short bf16;
#define GAS __attribute__((address_space(1)))
#define LAS __attribute__((address_space(3)))
typedef unsigned v4u __attribute__((ext_vector_type(4)));
typedef unsigned v2u __attribute__((ext_vector_type(2)));
typedef float f32x2_g __attribute__((ext_vector_type(2))); typedef __bf16 bf16x2_g __attribute__((ext_vector_type(2)));
__device__ __forceinline__ unsigned pk2(float lo, float hi) { f32x2_g v = {lo, hi}; bf16x2_g b = __builtin_convertvector(v, bf16x2_g); return __builtin_bit_cast(unsigned, b); }
__device__ __forceinline__ unsigned f2bf(float f) { return pk2(f, 0.0f); }
__device__ __forceinline__ float bf2f(unsigned short h) { return __builtin_bit_cast(float, (unsigned)h << 16); }
__device__ __forceinline__ float bflo(unsigned w) { return __builtin_bit_cast(float, w << 16); }
__device__ __forceinline__ float bfhi(unsigned w) { return __builtin_bit_cast(float, w & 0xffff0000u); }
__device__ __forceinline__ float fexp2(float x) { return __builtin_amdgcn_exp2f(x); }
__device__ __forceinline__ float sigmoidf_(float x) { return 1.0f / (1.0f + __expf(-x)); }

namespace pg8 {
#define PG8_LAS __attribute__((address_space(3)))
typedef unsigned short bf16_t;
typedef short bf16x8 __attribute__((ext_vector_type(8)));
typedef float f32x4 __attribute__((ext_vector_type(4)));
typedef unsigned u32x4 __attribute__((ext_vector_type(4)));
constexpr int BM = 256, BK = 64, HALF = 128, HTB = HALF * BK * 2  , STAGE_BYTES = 8 * HTB, NXCD = 8, WGM = 8;

__host__ __device__ __forceinline__ int lds_byte(int r, int c) { const int st = (r >> 4) * 2 + (c >> 5), rr = r & 15, cc = c & 31, ob = rr * 64 + cc * 2; return st * 1024 + (ob ^ (((ob >> 9) & 1) << 5)); }
__host__ __device__ __forceinline__ void stage_rc(int b, int& R, int& C) { const int st = b / 1024, sb = b % 1024, swz = sb ^ (((sb >> 9) & 1) << 5); R = (st >> 1) * 16 + swz / 64; C = (st & 1) * 32 + (swz % 64) / 2; }
__host__ __device__ __forceinline__ int perm32(int rho) { const int n = rho >> 4, i = rho & 15; return 8 * (i >> 2) + 4 * n + (i & 3); }

struct Unit { int pm, pn; };
struct Gemm { const bf16_t* A; const bf16_t* Bt; int M, N, K; };

struct StaticOrder {
    int nM, nN, nwg, G, c;
    __host__ __device__ void init(int M, int N, int G_, int c_) { nM = M / BM; nN = N / BM; nwg = nM * nN; G = G_; c = c_; }
    __host__ __device__ bool next(int i, Unit& u) const {
        const long L = (long)i * G + c; if (L >= nwg) return false;
        int wgid = (int)L; { const int q = nwg / NXCD, r = nwg % NXCD, xcd = wgid % NXCD, off = wgid / NXCD; wgid = (xcd < r ? xcd * (q + 1) : r * (q + 1) + (xcd - r) * q) + off; }
        const int nig = WGM * nN, gid = wgid / nig, fm = gid * WGM, gsz = (nM - fm) < WGM ? (nM - fm) : WGM;
        u.pm = fm + ((wgid % nig) % gsz); u.pn = (wgid % nig) / gsz; return true;
    }
    __device__ __forceinline__ void a_ready(const Unit&) const {}
    __device__ __forceinline__ void done(const Unit&) const {}
};


__device__ __forceinline__ unsigned cvt_pk_bf16(float lo, float hi) { unsigned r; asm volatile("v_cvt_pk_bf16_f32 %0, %1, %2" : "=v"(r) : "v"(lo), "v"(hi)); return r; }
typedef unsigned u32x2 __attribute__((ext_vector_type(2)));
__device__ __forceinline__ float row_rstd(const float* ssq, int r) {
    const f32x4* p = (const f32x4*)(ssq + (size_t)r * 16);
    const f32x4 a = p[0], b = p[1], c = p[2], d = p[3];
    const float s = (((a[0] + a[1]) + (a[2] + a[3])) + ((b[0] + b[1]) + (b[2] + b[3]))) + (((c[0] + c[1]) + (c[2] + c[3])) + ((d[0] + d[1]) + (d[2] + d[3])));
    return __builtin_amdgcn_rsqf(s * (1.0f / 1024.0f) + cfg::RMS_EPS);
}
__device__ __forceinline__ void rows_rstd(const float* ssq, int rbase, float (&rs)[2][4]) {
#pragma unroll
    for (int ai = 0; ai < 2; ++ai) {
        f32x4 t[4][4];
#pragma unroll
        for (int m = 0; m < 4; ++m) { const f32x4* p = (const f32x4*)(ssq + (size_t)(rbase + ai * HALF + m * 16) * 16);
#pragma unroll
            for (int q = 0; q < 4; ++q) t[m][q] = p[q]; }
#pragma unroll
        for (int m = 0; m < 4; ++m) { float s = 0.f;
#pragma unroll
            for (int q = 0; q < 4; ++q) s += (t[m][q][0] + t[m][q][1]) + (t[m][q][2] + t[m][q][3]);
            rs[ai][m] = __builtin_amdgcn_rsqf(s * (1.0f / 1024.0f) + cfg::RMS_EPS); }
        asm volatile("" : "+v"(rs[ai][0]), "+v"(rs[ai][1]), "+v"(rs[ai][2]), "+v"(rs[ai][3]));
    }
}
__device__ __forceinline__ void st_bf16x4(bf16_t* p, f32x4 v) { u32x2 w; w.x = cvt_pk_bf16(v[0], v[1]); w.y = cvt_pk_bf16(v[2], v[3]); *(u32x2*)p = w; }
__device__ __forceinline__ void st_bf16x4_pair(bf16_t* p, f32x4 v0, f32x4 v1, int fq) {
    const unsigned a0 = cvt_pk_bf16(v0[0], v0[1]), a1 = cvt_pk_bf16(v0[2], v0[3]), b0 = cvt_pk_bf16(v1[0], v1[1]), b1 = cvt_pk_bf16(v1[2], v1[3]);
    const auto s0 = __builtin_amdgcn_permlane16_swap(a0, b0, false, false); const auto s1 = __builtin_amdgcn_permlane16_swap(a1, b1, false, false);
    u32x4 o; o.x = s0[0]; o.y = s1[0]; o.z = s0[1]; o.w = s1[1];
    *(u32x4*)((fq & 1) ? p + 16 - 4 : p) = o;
}

constexpr int RSTD_LDS_OFF = 131072 + 1024, RSTD_SLOTS = 8;
template <class Sched>
__device__ __forceinline__ void build_rstd_tables(const Sched& S, const float* ssq, PG8_LAS float* tab, int tid) {
    const int row = tid >> 1, half = tid & 1; Unit u; PG8_LAS int* pmt = (PG8_LAS int*)(tab + RSTD_SLOTS * 256);
    if (tid < RSTD_SLOTS) pmt[tid] = -1;
    __syncthreads();
    int ns = 0, last = -1;
    for (int i = 0; ns < RSTD_SLOTS && S.next(i, u); ++i) {
        if (u.pm == last) continue;
        last = u.pm;
        const f32x4* p = (const f32x4*)(ssq + (size_t)(u.pm * BM + row) * 16 + 8 * half); const f32x4 a = p[0], b = p[1];
        float s = ((a[0] + a[1]) + (a[2] + a[3])) + ((b[0] + b[1]) + (b[2] + b[3]));
        s += __shfl_xor(s, 1);
        if (half == 0) tab[ns * 256 + row] = __builtin_amdgcn_rsqf(s * (1.0f / 1024.0f) + cfg::RMS_EPS);
        if (tid == 0) pmt[ns] = u.pm;
        ++ns;
    }
    __syncthreads();
}
__device__ __forceinline__ void rows_rstd_lds(const PG8_LAS float* tab, int pm, int wr, int fr, float (&rs)[2][4]) {
    const PG8_LAS int* pmt = (const PG8_LAS int*)(tab + RSTD_SLOTS * 256);
    int slot = 0;
#pragma unroll
    for (int j = 1; j < RSTD_SLOTS; ++j) if (pmt[j] == pm) slot = j;
#pragma unroll
    for (int ai = 0; ai < 2; ++ai)
#pragma unroll
        for (int m = 0; m < 4; ++m) rs[ai][m] = tab[slot * 256 + ai * HALF + wr * 64 + m * 16 + fr];
}

struct Epi1 {
    static constexpr bool PERM = false, AFTER_DRAIN = false, HOOK = false;
    unsigned char* ws;
    __device__ __forceinline__ void hook(f32x4 (&)[2][2][4][2], const Unit&, int, int, int, int, int) const {}
    __device__ __forceinline__ void operator()(const f32x4 (&acc)[2][2][4][2], const Unit& u, int wr, int wc, int fr, int fq) const {
        const int pn = u.pn;
        const PG8_LAS float* tab = (const PG8_LAS float*)RSTD_LDS_OFF;
        float rsv[2][4]; rows_rstd_lds(tab, u.pm, wr, fr, rsv);
        if (pn < 6) {
            const float* rt = (const float*)(ws + cfg::WS_TAB + cfg::TAB_RT); const float* gq = (const float*)(ws + cfg::WS_TAB + cfg::TAB_QKG); const float* gk = gq + 64;
            const int mixer = pn >> 1;
            unsigned char* mb = ws + cfg::WS_QKV + (size_t)mixer * cfg::QKV_MIX;
            bf16_t* base; int pitch, colofs; float scale = 1.0f; int mode = 0; const float* g = gq;
            if (!(pn & 1)) { base = (bf16_t*)mb; pitch = 256; colofs = wc * 64; scale = (mixer == 2) ? cfg::QSCALE32 : cfg::QSCALE64; mode = (mixer == 1); }
            else if (wc < 2) { base = (bf16_t*)(mb + (size_t)cfg::T * 512); pitch = 128; colofs = wc * 64; mode = (mixer == 1); g = gk; }
            else { base = (bf16_t*)(mb + (size_t)cfg::T * 768); pitch = 128; colofs = (wc - 2) * 64; }
            f32x4 gain[2][2];
            if (mode) {
#pragma unroll
                for (int bj = 0; bj < 2; ++bj)
#pragma unroll
                    for (int n = 0; n < 2; ++n) gain[bj][n] = *(const f32x4*)(g + 32 * bj + 16 * n + 4 * fq);
            }
#pragma unroll
            for (int ai = 0; ai < 2; ++ai)
#pragma unroll
                for (int m = 0; m < 4; ++m) {
                    const int r = u.pm * BM + ai * HALF + wr * 64 + m * 16 + fr;
                    const float rs = rsv[ai][m];
                    f32x4 x[2][2];
#pragma unroll
                    for (int bj = 0; bj < 2; ++bj)
#pragma unroll
                        for (int n = 0; n < 2; ++n) x[bj][n] = acc[ai][bj][m][n] * rs;
                    if (mode) {
                        float ss = 0.f;
#pragma unroll
                        for (int bj = 0; bj < 2; ++bj)
#pragma unroll
                            for (int n = 0; n < 2; ++n) { const f32x4 v = x[bj][n]; ss += (v[0] * v[0] + v[1] * v[1]) + (v[2] * v[2] + v[3] * v[3]); }
                        ss += __shfl_xor(ss, 16); ss += __shfl_xor(ss, 32);
                        const float r2 = __builtin_amdgcn_rsqf(ss * (1.0f / 64.0f) + cfg::RMS_EPS);
                        const int b = r / cfg::L, pos = r - b * cfg::L;
                        int tv[2];
                        if (pos < cfg::FRONT) { tv[0] = 1; tv[1] = 1; }
                        else if (pos < cfg::MEND) { tv[0] = 0; tv[1] = pos - cfg::FRONT + 1; }
                        else { const int s = pos - cfg::MEND; tv[0] = (s >> 6) + 1; tv[1] = (s & 63) + 1; }
#pragma unroll
                        for (int bj = 0; bj < 2; ++bj) {
                            const f32x4* cs = (const f32x4*)(rt + (size_t)(tv[bj] * 16 + 4 * fq) * 2);
                            const f32x4 cs0 = cs[0], cs1 = cs[1];
                            const f32x4 y1 = x[bj][0] * gain[bj][0] * r2, y2 = x[bj][1] * gain[bj][1] * r2;
                            f32x4 o1, o2;
                            o1[0] = y1[0] * cs0[0] - y2[0] * cs0[1]; o2[0] = y2[0] * cs0[0] + y1[0] * cs0[1];
                            o1[1] = y1[1] * cs0[2] - y2[1] * cs0[3]; o2[1] = y2[1] * cs0[2] + y1[1] * cs0[3];
                            o1[2] = y1[2] * cs1[0] - y2[2] * cs1[1]; o2[2] = y2[2] * cs1[0] + y1[2] * cs1[1];
                            o1[3] = y1[3] * cs1[2] - y2[3] * cs1[3]; o2[3] = y2[3] * cs1[2] + y1[3] * cs1[3];
                            x[bj][0] = o1; x[bj][1] = o2;
                        }
                    }
                    bf16_t* rowp = base + (size_t)r * pitch + colofs + 4 * fq;
#pragma unroll
                    for (int bj = 0; bj < 2; ++bj)
                        st_bf16x4_pair(rowp + 32 * bj, x[bj][0] * scale, x[bj][1] * scale, fq);
                }
        } else if (pn < 11) {
            const int arr = pn - 6;
            bf16_t* base = (bf16_t*)(ws + cfg::WS_D + (size_t)arr * cfg::D_ARR);
            const float scale = (arr == 0) ? 0.125f : 1.0f;
#pragma unroll
            for (int ai = 0; ai < 2; ++ai)
#pragma unroll
                for (int m = 0; m < 4; ++m) {
                    const int r = u.pm * BM + ai * HALF + wr * 64 + m * 16 + fr;
                    const float rs = rsv[ai][m] * scale;
                    bf16_t* rowp = base + (size_t)r * 256 + wc * 32 + 4 * fq;
#pragma unroll
                    for (int bj = 0; bj < 2; ++bj)
                        st_bf16x4_pair(rowp + 128 * bj, acc[ai][bj][m][0] * rs, acc[ai][bj][m][1] * rs, fq);
                }
        } else {
            const int br = (pn - 11) >> 2, pnD = (pn - 11) & 3;
            unsigned* base = (unsigned*)(ws + cfg::WS_GATE + (size_t)((u.pm * 4 + pnD) * 4 + br) * 65536) + (wr * 4 + wc) * 2048 + (fq * 16 + fr) * 4;
#pragma unroll
            for (int ai = 0; ai < 2; ++ai)
#pragma unroll
                for (int m = 0; m < 4; ++m) {
                    const float rs = rsv[ai][m] * -cfg::LOG2E;
                    u32x4 wq;
#pragma unroll
                    for (int bj = 0; bj < 2; ++bj)
#pragma unroll
                        for (int n = 0; n < 2; ++n) {
                            const f32x4 v = acc[ai][bj][m][n] * rs; unsigned w = 0;
#pragma unroll
                            for (int j = 0; j < 4; ++j) { const float g256 = __builtin_amdgcn_rcpf(__builtin_fmaf(__builtin_amdgcn_exp2f(v[j]), 1.0f / 256.0f, 1.0f / 256.0f));
                                w = __builtin_amdgcn_cvt_pk_u8_f32(g256 - 0.5f, (unsigned)j, w); }
                            wq[bj * 2 + n] = w;
                        }
                    *(u32x4*)(base + (ai * 4 + m) * 256) = wq;
                }
        }
    }
};

struct EpiHorner {
    static constexpr bool PERM = false, AFTER_DRAIN = false, HOOK = true;
    unsigned char* ws;
    static __device__ __forceinline__ f32x4 deqr(unsigned w) {
        f32x4 g; g[0] = (float)(w & 255u); g[1] = (float)((w >> 8) & 255u); g[2] = (float)((w >> 16) & 255u); g[3] = (float)(w >> 24);
        return g + 0.5f;
    }
    static __device__ __forceinline__ f32x4 deq(unsigned w) {
        f32x4 g; g[0] = __builtin_fmaf((float)(w & 255u), 1.0f / 256.0f, 0.5f / 256.0f); g[1] = __builtin_fmaf((float)((w >> 8) & 255u), 1.0f / 256.0f, 0.5f / 256.0f);
        g[2] = __builtin_fmaf((float)((w >> 16) & 255u), 1.0f / 256.0f, 0.5f / 256.0f); g[3] = __builtin_fmaf((float)(w >> 24), 1.0f / 256.0f, 0.5f / 256.0f);
        return g;
    }
    __device__ __forceinline__ void hook(f32x4 (&acc)[2][2][4][2], const Unit& u, int t, int wr, int wc, int fr, int fq) const {
        const int nb = (t >> 2) - 1; const unsigned char* gate = ws + cfg::WS_GATE;
        const unsigned* g0p = (const unsigned*)(gate + (size_t)((u.pm * 4 + u.pn) * 4 + nb) * 65536) + (wr * 4 + wc) * 2048 + (fq * 16 + fr) * 4;
        unsigned w0[2][4][2][2], w1[2][4][2][2];
#pragma unroll
        for (int ai = 0; ai < 2; ++ai)
#pragma unroll
            for (int m = 0; m < 4; ++m) { const u32x4 q0 = *(const u32x4*)(g0p + (ai * 4 + m) * 256), q1 = *(const u32x4*)(g0p + (ai * 4 + m) * 256 + 16384);
#pragma unroll
                for (int bj = 0; bj < 2; ++bj)
#pragma unroll
                    for (int n = 0; n < 2; ++n) { w0[ai][m][bj][n] = q0[bj * 2 + n]; w1[ai][m][bj][n] = q1[bj * 2 + n]; } }
        __builtin_amdgcn_sched_barrier(0);
#pragma unroll
        for (int ai = 0; ai < 2; ++ai)
#pragma unroll
            for (int m = 0; m < 4; ++m)
#pragma unroll
                for (int bj = 0; bj < 2; ++bj)
#pragma unroll
                    for (int n = 0; n < 2; ++n) { const f32x4 g0 = deq(w0[ai][m][bj][n]), g1 = deq(w1[ai][m][bj][n]);
                        f32x4 rr; rr[0] = g0[0] * __builtin_amdgcn_rcpf(g1[0]); rr[1] = g0[1] * __builtin_amdgcn_rcpf(g1[1]); rr[2] = g0[2] * __builtin_amdgcn_rcpf(g1[2]); rr[3] = g0[3] * __builtin_amdgcn_rcpf(g1[3]);
                        acc[ai][bj][m][n] *= rr; }
        __builtin_amdgcn_sched_barrier(0);
    }
    __device__ __forceinline__ void operator()(const f32x4 (&acc)[2][2][4][2], const Unit& u, int wr, int wc, int fr, int fq) const {
        const unsigned char* gate = ws + cfg::WS_GATE; bf16_t* out = (bf16_t*)(ws + cfg::WS_MERGED);
        const unsigned* g3p = (const unsigned*)(gate + (size_t)((u.pm * 4 + u.pn) * 4 + 3) * 65536) + (wr * 4 + wc) * 2048 + (fq * 16 + fr) * 4;
        unsigned w3[2][4][2][2];
#pragma unroll
        for (int ai = 0; ai < 2; ++ai)
#pragma unroll
            for (int m = 0; m < 4; ++m) { const u32x4 q3 = *(const u32x4*)(g3p + (ai * 4 + m) * 256);
#pragma unroll
                for (int bj = 0; bj < 2; ++bj)
#pragma unroll
                    for (int n = 0; n < 2; ++n) w3[ai][m][bj][n] = q3[bj * 2 + n]; }
#pragma unroll
        for (int ai = 0; ai < 2; ++ai)
#pragma unroll
            for (int m = 0; m < 4; ++m) {
                const int r = u.pm * BM + ai * HALF + wr * 64 + m * 16 + fr;
                bf16_t* rowp = out + (size_t)r * 1024 + u.pn * 256 + wc * 32 + 4 * fq;
#pragma unroll
                for (int bj = 0; bj < 2; ++bj)
                    st_bf16x4_pair(rowp + 128 * bj, acc[ai][bj][m][0] * deq(w3[ai][m][bj][0]), acc[ai][bj][m][1] * deq(w3[ai][m][bj][1]), fq);
            }
    }
};

__device__ __forceinline__ f32x4 ld_bf16x4(const bf16_t* p) { const u32x2 w = *(const u32x2*)p; f32x4 v; v[0] = __builtin_bit_cast(float, w.x << 16); v[1] = __builtin_bit_cast(float, w.x & 0xffff0000u); v[2] = __builtin_bit_cast(float, w.y << 16); v[3] = __builtin_bit_cast(float, w.y & 0xffff0000u); return v; }
struct EpiRes {
    static constexpr bool PERM = true, AFTER_DRAIN = false, HOOK = false;
    unsigned char* ws; int feed;
    __device__ __forceinline__ void hook(f32x4 (&)[2][2][4][2], const Unit&, int, int, int, int, int) const {}
    __device__ __forceinline__ void operator()(const f32x4 (&acc)[2][2][4][2], const Unit& u, int wr, int wc, int fr, int fq) const {
        bf16_t* hb = (bf16_t*)(ws + cfg::WS_HB); float* ssq = (float*)(ws + cfg::WS_SSQ);
        const int c0 = u.pn * 256 + wc * 32 + 8 * fq;
        u32x4 hv[2][4][2];
#pragma unroll
        for (int ai = 0; ai < 2; ++ai)
#pragma unroll
            for (int m = 0; m < 4; ++m) { const bf16_t* br = hb + (size_t)(u.pm * BM + ai * HALF + wr * 64 + m * 16 + fr) * 1024 + c0;
#pragma unroll
                for (int bj = 0; bj < 2; ++bj) hv[ai][m][bj] = *(const u32x4*)(br + 128 * bj); }
        __builtin_amdgcn_sched_barrier(0);
#pragma unroll
        for (int ai = 0; ai < 2; ++ai) {
#pragma unroll
            for (int m = 0; m < 4; ++m) {
                const int r = u.pm * BM + ai * HALF + wr * 64 + m * 16 + fr;
                bf16_t* br = hb + (size_t)r * 1024 + c0;
                float ss = 0.f;
#pragma unroll
                for (int bj = 0; bj < 2; ++bj) {
                    const u32x4 w = hv[ai][m][bj]; f32x4 v0, v1;
                    v0[0] = __builtin_bit_cast(float, w.x << 16); v0[1] = __builtin_bit_cast(float, w.x & 0xffff0000u); v0[2] = __builtin_bit_cast(float, w.y << 16); v0[3] = __builtin_bit_cast(float, w.y & 0xffff0000u);
                    v1[0] = __builtin_bit_cast(float, w.z << 16); v1[1] = __builtin_bit_cast(float, w.z & 0xffff0000u); v1[2] = __builtin_bit_cast(float, w.w << 16); v1[3] = __builtin_bit_cast(float, w.w & 0xffff0000u);
                    v0 += acc[ai][bj][m][0]; v1 += acc[ai][bj][m][1];
                    u32x4 o; o.x = cvt_pk_bf16(v0[0], v0[1]); o.y = cvt_pk_bf16(v0[2], v0[3]); o.z = cvt_pk_bf16(v1[0], v1[1]); o.w = cvt_pk_bf16(v1[2], v1[3]);
                    *(u32x4*)(br + 128 * bj) = o;
                    ss += ((v0[0] * v0[0] + v0[1] * v0[1]) + (v0[2] * v0[2] + v0[3] * v0[3])) + ((v1[0] * v1[0] + v1[1] * v1[1]) + (v1[2] * v1[2] + v1[3] * v1[3]));
                }
                ss += __shfl_xor(ss, 16); ss += __shfl_xor(ss, 32);
                if (feed && fq == 0) ssq[(size_t)r * 16 + u.pn * 4 + wc] = ss;
            }
        }
    }
};

struct EpiResFinal {
    static constexpr bool PERM = false, AFTER_DRAIN = true, HOOK = false;
    float* hout; unsigned char* ws; const float* lnf;
    __device__ __forceinline__ void hook(f32x4 (&)[2][2][4][2], const Unit&, int, int, int, int, int) const {}
    __device__ __forceinline__ void fused(f32x4 (&acc)[2][2][4][2], const Unit& u, int wr, int wc, int fr, int fq, PG8_LAS unsigned char* lds, int wid, int lane) const {
        const bf16_t* hb = (const bf16_t*)(ws + cfg::WS_HB); float* ssq = (float*)(ws + cfg::WS_SSQ); unsigned* cnt = (unsigned*)ws + cfg::CW_FIN + 16 * u.pm;
        const int c0 = u.pn * 256 + wc * 32 + 4 * fq;
#pragma unroll
        for (int ai = 0; ai < 2; ++ai) {
            f32x4 hv[4][2][2];
#pragma unroll
            for (int m = 0; m < 4; ++m) { const bf16_t* br = hb + (size_t)(u.pm * BM + ai * HALF + wr * 64 + m * 16 + fr) * 1024 + c0;
#pragma unroll
                for (int bj = 0; bj < 2; ++bj)
#pragma unroll
                    for (int n = 0; n < 2; ++n) hv[m][bj][n] = ld_bf16x4(br + 128 * bj + 16 * n); }
#pragma unroll
            for (int m = 0; m < 4; ++m) {
                const int r = u.pm * BM + ai * HALF + wr * 64 + m * 16 + fr;
                float ss = 0.f;
#pragma unroll
                for (int bj = 0; bj < 2; ++bj)
#pragma unroll
                    for (int n = 0; n < 2; ++n) { const f32x4 v = hv[m][bj][n] + acc[ai][bj][m][n]; acc[ai][bj][m][n] = v; ss += (v[0] * v[0] + v[1] * v[1]) + (v[2] * v[2] + v[3] * v[3]); }
                ss += __shfl_xor(ss, 16); ss += __shfl_xor(ss, 32);
                if (fq == 0) __hip_atomic_store(ssq + (size_t)r * 16 + u.pn * 4 + wc, ss, __ATOMIC_RELAXED, __HIP_MEMORY_SCOPE_AGENT);
            }
        }
        asm volatile("s_waitcnt vmcnt(0)" ::: "memory");
        if (lane == 0) { const unsigned one = 1u; asm volatile("global_atomic_add %0, %1, off" :: "v"(cnt), "v"(one) : "memory"); }
        if (wid == 0) {
            if (lane == 0) { unsigned sp = 0; while (__hip_atomic_load(cnt, __ATOMIC_RELAXED, __HIP_MEMORY_SCOPE_AGENT) < 32u) { __builtin_amdgcn_s_sleep(2); if (++sp > (1u << 18)) break; } }
            __builtin_amdgcn_fence(__ATOMIC_ACQUIRE, "agent"); asm volatile("s_waitcnt vmcnt(0)" ::: "memory");
        }
        asm volatile("s_waitcnt lgkmcnt(0)\n\ts_barrier" ::: "memory");
        f32x4 g[2][2];
#pragma unroll
        for (int bj = 0; bj < 2; ++bj)
#pragma unroll
            for (int n = 0; n < 2; ++n) g[bj][n] = *(const f32x4*)(lnf + c0 + 128 * bj + 16 * n);
#pragma unroll
        for (int ai = 0; ai < 2; ++ai) {
            float rs[4];
#pragma unroll
            for (int mh = 0; mh < 4; mh += 2) { f32x4 t[2][4];
#pragma unroll
              for (int m = 0; m < 2; ++m) { const f32x4* p = (const f32x4*)(ssq + (size_t)(u.pm * BM + ai * HALF + wr * 64 + (mh + m) * 16 + fr) * 16);
#pragma unroll
                  for (int q = 0; q < 4; ++q) t[m][q] = p[q]; }
#pragma unroll
              for (int m = 0; m < 2; ++m) { float s = 0.f;
#pragma unroll
                  for (int q = 0; q < 4; ++q) s += (t[m][q][0] + t[m][q][1]) + (t[m][q][2] + t[m][q][3]);
                  rs[mh + m] = __builtin_amdgcn_rsqf(s * (1.0f / 1024.0f) + cfg::RMS_EPS); } }
#pragma unroll
            for (int m = 0; m < 4; ++m) { const int r = u.pm * BM + ai * HALF + wr * 64 + m * 16 + fr, b = r / cfg::L, pos = r - b * cfg::L;
                float* hr = (pos >= cfg::MEND ? hout + (size_t)(b * cfg::SEQ + pos - cfg::MEND) * cfg::DM : (float*)(ws + cfg::WS_HSIDE) + (size_t)(b * 128 + pos) * cfg::DM) + c0;
#pragma unroll
                for (int bj = 0; bj < 2; ++bj)
#pragma unroll
                    for (int n = 0; n < 2; ++n) *(f32x4*)(hr + 128 * bj + 16 * n) = acc[ai][bj][m][n] * rs[m] * g[bj][n]; }
        }
    }
};

struct EpiGLU {
    static constexpr bool PERM = true, AFTER_DRAIN = false, HOOK = false;
    unsigned char* ws;
    __device__ __forceinline__ void hook(f32x4 (&)[2][2][4][2], const Unit&, int, int, int, int, int) const {}
    __device__ __forceinline__ void operator()(const f32x4 (&acc)[2][2][4][2], const Unit& u, int wr, int wc, int fr, int fq) const {
        const PG8_LAS float* tab = (const PG8_LAS float*)RSTD_LDS_OFF; bf16_t* ff = (bf16_t*)(ws + cfg::WS_FF);
        float rsv[2][4]; rows_rstd_lds(tab, u.pm, wr, fr, rsv);
#pragma unroll
        for (int ai = 0; ai < 2; ++ai)
#pragma unroll
            for (int m = 0; m < 4; ++m) {
                const int r = u.pm * BM + ai * HALF + wr * 64 + m * 16 + fr;
                const float rs = rsv[ai][m], rsn = rs * -cfg::LOG2E, rs2 = rs * rs;
                u32x4 w;
#pragma unroll
                for (int n = 0; n < 2; ++n) {
                    const f32x4 t = acc[ai][0][m][n] * rsn, gu = (acc[ai][0][m][n] * acc[ai][1][m][n]) * rs2; f32x4 o;
#pragma unroll
                    for (int j = 0; j < 4; ++j) o[j] = gu[j] * __builtin_amdgcn_rcpf(1.0f + __builtin_amdgcn_exp2f(t[j]));
                    if (n == 0) { w.x = cvt_pk_bf16(o[0], o[1]); w.y = cvt_pk_bf16(o[2], o[3]); } else { w.z = cvt_pk_bf16(o[0], o[1]); w.w = cvt_pk_bf16(o[2], o[3]); }
                }
                *(u32x4*)(ff + (size_t)r * cfg::DFF + u.pn * 128 + wc * 32 + 8 * fq) = w;
            }
    }
};


constexpr int TAIL_ROW0 = 16384, TAIL_TASKS = 256;
template <int NSTEP>
__device__ __forceinline__ void tail_chunk(const bf16_t* ap, const bf16_t* bp, int ld, f32x4 (&acc)[2][4]) {
    bf16x8 a[NSTEP][2], b[NSTEP][4];
#pragma unroll
    for (int s = 0; s < NSTEP; ++s) { a[s][0] = *(const bf16x8*)(ap + 32 * s); a[s][1] = *(const bf16x8*)(ap + (size_t)16 * ld + 32 * s);
#pragma unroll
        for (int cb = 0; cb < 4; ++cb) b[s][cb] = *(const bf16x8*)(bp + (size_t)(16 * cb) * ld + 32 * s); }
    __builtin_amdgcn_sched_barrier(0);
#pragma unroll
    for (int s = 0; s < NSTEP; ++s)
#pragma unroll
        for (int h = 0; h < 2; ++h)
#pragma unroll
            for (int cb = 0; cb < 4; ++cb) acc[h][cb] = __builtin_amdgcn_mfma_f32_16x16x32_bf16(b[s][cb], a[s][h], acc[h][cb], 0, 0, 0);
}
template <int NSTEP>
__device__ __forceinline__ void tail_ld(const bf16_t* ap, const bf16_t* bp, int ld, bf16x8 (&a)[3][2], bf16x8 (&b)[3][4]) {
#pragma unroll
    for (int s = 0; s < NSTEP; ++s) { a[s][0] = *(const bf16x8*)(ap + 32 * s); a[s][1] = *(const bf16x8*)(ap + (size_t)16 * ld + 32 * s);
#pragma unroll
        for (int cb = 0; cb < 4; ++cb) b[s][cb] = *(const bf16x8*)(bp + (size_t)(16 * cb) * ld + 32 * s); }
}
template <int NSTEP>
__device__ __forceinline__ void tail_mm(const bf16x8 (&a)[3][2], const bf16x8 (&b)[3][4], f32x4 (&acc)[2][4]) {
#pragma unroll
    for (int s = 0; s < NSTEP; ++s)
#pragma unroll
        for (int h = 0; h < 2; ++h)
#pragma unroll
            for (int cb = 0; cb < 4; ++cb) acc[h][cb] = __builtin_amdgcn_mfma_f32_16x16x32_bf16(b[s][cb], a[s][h], acc[h][cb], 0, 0, 0);
}
__device__ __forceinline__ void tail_reduce(f32x4 (&acc)[2][4], float* part, int wave, int lane) {
    if (wave) { float* mine = part + (wave - 1) * 2048 + lane;
#pragma unroll
        for (int h = 0; h < 2; ++h)
#pragma unroll
            for (int cb = 0; cb < 4; ++cb)
#pragma unroll
                for (int r = 0; r < 4; ++r) mine[((h * 4 + cb) * 4 + r) * 64] = acc[h][cb][r]; }
    __syncthreads();
    if (!wave) {
#pragma unroll 2
        for (int o = 0; o < 7; ++o)
#pragma unroll
            for (int h = 0; h < 2; ++h)
#pragma unroll
                for (int cb = 0; cb < 4; ++cb)
#pragma unroll
                    for (int r = 0; r < 4; ++r) acc[h][cb][r] += part[o * 2048 + ((h * 4 + cb) * 4 + r) * 64 + lane];
    }
}
__device__ __forceinline__ void tail_res(const bf16_t* A, const bf16_t* Bt, int K, float* hout, bf16_t* hb, float* ssq, int feed, const float* lnf, unsigned* cntT, int bx, int wave, int lane, float* part) {
    const int task = bx, rb = task >> 4, cg = task & 15, row0 = TAIL_ROW0 + 32 * rb, col0 = 64 * cg, c = lane & 15, q4 = lane >> 4;
    f32x4 acc[2][4];
#pragma unroll
    for (int h = 0; h < 2; ++h)
#pragma unroll
        for (int cb = 0; cb < 4; ++cb) acc[h][cb] = (f32x4){0.f, 0.f, 0.f, 0.f};
    u32x2 hbv[2][4] = {};
    f32x4 lnv[4] = {};
    if (wave == 0 && task < TAIL_TASKS) {
#pragma unroll
        for (int h = 0; h < 2; ++h)
#pragma unroll
            for (int cb = 0; cb < 4; ++cb) hbv[h][cb] = *(const u32x2*)(hb + (size_t)(row0 + 16 * h + c) * 1024 + col0 + 16 * cb + 4 * q4);
        if (lnf) {
#pragma unroll
            for (int cb = 0; cb < 4; ++cb) lnv[cb] = *(const f32x4*)(lnf + col0 + 16 * cb + 4 * q4); }
    }
    if (task < TAIL_TASKS) {
        const int Ke = K >> 3; const bf16_t* ap = A + (size_t)(row0 + c) * K + wave * Ke + 8 * q4; const bf16_t* bp = Bt + (size_t)(col0 + c) * K + wave * Ke + 8 * q4;
        if (Ke == 128) tail_chunk<4>(ap, bp, K, acc);
        else {
            bf16x8 a0[3][2], b0[3][4], a1[3][2], b1[3][4];
            tail_ld<3>(ap, bp, K, a0, b0); tail_ld<3>(ap + 96, bp + 96, K, a1, b1); __builtin_amdgcn_sched_barrier(0);
            tail_mm<3>(a0, b0, acc); __builtin_amdgcn_sched_barrier(0);
            tail_ld<3>(ap + 192, bp + 192, K, a0, b0); __builtin_amdgcn_sched_barrier(0);
            tail_mm<3>(a1, b1, acc); __builtin_amdgcn_sched_barrier(0);
            tail_ld<2>(ap + 288, bp + 288, K, a1, b1); __builtin_amdgcn_sched_barrier(0);
            tail_mm<3>(a0, b0, acc); tail_mm<2>(a1, b1, acc);
        }
    }
    tail_reduce(acc, part, wave, lane);
    if (wave == 0 && task < TAIL_TASKS) {
        f32x4 hvv[2][4]; float ssr[2];
#pragma unroll
        for (int h = 0; h < 2; ++h) { float ss = 0.f;
#pragma unroll
            for (int cb = 0; cb < 4; ++cb) { const u32x2 w = hbv[h][cb]; f32x4 v; v[0] = __builtin_bit_cast(float, w.x << 16); v[1] = __builtin_bit_cast(float, w.x & 0xffff0000u); v[2] = __builtin_bit_cast(float, w.y << 16); v[3] = __builtin_bit_cast(float, w.y & 0xffff0000u);
                v += acc[h][cb]; hvv[h][cb] = v; ss += (v[0] * v[0] + v[1] * v[1]) + (v[2] * v[2] + v[3] * v[3]); }
            ss += __shfl_xor(ss, 16); ss += __shfl_xor(ss, 32); ssr[h] = ss; }
        if (lnf) {
#pragma unroll
            for (int h = 0; h < 2; ++h) if (q4 == 0) __hip_atomic_store(ssq + (size_t)(row0 + 16 * h + c) * 16 + cg, ssr[h], __ATOMIC_RELAXED, __HIP_MEMORY_SCOPE_AGENT);
            asm volatile("s_waitcnt vmcnt(0)" ::: "memory");
            unsigned* cn = cntT + 16 * rb;
            if (lane == 0) { const unsigned one = 1u; asm volatile("global_atomic_add %0, %1, off" :: "v"(cn), "v"(one) : "memory");
                unsigned sp = 0; while (__hip_atomic_load(cn, __ATOMIC_RELAXED, __HIP_MEMORY_SCOPE_AGENT) < 16u) { __builtin_amdgcn_s_sleep(2); if (++sp > (1u << 18)) break; } }
            __builtin_amdgcn_fence(__ATOMIC_ACQUIRE, "agent"); asm volatile("s_waitcnt vmcnt(0)" ::: "memory");
#pragma unroll
            for (int h = 0; h < 2; ++h) { const int row = row0 + 16 * h + c; const f32x4* sp_ = (const f32x4*)(ssq + (size_t)row * 16); const f32x4 a = sp_[0], b = sp_[1], cc = sp_[2], d = sp_[3];
                const float s = (((a[0] + a[1]) + (a[2] + a[3])) + ((b[0] + b[1]) + (b[2] + b[3]))) + (((cc[0] + cc[1]) + (cc[2] + cc[3])) + ((d[0] + d[1]) + (d[2] + d[3])));
                const float rs = __builtin_amdgcn_rsqf(s * (1.0f / 1024.0f) + cfg::RMS_EPS); float* hr = hout + (size_t)(row - 3 * cfg::L - cfg::MEND + 3 * cfg::SEQ) * cfg::DM + col0 + 4 * q4;
#pragma unroll
                for (int cb = 0; cb < 4; ++cb) *(f32x4*)(hr + 16 * cb) = hvv[h][cb] * rs * lnv[cb]; }
        } else {
#pragma unroll
            for (int h = 0; h < 2; ++h) { const int row = row0 + 16 * h + c; bf16_t* br = hb + (size_t)row * 1024 + col0 + 4 * q4;
#pragma unroll
                for (int cb = 0; cb < 4; ++cb) st_bf16x4(br + 16 * cb, hvv[h][cb]);
                if (feed && q4 == 0) ssq[(size_t)row * 16 + cg] = ssr[h]; }
        }
    }
    __syncthreads();
}
__device__ __forceinline__ void tail_branch(const bf16_t* Y, const bf16_t* Wbt, const unsigned char* gate, bf16_t* out, int bx, int wave, int lane, float* part) {
    const int task = bx, n = wave >> 1, kh = wave & 1;
    const int rb = task >> 4, cg = task & 15, row0 = TAIL_ROW0 + 32 * rb, col0 = 64 * cg, c = lane & 15, q4 = lane >> 4;
    f32x4 acc[2][4];
#pragma unroll
    for (int h = 0; h < 2; ++h)
#pragma unroll
        for (int cb = 0; cb < 4; ++cb) acc[h][cb] = (f32x4){0.f, 0.f, 0.f, 0.f};
    if (task < TAIL_TASKS) {
        unsigned gbv[2][4];
#pragma unroll
        for (int h = 0; h < 2; ++h) { const int row = row0 + 16 * h + c, rr = row & 255;
#pragma unroll
            for (int cb = 0; cb < 4; ++cb) { const int col = col0 + 16 * cb + 4 * q4, cc = col & 255;
                const int w_ = ((rr >> 6) & 1) * 4 + ((cc >> 5) & 3), idx = (((w_ * 2 + (rr >> 7)) * 4 + ((rr >> 4) & 3)) * 64 + ((cc >> 2) & 3) * 16 + (rr & 15)) * 4 + (cc >> 7) * 2 + ((cc >> 4) & 1);
                gbv[h][cb] = ((const unsigned*)gate)[(size_t)(((row >> 8) * 4 + (col >> 8)) * 4 + n) * 16384 + idx]; } }
        tail_chunk<4>(Y + (size_t)(row0 + c) * 1024 + 256 * n + 128 * kh + 8 * q4, Wbt + (size_t)(col0 + c) * 1024 + 256 * n + 128 * kh + 8 * q4, 1024, acc);
#pragma unroll
        for (int h = 0; h < 2; ++h)
#pragma unroll
            for (int cb = 0; cb < 4; ++cb) { const unsigned w = gbv[h][cb]; f32x4 g; g[0] = __builtin_fmaf((float)(w & 255u), 1.0f / 256.0f, 0.5f / 256.0f); g[1] = __builtin_fmaf((float)((w >> 8) & 255u), 1.0f / 256.0f, 0.5f / 256.0f);
                g[2] = __builtin_fmaf((float)((w >> 16) & 255u), 1.0f / 256.0f, 0.5f / 256.0f); g[3] = __builtin_fmaf((float)(w >> 24), 1.0f / 256.0f, 0.5f / 256.0f); acc[h][cb] *= g; }
    }
    tail_reduce(acc, part, wave, lane);
    if (wave == 0 && task < TAIL_TASKS) {
#pragma unroll
        for (int h = 0; h < 2; ++h) { bf16_t* op = out + (size_t)(row0 + 16 * h + c) * 1024 + col0 + 4 * q4;
#pragma unroll
            for (int cb = 0; cb < 4; ++cb) st_bf16x4(op + 16 * cb, acc[h][cb]); }
    }
    __syncthreads();
}
template <class Epi, class Sched, bool ALIGN_EPI = false, bool SP2 = false>
__device__ __forceinline__ void gemm_phase(PG8_LAS unsigned char* lds, const Gemm g, const Sched& S, const Epi& E, int tid_in) {
    int tid_l = tid_in; asm volatile("" : "+v"(tid_l));
    const int tid = tid_l, wid = __builtin_amdgcn_readfirstlane(tid >> 6), lane = tid & 63, wr = wid >> 2, wc = wid & 3, fr = lane & 15, fq = lane >> 4;
    const int K = g.K, nt = K / BK;
    unsigned voffA[2], voffB[2];
#pragma unroll
    for (int i = 0; i < 2; ++i) { int R, C; stage_rc(tid * 16 + i * 8192, R, C); const int Rb = Epi::PERM ? ((R & ~31) + perm32(R & 31)) : R;
        voffA[i] = (unsigned)(R * K + C) * 2u; voffB[i] = (unsigned)(Rb * K + C) * 2u; }
    const size_t kstep = (size_t)(BK * 2);
    const size_t hstep = (size_t)HALF * K * 2;
    const size_t tstep = 2 * hstep;
    const unsigned ldsw = (unsigned)wid * 1024u;
    const int aoff = lds_byte(wr * 64 + fr, fq * 8), boff = lds_byte(wc * 32 + fr, fq * 8);
#define PG8_SA(b, h) (((b) * 2 + (h)) * HTB)
#define PG8_SB(b, h) ((4 + (b) * 2 + (h)) * HTB)
#define PG8_STAGE(bufoff, gbase, voff) do { _Pragma("unroll") for (int _i = 0; _i < 2; ++_i) \
        __builtin_amdgcn_global_load_lds((const unsigned*)((const char*)(gbase) + (voff)[_i]), (PG8_LAS unsigned*)(lds + (bufoff) + ldsw + _i * 8192), 16, 0, 0); } while (0)
#define PG8_LDA(dst, b, h) do { _Pragma("unroll") for (int m = 0; m < 4; ++m) _Pragma("unroll") for (int k = 0; k < 2; ++k) dst[m][k] = *(const PG8_LAS bf16x8*)(lds + PG8_SA(b, h) + aoff + m * 2048 + k * 1024); } while (0)
#define PG8_LDB(dst, b, h) do { _Pragma("unroll") for (int n = 0; n < 2; ++n) _Pragma("unroll") for (int k = 0; k < 2; ++k) dst[n][k] = *(const PG8_LAS bf16x8*)(lds + PG8_SB(b, h) + boff + n * 2048 + k * 1024); } while (0)
#define PG8_MMA(ai, bj, At, Bt) do { __builtin_amdgcn_s_setprio(1); _Pragma("unroll") for (int m = 0; m < 4; ++m) _Pragma("unroll") for (int n = 0; n < 2; ++n) _Pragma("unroll") for (int k = 0; k < 2; ++k) \
        acc[ai][bj][m][n] = __builtin_amdgcn_mfma_f32_16x16x32_bf16(Bt[n][k], At[m][k], acc[ai][bj][m][n], 0, 0, 0); __builtin_amdgcn_s_setprio(0); } while (0)
#define PG8_WAIT_V(n) asm volatile("s_waitcnt vmcnt(" #n ")" ::: "memory")
#define PG8_WAIT_L(n) asm volatile("s_waitcnt lgkmcnt(" #n ")" ::: "memory")
#define PG8_BAR __builtin_amdgcn_s_barrier()
#define PG8_SCHED __builtin_amdgcn_sched_barrier(0)
    Unit cur, nxt; int ui = 0;
    if (!S.next(0, cur)) return;
    f32x4 acc[2][2][4][2];
#pragma unroll
    for (int a = 0; a < 2; ++a)
#pragma unroll
        for (int b = 0; b < 2; ++b)
#pragma unroll
            for (int m = 0; m < 4; ++m)
#pragma unroll
                for (int n = 0; n < 2; ++n) acc[a][b][m][n] = (f32x4){0.f, 0.f, 0.f, 0.f};
    bf16x8 At[4][2], B0[2][2], B1[2][2];
    const char* cA = (const char*)g.A + (size_t)cur.pm * tstep; const char* cB = (const char*)g.Bt + (size_t)cur.pn * tstep;
    S.a_ready(cur);
    if constexpr (SP2) {
        PG8_STAGE(PG8_SB(0, 0), cB, voffB); PG8_STAGE(PG8_SB(0, 1), cB + hstep, voffB); PG8_STAGE(PG8_SA(0, 0), cA, voffA); PG8_STAGE(PG8_SA(0, 1), cA + hstep, voffA);
        if (wr == 1) PG8_BAR;
        PG8_WAIT_V(2); PG8_BAR;
        PG8_STAGE(PG8_SB(1, 0), cB + kstep, voffB); PG8_STAGE(PG8_SA(1, 0), cA + kstep, voffA); PG8_STAGE(PG8_SB(1, 1), cB + hstep + kstep, voffB);
        PG8_WAIT_V(6); PG8_BAR;
    } else {
        PG8_STAGE(PG8_SB(0, 0), cB, voffB); PG8_STAGE(PG8_SA(0, 0), cA, voffA); PG8_STAGE(PG8_SB(0, 1), cB + hstep, voffB); PG8_STAGE(PG8_SA(0, 1), cA + hstep, voffA);
        if (wr == 1) PG8_BAR;
        PG8_WAIT_V(4); PG8_BAR;
        PG8_STAGE(PG8_SB(1, 0), cB + kstep, voffB); PG8_STAGE(PG8_SA(1, 0), cA + kstep, voffA); PG8_STAGE(PG8_SB(1, 1), cB + hstep + kstep, voffB);
        PG8_WAIT_V(6); PG8_BAR;
    }
    for (;;) {
        const bool has_next = S.next(ui + 1, nxt);
        const char* nA = has_next ? (const char*)g.A + (size_t)nxt.pm * tstep : cA; const char* nB = has_next ? (const char*)g.Bt + (size_t)nxt.pn * tstep : cB;
        for (int t = 0; t < nt; t += 2) {
            const bool last = (t == nt - 2);
            if constexpr (Epi::HOOK) { if (t != 0 && (t & 3) == 0) E.hook(acc, cur, t, wr, wc, fr, fq); }
            const char* a1 = cA + (size_t)(t + 1) * kstep;
            const char* a2 = last ? nA : cA + (size_t)(t + 2) * kstep; const char* b2 = last ? nB : cB + (size_t)(t + 2) * kstep;
            const char* a3 = a2 + kstep; const char* b3 = b2 + kstep;
            if (last && has_next) S.a_ready(nxt);
            if constexpr (SP2) {
            PG8_LDB(B0, 0, 0); PG8_LDB(B1, 0, 1); PG8_SCHED; PG8_LDA(At, 0, 0); PG8_STAGE(PG8_SA(1, 1), a1 + hstep, voffA);
            PG8_WAIT_V(8); PG8_WAIT_L(0); PG8_BAR; PG8_MMA(0, 0, At, B0); PG8_MMA(0, 1, At, B1); PG8_BAR; PG8_SCHED;
            PG8_LDA(At, 0, 1); PG8_STAGE(PG8_SB(0, 0), b2, voffB); PG8_STAGE(PG8_SB(0, 1), b2 + hstep, voffB); PG8_STAGE(PG8_SA(0, 0), a2, voffA);
            PG8_WAIT_V(8); PG8_WAIT_L(0); PG8_BAR; PG8_MMA(1, 0, At, B0); PG8_MMA(1, 1, At, B1); PG8_BAR; PG8_SCHED;
            PG8_LDB(B0, 1, 0); PG8_LDB(B1, 1, 1); PG8_SCHED; PG8_LDA(At, 1, 0); PG8_STAGE(PG8_SA(0, 1), a2 + hstep, voffA);
            PG8_WAIT_V(8); PG8_WAIT_L(0); PG8_BAR; PG8_MMA(0, 0, At, B0); PG8_MMA(0, 1, At, B1); PG8_BAR; PG8_SCHED;
            PG8_LDA(At, 1, 1); PG8_STAGE(PG8_SB(1, 0), b3, voffB); PG8_STAGE(PG8_SB(1, 1), b3 + hstep, voffB); PG8_STAGE(PG8_SA(1, 0), a3, voffA);
            PG8_WAIT_V(8); PG8_WAIT_L(0); PG8_BAR; PG8_MMA(1, 0, At, B0); PG8_MMA(1, 1, At, B1); PG8_BAR; PG8_SCHED;
            } else {
            PG8_LDB(B0, 0, 0); PG8_SCHED; PG8_LDA(At, 0, 0); PG8_STAGE(PG8_SA(1, 1), a1 + hstep, voffA);
            PG8_WAIT_L(8); PG8_BAR; PG8_WAIT_L(0); PG8_MMA(0, 0, At, B0); PG8_BAR; PG8_SCHED;
            PG8_LDB(B1, 0, 1); PG8_STAGE(PG8_SB(0, 0), b2, voffB);
            PG8_BAR; PG8_WAIT_L(0); PG8_MMA(0, 1, At, B1); PG8_BAR;
            PG8_LDA(At, 0, 1); PG8_STAGE(PG8_SA(0, 0), a2, voffA);
            PG8_BAR; PG8_WAIT_L(0); PG8_MMA(1, 0, At, B0); PG8_BAR; PG8_SCHED;
            PG8_STAGE(PG8_SB(0, 1), b2 + hstep, voffB);
            PG8_WAIT_V(6); PG8_BAR; PG8_MMA(1, 1, At, B1); PG8_BAR;
            PG8_LDB(B0, 1, 0); PG8_SCHED; PG8_LDA(At, 1, 0); PG8_STAGE(PG8_SA(0, 1), a2 + hstep, voffA);
            PG8_WAIT_L(8); PG8_BAR; PG8_WAIT_L(0); PG8_MMA(0, 0, At, B0); PG8_BAR; PG8_SCHED;
            PG8_LDB(B1, 1, 1); PG8_STAGE(PG8_SB(1, 0), b3, voffB);
            PG8_BAR; PG8_WAIT_L(0); PG8_MMA(0, 1, At, B1); PG8_BAR;
            PG8_LDA(At, 1, 1); PG8_STAGE(PG8_SA(1, 0), a3, voffA);
            PG8_BAR; PG8_WAIT_L(0); PG8_MMA(1, 0, At, B0); PG8_BAR; PG8_SCHED;
            PG8_STAGE(PG8_SB(1, 1), b3 + hstep, voffB);
            PG8_WAIT_V(6); PG8_BAR; PG8_MMA(1, 1, At, B1); PG8_BAR;
            }
        }
        if constexpr (ALIGN_EPI) { if (wr == 0) PG8_BAR; }
        if constexpr (!Epi::AFTER_DRAIN) { E(acc, cur, wr, wc, fr, fq); S.done(cur); }
        if (!has_next) break;
#pragma unroll
        for (int a = 0; a < 2; ++a)
#pragma unroll
            for (int b = 0; b < 2; ++b)
#pragma unroll
                for (int m = 0; m < 4; ++m)
#pragma unroll
                    for (int n = 0; n < 2; ++n) acc[a][b][m][n] = (f32x4){0.f, 0.f, 0.f, 0.f};
        cur = nxt; cA = nA; cB = nB; ++ui;
        if constexpr (ALIGN_EPI) { if (wr == 1) PG8_BAR; }
    }
    PG8_WAIT_V(0);
    if constexpr (!ALIGN_EPI) { if (wr == 0) PG8_BAR; }
    PG8_BAR;
    if constexpr (Epi::AFTER_DRAIN) { E.fused(acc, cur, wr, wc, fr, fq, lds, wid, lane); S.done(cur); }
#undef PG8_SA
#undef PG8_SB
#undef PG8_STAGE
#undef PG8_LDA
#undef PG8_LDB
#undef PG8_MMA
#undef PG8_WAIT_V
#undef PG8_WAIT_L
#undef PG8_BAR
#undef PG8_SCHED
}
}

namespace att {
typedef short bf16x8 __attribute__((ext_vector_type(8)));
typedef short s16x4 __attribute__((ext_vector_type(4)));
typedef float f32x16 __attribute__((ext_vector_type(16)));
typedef unsigned u32x4 __attribute__((ext_vector_type(4)));
typedef float f32x4 __attribute__((ext_vector_type(4)));
constexpr int SLOTB = 8192, LDS_K = 0, LDS_V = 3 * SLOTB, LDS_WS = 6 * SLOTB, LDS_OST = LDS_WS + 8 * 256, OST_W = 8448, LDS_END = LDS_OST + 8 * OST_W, LDS_LUT = 131072 + 1024;
static_assert(LDS_END <= 131072 && LDS_LUT + 2 * 4352 <= cfg::LDS_BYTES, "attention LDS map");
__device__ __forceinline__ int crow(int r, int hi) { return (r & 3) + 8 * (r >> 2) + 4 * hi; }
__device__ __forceinline__ void glds16(const void* gsrc, unsigned lds_dst) { unsigned keep;
    asm volatile("s_mov_b32 %0, m0\n\ts_mov_b32 m0, %2\n\ts_nop 0\n\tglobal_load_lds_dwordx4 %1, off\n\ts_mov_b32 m0, %0" : "=&s"(keep) : "v"(gsrc), "s"(lds_dst) : "memory"); }
typedef float f32x2_t __attribute__((ext_vector_type(2))); typedef __bf16 bf16x2_t __attribute__((ext_vector_type(2)));
__device__ __forceinline__ unsigned cvtpk_s(float lo, float hi) { f32x2_t v = {lo, hi}; bf16x2_t b = __builtin_convertvector(v, bf16x2_t); return __builtin_bit_cast(unsigned, b); }
#define ATT_WAIT_BAR(N) asm volatile("s_waitcnt vmcnt(" #N ") lgkmcnt(0)\n\ts_barrier" ::: "memory")
#define ATT_MFMA(a, b, c) __builtin_amdgcn_mfma_f32_32x32x16_bf16(a, b, c, 0, 0, 0)

__device__ __forceinline__ void pv(f32x16* o, int vb, bf16x8 pa0, bf16x8 pa1, bf16x8 pa2, bf16x8 pa3) {
#pragma unroll
    for (int d0 = 0; d0 < 2; ++d0) { s16x4 lo[4], hi[4];
#pragma unroll
        for (int ks = 0; ks < 4; ++ks) {
            asm volatile("ds_read_b64_tr_b16 %0,%1 offset:%c2" : "=&v"(lo[ks]) : "v"(vb), "i"(d0 * 4096 + ks * 1024) : "memory");
            asm volatile("ds_read_b64_tr_b16 %0,%1 offset:%c2" : "=&v"(hi[ks]) : "v"(vb), "i"(d0 * 4096 + ks * 1024 + 512) : "memory"); }
        asm volatile("s_waitcnt lgkmcnt(0)" ::: "memory"); __builtin_amdgcn_sched_barrier(0);
#define ATT_PK(k) (bf16x8){lo[k][0], lo[k][1], lo[k][2], lo[k][3], hi[k][0], hi[k][1], hi[k][2], hi[k][3]}
        o[d0] = ATT_MFMA(pa0, ATT_PK(0), o[d0]);
        o[d0] = ATT_MFMA(pa1, ATT_PK(1), o[d0]);
        o[d0] = ATT_MFMA(pa2, ATT_PK(2), o[d0]);
        o[d0] = ATT_MFMA(pa3, ATT_PK(3), o[d0]);
#undef ATT_PK
    }
}

struct Ctx { const unsigned char* mix; bf16* Y; const float* sink; const float* subg; float lam, lam_scale; };

template <int MODE>
__device__ __forceinline__ void attn_unit(const Ctx& C, int item, char* shm, int tid) {
    using cfg::L; using cfg::T;
    constexpr int NK = (MODE == 2) ? 2 : 4;
    const int lane = tid & 63, r32 = lane & 31, hi = lane >> 5; const int wid = __builtin_amdgcn_readfirstlane(tid >> 6);
    const bf16* Qg = (const bf16*)C.mix; const bf16* Kg = (const bf16*)(C.mix + (size_t)T * 512); const bf16* Vg = (const bf16*)(C.mix + (size_t)T * 768);
    const int kvh = item & 1; int b, qpos0, h, kc0 = 0;
    if (MODE == 2) { const int qi = (item >> 1) % 66; b = (item >> 1) / 66; const int g = wid >> 2, c = (wid >> 1) & 1, rb = wid & 1; h = 2 * kvh + g; qpos0 = 64 * qi + 32 * rb; kc0 = 2 * c; }
    else { const int qb = (item >> 1) % 33; b = (item >> 1) / 33; h = 2 * kvh + (wid >> 2); qpos0 = 128 * qb + 32 * (wid & 3); }
    const int qpos = qpos0 + r32; const long mrow = (long)b * L + qpos;
    int kt_lo, nwin, NT;
    if (MODE == 0) { const int qb = qpos0 >> 7; kt_lo = 2 * qb - 2; if (kt_lo < 2) kt_lo = 2; int kt_hi = 2 * qb + 3; if (kt_hi > 65) kt_hi = 65; nwin = kt_hi - kt_lo + 1; NT = nwin + 1; }
    else { kt_lo = 1; nwin = 65; NT = 65; }
#define ATT_KT(t) ((t) < nwin ? kt_lo + (t) : 1)
    const unsigned lds0 = (unsigned)(uintptr_t)shm;
    float* wsf = (float*)(shm + LDS_WS) + wid * 64;
    const float* lutS = (const float*)(shm + LDS_LUT) + (MODE == 0 ? 1088 : 0);
    const bf16* Kh = Kg + (size_t)b * L * 128 + kvh * 64; const bf16* Vh = Vg + (size_t)b * L * 128 + kvh * 64;
    const bf16* ksrc = Kh + (long)lane * 128 + wid * 8;
    const bf16* vsrc = Vh + (long)(16 * (wid & 3) + (lane >> 2)) * 128 + (wid >> 2) * 32 + (lane & 3) * 8;
    const unsigned kdst = lds0 + LDS_K + wid * 1024, vdst = lds0 + LDS_V + wid * 1024;
#define ATT_DMA(t, slot) do { const long ko_ = (long)ATT_KT(t) * 64 * 128; glds16(ksrc + ko_, (unsigned)__builtin_amdgcn_readfirstlane(kdst + (slot))); glds16(vsrc + ko_, (unsigned)__builtin_amdgcn_readfirstlane(vdst + (slot))); } while (0)
    const int vb0 = (int)(lds0 + LDS_V) + ((lane >> 4) & 1) * 32 + (lane & 3) * 8 + (4 * hi + ((lane & 15) >> 2)) * 64;
    bf16x8 qr[NK];
    { const bf16* qp = Qg + mrow * 256 + h * 64 + 16 * kc0 + 8 * hi;
#pragma unroll
      for (int d0 = 0; d0 < NK; ++d0) qr[d0] = *(const bf16x8*)(qp + 16 * d0); }
    ATT_DMA(0, 0); if (NT > 1) ATT_DMA(1, SLOTB);
    float m_run = -1e30f, l_run = 0.f; f32x16 o[2];
#pragma unroll
    for (int r = 0; r < 16; ++r) { o[0][r] = 0.f; o[1][r] = 0.f; }
    int sl_cur = 0, sl_nn = 2 * SLOTB;
    for (int t = 0; t < NT; ++t) {
        if (t + 1 < NT) ATT_WAIT_BAR(2); else ATT_WAIT_BAR(0);
        if (t + 2 < NT) ATT_DMA(t + 2, sl_nn);
        const int kt = ATT_KT(t), k0 = kt * 64;
        float cinit = 0.f; bool near = false;
        if (MODE == 2) { if (k0 + 63 - qpos0 <= -128) cinit = lutS[h * 260]; else if (k0 - qpos0 - 31 >= 128) cinit = lutS[h * 260 + 256]; else near = true; }
        if (MODE == 0) near = true;
        f32x16 p0, p1;
        { const char* kb = shm + LDS_K + sl_cur + hi * 1024 + r32 * 16 + kc0 * 2048;
          f32x16 cz;
#pragma unroll
          for (int r = 0; r < 16; ++r) cz[r] = cinit;
#pragma unroll
          for (int d0 = 0; d0 < NK; ++d0) { const bf16x8 b0 = *(const bf16x8*)(kb + d0 * 2048), b1 = *(const bf16x8*)(kb + d0 * 2048 + 512);
              if (d0 == 0) { p0 = ATT_MFMA(b0, qr[0], cz); p1 = ATT_MFMA(b1, qr[0], cz); } else { p0 = ATT_MFMA(b0, qr[d0], p0); p1 = ATT_MFMA(b1, qr[d0], p1); } } }
        if (near) {
#pragma unroll
            for (int r = 0; r < 16; ++r) { const int j = crow(r, hi);
                int rel0 = k0 + j - qpos, rel1 = rel0 + 32;
                const int c0 = rel0 < -128 ? -128 : (rel0 > 128 ? 128 : rel0), c1 = rel1 < -128 ? -128 : (rel1 > 128 ? 128 : rel1);
                p0[r] += lutS[h * 260 + c0 + 128]; p1[r] += lutS[h * 260 + c1 + 128];
                if (MODE == 0 && kt != 1) { if (rel0 < -128 || rel0 > 128) p0[r] = -INFINITY; if (rel1 < -128 || rel1 > 128) p1[r] = -INFINITY; } }
        }
        if (kt == 1) {
#pragma unroll
            for (int r = 0; r < 16; ++r) { p0[r] = -INFINITY; if (r < 8) p1[r] = -INFINITY; }
        }
        float rm = fmaxf(p0[0], p1[0]);
#pragma unroll
        for (int r = 1; r < 16; ++r) rm = fmaxf(rm, fmaxf(p0[r], p1[r]));
        { auto rr = __builtin_amdgcn_permlane32_swap(__float_as_uint(rm), __float_as_uint(rm), false, false); rm = fmaxf(__uint_as_float(rr[0]), __uint_as_float(rr[1])); }
        bool resc = false;
        if (__any(rm > m_run + 8.0f)) { const float mn = fmaxf(m_run, rm); const float alpha = fexp2(m_run - mn); m_run = mn; l_run *= alpha; if (hi == 0) wsf[r32] = alpha; resc = true; }
        float sacc = 0.f;
#pragma unroll
        for (int r = 0; r < 16; ++r) { p0[r] = fexp2(p0[r] - m_run); p1[r] = fexp2(p1[r] - m_run); sacc += p0[r] + p1[r]; }
        l_run += sacc;
        if (resc) {
            asm volatile("s_waitcnt lgkmcnt(0)" ::: "memory");
#pragma unroll
            for (int r = 0; r < 16; ++r) { const float f = wsf[crow(r, hi)]; o[0][r] *= f; o[1][r] *= f; }
        }
        u32x4 pw0 = {cvtpk_s(p0[0], p0[1]), cvtpk_s(p0[2], p0[3]), cvtpk_s(p0[4], p0[5]), cvtpk_s(p0[6], p0[7])};
        u32x4 pw1 = {cvtpk_s(p0[8], p0[9]), cvtpk_s(p0[10], p0[11]), cvtpk_s(p0[12], p0[13]), cvtpk_s(p0[14], p0[15])};
        u32x4 pw2 = {cvtpk_s(p1[0], p1[1]), cvtpk_s(p1[2], p1[3]), cvtpk_s(p1[4], p1[5]), cvtpk_s(p1[6], p1[7])};
        u32x4 pw3 = {cvtpk_s(p1[8], p1[9]), cvtpk_s(p1[10], p1[11]), cvtpk_s(p1[12], p1[13]), cvtpk_s(p1[14], p1[15])};
        pv(o, vb0 + sl_cur, __builtin_bit_cast(bf16x8, pw0), __builtin_bit_cast(bf16x8, pw1), __builtin_bit_cast(bf16x8, pw2), __builtin_bit_cast(bf16x8, pw3));
        sl_nn = sl_cur; sl_cur = (sl_cur == 2 * SLOTB) ? 0 : sl_cur + SLOTB;
    }
    { auto rr = __builtin_amdgcn_permlane32_swap(__float_as_uint(l_run), __float_as_uint(l_run), false, false); l_run = __uint_as_float(rr[0]) + __uint_as_float(rr[1]); }
    if (MODE == 0) l_run += fexp2(C.sink[h] * cfg::LOG2E - m_run);
    if (hi == 0) wsf[32 + r32] = l_run;
    asm volatile("s_waitcnt lgkmcnt(0)" ::: "memory");
    float rli[16];
#pragma unroll
    for (int r = 0; r < 16; ++r) rli[r] = __builtin_amdgcn_rcpf(wsf[32 + crow(r, hi)]);
    if (MODE != 2) {
        bf16* Ow = C.Y + ((long)b * L + qpos0) * 1024 + (MODE == 0 ? 0 : 256) + h * 64;
        unsigned short* stg = (unsigned short*)(shm + LDS_OST + wid * OST_W);
#pragma unroll
        for (int r = 0; r < 16; ++r) { const int orow = crow(r, hi);
#pragma unroll
            for (int d0 = 0; d0 < 2; ++d0) stg[orow * 64 + d0 * 32 + r32] = (unsigned short)f2bf(o[d0][r] * rli[r]); }
        asm volatile("s_waitcnt lgkmcnt(0)" ::: "memory");
#pragma unroll
        for (int i = 0; i < 4; ++i) { const int row = i * 8 + (lane >> 3), ch = lane & 7; const u32x4 v = *(const u32x4*)(stg + row * 64 + ch * 8); *(u32x4*)(Ow + (long)row * 1024 + ch * 8) = v; }
    } else {
        const int g = wid >> 2, c = (wid >> 1) & 1, rb = wid & 1;
        float* buf = (float*)(shm + LDS_OST + (g * 2 + rb) * OST_W);
        if (c == 1) {
#pragma unroll
            for (int r = 0; r < 16; ++r) { const int orow = crow(r, hi);
#pragma unroll
                for (int d0 = 0; d0 < 2; ++d0) buf[orow * 66 + d0 * 32 + r32] = o[d0][r] * rli[r]; }
        }
        asm volatile("s_waitcnt lgkmcnt(0)\n\ts_barrier" ::: "memory");
        if (c == 0) {
#pragma unroll
            for (int r = 0; r < 16; ++r) { const int orow = crow(r, hi);
#pragma unroll
                for (int d0 = 0; d0 < 2; ++d0) { float* e = buf + orow * 66 + d0 * 32 + r32; *e = o[d0][r] * rli[r] - C.lam * *e; } }
            asm volatile("s_waitcnt lgkmcnt(0)" ::: "memory");
            const int row = lane >> 1, half = lane & 1; const float* src = buf + row * 66 + half * 32;
            float x[32]; float ss = 0.f;
#pragma unroll
            for (int d = 0; d < 32; ++d) { x[d] = src[d]; ss += x[d] * x[d]; }
            ss += __shfl_xor(ss, 1);
            const float rn = __builtin_amdgcn_rsqf(ss * (1.0f / 64.0f) + cfg::RMS_EPS) * C.lam_scale;
            const float* sg = C.subg + half * 32;
            bf16* yp = C.Y + ((long)b * L + qpos0 + row) * 1024 + 512 + h * 64 + half * 32;
#pragma unroll
            for (int d = 0; d < 32; d += 8) { u32x4 w;
                w.x = pk2(x[d] * rn * sg[d], x[d + 1] * rn * sg[d + 1]); w.y = pk2(x[d + 2] * rn * sg[d + 2], x[d + 3] * rn * sg[d + 3]);
                w.z = pk2(x[d + 4] * rn * sg[d + 4], x[d + 5] * rn * sg[d + 5]); w.w = pk2(x[d + 6] * rn * sg[d + 6], x[d + 7] * rn * sg[d + 7]);
                *(u32x4*)(yp + d) = w; }
        }
    }
    asm volatile("s_waitcnt lgkmcnt(0)\n\ts_barrier" ::: "memory");
#undef ATT_DMA
#undef ATT_KT
}
}

namespace att {
typedef __attribute__((address_space(3))) const char* lds_cptr;
typedef short v4i16_t __attribute__((ext_vector_type(4)));
__device__ __forceinline__ s16x4 vtr(lds_cptr p) { return __builtin_bit_cast(s16x4, __builtin_amdgcn_ds_read_tr16_b64_v4i16((__attribute__((address_space(3))) v4i16_t*)p)); }
__device__ __forceinline__ bf16x8 kld(lds_cptr p) { return *(const __attribute__((address_space(3))) bf16x8*)p; }
#define SBAR() __builtin_amdgcn_sched_barrier(0)

template <int MODE>
__device__ __forceinline__ void attn_unit_p(const Ctx& C, int item, char* shm, int tid) {
    using cfg::L; using cfg::T;
    constexpr int NK = (MODE == 2) ? 2 : 4;
    const int lane = tid & 63, r32 = lane & 31, hi = lane >> 5; const int wid = __builtin_amdgcn_readfirstlane(tid >> 6);
    const bf16* Qg = (const bf16*)C.mix; const bf16* Kg = (const bf16*)(C.mix + (size_t)T * 512); const bf16* Vg = (const bf16*)(C.mix + (size_t)T * 768);
    const int kvh = item & 1; int b, qpos0, h, kc0 = 0;
    if (MODE == 2) { const int qi = (item >> 1) % 66; b = (item >> 1) / 66; const int g = wid >> 2, c = (wid >> 1) & 1, rb = wid & 1; h = 2 * kvh + g; qpos0 = 64 * qi + 32 * rb; kc0 = 2 * c; }
    else { const int qb = (item >> 1) % 33; b = (item >> 1) / 33; h = 2 * kvh + (wid >> 2); qpos0 = 128 * qb + 32 * (wid & 3); }
    const int qpos = qpos0 + r32; const long mrow = (long)b * L + qpos;
    int kt_lo = 1, NT = 65;
    if (MODE == 0) { const int qb = qpos0 >> 7; kt_lo = 2 * qb - 2; if (kt_lo < 2) kt_lo = 2; int kt_hi = 2 * qb + 3; if (kt_hi > 65) kt_hi = 65; NT = kt_hi - kt_lo + 2; }
#define ATT_KT(t) (MODE == 0 ? ((t) == 0 ? 1 : kt_lo + (t) - 1) : 1 + (t))
    const unsigned lds0 = (unsigned)(uintptr_t)shm;
    float* wsf = (float*)(shm + LDS_WS) + wid * 64;
    const float* lutS = (const float*)(shm + LDS_LUT) + (MODE == 0 ? 1088 : 0);
    const bf16* Kh = Kg + (size_t)b * L * 128 + kvh * 64; const bf16* Vh = Vg + (size_t)b * L * 128 + kvh * 64;
    const bf16* ksrc = Kh + (long)lane * 128 + wid * 8;
    const bf16* vsrc = Vh + (long)(16 * (wid & 3) + (lane >> 2)) * 128 + (wid >> 2) * 32 + (lane & 3) * 8;
    const unsigned kdst = lds0 + LDS_K + wid * 1024, vdst = lds0 + LDS_V + wid * 1024;
#define DMA_K(t, slot) glds16(ksrc + (long)ATT_KT(t) * 64 * 128, (unsigned)__builtin_amdgcn_readfirstlane(kdst + (slot)))
#define DMA_V(t, slot) glds16(vsrc + (long)ATT_KT(t) * 64 * 128, (unsigned)__builtin_amdgcn_readfirstlane(vdst + (slot)))
    const int vb0 = (int)(lds0 + LDS_V) + ((lane >> 4) & 1) * 32 + (lane & 3) * 8 + (4 * hi + ((lane & 15) >> 2)) * 64;
    const lds_cptr shm3 = (lds_cptr)shm; const lds_cptr kp0 = shm3 + LDS_K + hi * 1024 + r32 * 16 + kc0 * 2048;
    const lds_cptr vp0 = shm3 + LDS_V + ((lane >> 4) & 1) * 32 + (lane & 3) * 8 + (4 * hi + ((lane & 15) >> 2)) * 64;
    bf16x8 kf[2 * NK];
    DMA_K(0, 0); DMA_V(0, 0); DMA_K(1, SLOTB);
    bf16x8 qr[NK];
    { const bf16* qp = Qg + mrow * 256 + h * 64 + 16 * kc0 + 8 * hi;
#pragma unroll
      for (int d0 = 0; d0 < NK; ++d0) qr[d0] = *(const bf16x8*)(qp + 16 * d0); }
    float mhat = 0.f, l_reg = 0.f; f32x16 o[2]; f32x16 negm;
#pragma unroll
    for (int r = 0; r < 16; ++r) { o[0][r] = 0.f; o[1][r] = 0.f; negm[r] = 0.f; }
    asm volatile("" : "+v"(negm));
    bool resc = false;
    f32x16 czp; float czb = 0.f;
#pragma unroll
    for (int r = 0; r < 16; ++r) czp[r] = 0.f;
    const float fbLo = (MODE == 2) ? lutS[h * 260] : 0.f, fbHi = (MODE == 2) ? lutS[h * 260 + 256] : 0.f;
#define FARB(t) ((MODE != 2) ? 0.f : ((ATT_KT(t) * 64 + 63 - qpos0 <= -128) ? fbLo : ((ATT_KT(t) * 64 - qpos0 - 31 >= 128) ? fbHi : 0.f)))
#define HOOK(P0, P1, t) do { const int kt_ = ATT_KT(t), k0_ = kt_ * 64; \
        const bool near_ = (MODE == 0) || (MODE == 2 && !(k0_ + 63 - qpos0 <= -128) && !(k0_ - qpos0 - 31 >= 128)); \
        if (near_) { _Pragma("unroll") for (int r = 0; r < 16; ++r) { const int rel0 = k0_ + crow(r, hi) - qpos, rel1 = rel0 + 32; \
            const int c0_ = rel0 < -128 ? -128 : (rel0 > 128 ? 128 : rel0), c1_ = rel1 < -128 ? -128 : (rel1 > 128 ? 128 : rel1); \
            P0[r] += lutS[h * 260 + c0_ + 128]; P1[r] += lutS[h * 260 + c1_ + 128]; \
            if (MODE == 0 && kt_ != 1) { if (rel0 < -128 || rel0 > 128) P0[r] = -INFINITY; if (rel1 < -128 || rel1 > 128) P1[r] = -INFINITY; } } } \
        if (kt_ == 1) { _Pragma("unroll") for (int r = 0; r < 16; ++r) { P0[r] = -INFINITY; if (r < 8) P1[r] = -INFINITY; } } } while (0)
#define RESC() do { if (resc) { asm volatile("s_waitcnt lgkmcnt(0)" ::: "memory"); \
        _Pragma("unroll") for (int d_ = 0; d_ < 2; ++d_) _Pragma("unroll") for (int r = 0; r < 16; ++r) o[d_][r] *= wsf[crow(r, hi)]; } } while (0)
    f32x16 pA0, pA1, pB0, pB1;
    int sl_prev = 0, sl_cur = 0, sl_next = SLOTB;
#define ROT() do { sl_prev = sl_cur; sl_cur = sl_next; sl_next = (sl_next == 2 * SLOTB) ? 0 : sl_next + SLOTB; } while (0)
    DMA_K(2, 2 * SLOTB);
    ATT_WAIT_BAR(3);
    { f32x16 cz;
#pragma unroll
      for (int r = 0; r < 16; ++r) cz[r] = FARB(0);
#pragma unroll
      for (int d0 = 0; d0 < NK; ++d0) { const bf16x8 b0 = kld(kp0 + d0 * 2048), b1 = kld(kp0 + d0 * 2048 + 512);
          if (d0 == 0) { pA0 = ATT_MFMA(b0, qr[0], cz); pA1 = ATT_MFMA(b1, qr[0], cz); } else { pA0 = ATT_MFMA(b0, qr[d0], pA0); pA1 = ATT_MFMA(b1, qr[d0], pA1); } } }
    HOOK(pA0, pA1, 0);
    { float rm = fmaxf(pA0[0], pA1[0]);
#pragma unroll
      for (int r = 1; r < 16; ++r) rm = fmaxf(rm, fmaxf(pA0[r], pA1[r]));
      { auto rr = __builtin_amdgcn_permlane32_swap(__float_as_uint(rm), __float_as_uint(rm), false, false); rm = fmaxf(__uint_as_float(rr[0]), __uint_as_float(rr[1])); }
      mhat = rm;
#pragma unroll
      for (int r = 0; r < 16; ++r) { pA0[r] = fexp2(pA0[r] - rm); pA1[r] = fexp2(pA1[r] - rm); negm[r] = -mhat; czp[r] = -mhat; }
      asm volatile("" : "+v"(negm)); czb = 0.f; }
    ATT_WAIT_BAR(0);
    if (3 < NT) DMA_K(3, 0); DMA_V(1, SLOTB);
    ROT();
#pragma unroll
    for (int j = 0; j < NK; ++j) { kf[2 * j] = kld(kp0 + sl_cur + j * 2048); kf[2 * j + 1] = kld(kp0 + sl_cur + j * 2048 + 512); }
    ATT_WAIT_BAR(2);
    s16x4 vlo[8], vhi[8]; u32x4 pw0, pw1, pw2, pw3;
#define PKW(P, B) cvtpk_s(P[B], P[B + 1])
#define PAF(k) __builtin_bit_cast(bf16x8, pw##k)
#define VFR(i) (bf16x8){vlo[i][0], vlo[i][1], vlo[i][2], vlo[i][3], vhi[i][0], vhi[i][1], vhi[i][2], vhi[i][3]}
#define PIN(x) asm volatile("" : "+v"(x))
#define MX3(a, b, c) __builtin_fmaxf(__builtin_fmaxf((a), (b)), (c))
#define GAPA(MF, A0, A1, A2, A3, W0, W1, PW) do { MF; sacc += (f32x2_t){A0, A1}; sacc += (f32x2_t){A2, A3}; PIN(sacc); W0; W1; PIN(PW); SBAR(); } while (0)
#define EX(v) __builtin_amdgcn_exp2f(v)
#define GAPB(MF, X, B) do { MF; X[B] = EX(X[B]); X[B + 1] = EX(X[B + 1]); X[B + 2] = EX(X[B + 2]); X[B + 3] = EX(X[B + 3]); PIN(X); SBAR(); } while (0)
#define VRD(i) do { vlo[i] = vtr(vp_ + (((i) >> 2) * 4096 + ((i) & 3) * 1024)); vhi[i] = vtr(vp_ + (((i) >> 2) * 4096 + ((i) & 3) * 1024 + 512)); } while (0)
#define KRD(G, j) do { if ((G) && (j) < NK) { kf[2 * (j)] = kld(kp0 + sl_next + (j) * 2048); kf[2 * (j) + 1] = kld(kp0 + sl_next + (j) * 2048 + 512); SBAR(); } } while (0)
#define QK(n, C0, C1) do { if ((n) < 2 * NK) { if ((n) == 0) C0 = ATT_MFMA(kf[0], qr[0], cz_); else if ((n) == 1) C1 = ATT_MFMA(kf[1], qr[0], cz_); \
        else if (((n) & 1) == 0) C0 = ATT_MFMA(kf[(n) < 2 * NK ? (n) : 0], qr[((n) >> 1) < NK ? ((n) >> 1) : 0], C0); else C1 = ATT_MFMA(kf[(n) < 2 * NK ? (n) : 0], qr[((n) >> 1) < NK ? ((n) >> 1) : 0], C1); } } while (0)
#define STEP(C0, C1, P0, P1, t, GK, GV, GL) do { SBAR(); \
    const lds_cptr vp_ = vp0 + sl_prev; \
    if (MODE == 2) { const float fb_ = FARB(t); if (fb_ != czb) { czb = fb_; _Pragma("unroll") for (int r = 0; r < 16; ++r) czp[r] = negm[r] + fb_; asm volatile("" : "+v"(czp)); } } \
    const f32x16& cz_ = (MODE == 2) ? czp : negm; \
    VRD(0); SBAR(); f32x2_t sacc = {P0[0], P0[1]}; \
    GAPA(QK(0, C0, C1), P0[2], P0[3], P0[4], P0[5],     pw0[0] = PKW(P0, 0), pw0[1] = PKW(P0, 2), pw0); \
    VRD(4); SBAR(); GAPA(QK(1, C0, C1), P0[6], P0[7], P0[8], P0[9],     pw0[2] = PKW(P0, 4), pw0[3] = PKW(P0, 6), pw0); \
    VRD(1); SBAR(); GAPA(QK(2, C0, C1), P0[10], P0[11], P0[12], P0[13], pw1[0] = PKW(P0, 8), pw1[1] = PKW(P0, 10), pw1); \
    VRD(5); SBAR(); GAPA(QK(3, C0, C1), P0[14], P0[15], P1[0], P1[1],   pw1[2] = PKW(P0, 12), pw1[3] = PKW(P0, 14), pw1); \
    VRD(2); SBAR(); GAPA(QK(4, C0, C1), P1[2], P1[3], P1[4], P1[5],     pw2[0] = PKW(P1, 0), pw2[1] = PKW(P1, 2), pw2); \
    VRD(6); SBAR(); GAPA(QK(5, C0, C1), P1[6], P1[7], P1[8], P1[9],     pw2[2] = PKW(P1, 4), pw2[3] = PKW(P1, 6), pw2); \
    VRD(3); SBAR(); GAPA(QK(6, C0, C1), P1[10], P1[11], P1[12], P1[13], pw3[0] = PKW(P1, 8), pw3[1] = PKW(P1, 10), pw3); \
    VRD(7); SBAR(); GAPA(QK(7, C0, C1), P1[14], P1[15], 0.f, 0.f,       pw3[2] = PKW(P1, 12), pw3[3] = PKW(P1, 14), pw3); \
    l_reg += sacc[0] + sacc[1]; \
    if (GK) { DMA_K((t) + 3, sl_cur); } if (GV) { DMA_V((t) + 1, sl_next); } \
    HOOK(C0, C1, t); \
    { float a = MX3(C0[0], C0[1], C1[0]), b_ = MX3(C0[2], C0[3], C1[1]); a = MX3(a, C1[2], C1[3]); \
      _Pragma("unroll") for (int r = 4; r < 16; r += 4) { a = MX3(a, C0[r], C0[r + 1]); b_ = MX3(b_, C0[r + 2], C0[r + 3]); a = MX3(a, C1[r], C1[r + 1]); b_ = MX3(b_, C1[r + 2], C1[r + 3]); } \
      float rm = __builtin_fmaxf(a, b_); { auto rr = __builtin_amdgcn_permlane32_swap(__float_as_uint(rm), __float_as_uint(rm), false, false); rm = __builtin_fmaxf(__uint_as_float(rr[0]), __uint_as_float(rr[1])); } \
      resc = false; \
      if (__builtin_expect(__any(rm > 8.0f), 0)) { const float dl = __builtin_fmaxf(rm, 0.f); mhat += dl; \
        _Pragma("unroll") for (int r = 0; r < 16; ++r) { C0[r] -= dl; C1[r] -= dl; } \
        _Pragma("unroll") for (int r = 0; r < 16; ++r) negm[r] = -mhat; asm volatile("" : "+v"(negm)); \
        if (MODE == 2) { _Pragma("unroll") for (int r = 0; r < 16; ++r) czp[r] = czb - mhat; asm volatile("" : "+v"(czp)); } \
        const float f = __builtin_amdgcn_exp2f(-dl); l_reg *= f; if (hi == 0) wsf[r32] = f; resc = true; } } \
    SBAR(); \
    GAPB(o[0] = ATT_MFMA(PAF(0), VFR(0), o[0]), C0, 0); \
    GAPB(o[1] = ATT_MFMA(PAF(0), VFR(4), o[1]), C0, 4); \
    KRD(GL, 0); GAPB(o[0] = ATT_MFMA(PAF(1), VFR(1), o[0]), C0, 8); \
    KRD(GL, 1); GAPB(o[1] = ATT_MFMA(PAF(1), VFR(5), o[1]), C0, 12); \
    KRD(GL, 2); GAPB(o[0] = ATT_MFMA(PAF(2), VFR(2), o[0]), C1, 0); \
    KRD(GL, 3); GAPB(o[1] = ATT_MFMA(PAF(2), VFR(6), o[1]), C1, 4); \
    GAPB(o[0] = ATT_MFMA(PAF(3), VFR(3), o[0]), C1, 8); \
    GAPB(o[1] = ATT_MFMA(PAF(3), VFR(7), o[1]), C1, 12); \
    } while (0)
#define ENDW(tt) do { if ((tt) + 3 < NT) { ATT_WAIT_BAR(2); } else if ((tt) + 2 < NT) { ATT_WAIT_BAR(1); } else { ATT_WAIT_BAR(0); } } while (0)
#define DRAIN(P0, P1, slot) do { float sacc = P0[0] + P0[1]; _Pragma("unroll") for (int r = 2; r < 16; ++r) sacc += P0[r]; _Pragma("unroll") for (int r = 0; r < 16; ++r) sacc += P1[r]; l_reg += sacc; \
    pw0 = (u32x4){PKW(P0, 0), PKW(P0, 2), PKW(P0, 4), PKW(P0, 6)}; pw1 = (u32x4){PKW(P0, 8), PKW(P0, 10), PKW(P0, 12), PKW(P0, 14)}; pw2 = (u32x4){PKW(P1, 0), PKW(P1, 2), PKW(P1, 4), PKW(P1, 6)}; pw3 = (u32x4){PKW(P1, 8), PKW(P1, 10), PKW(P1, 12), PKW(P1, 14)}; \
    SBAR(); pv(o, vb0 + (slot), PAF(0), PAF(1), PAF(2), PAF(3)); } while (0)
    int t = 1;
    for (; t + 5 < NT; t += 2) {
        STEP(pB0, pB1, pA0, pA1, t, true, true, true);     ATT_WAIT_BAR(2); RESC(); ROT();
        STEP(pA0, pA1, pB0, pB1, t + 1, true, true, true); ATT_WAIT_BAR(2); RESC(); ROT();
    }
    for (; t + 1 < NT; t += 2) {
        STEP(pB0, pB1, pA0, pA1, t, (t + 3 < NT), (t + 1 < NT), (t + 1 < NT));     ENDW(t);     RESC(); ROT();
        STEP(pA0, pA1, pB0, pB1, t + 1, (t + 4 < NT), (t + 2 < NT), (t + 2 < NT)); ENDW(t + 1); RESC(); ROT();
    }
    if (t < NT) { STEP(pB0, pB1, pA0, pA1, t, false, false, false); RESC(); DRAIN(pB0, pB1, sl_cur); }
    else { DRAIN(pA0, pA1, sl_prev); }
#undef PKW
#undef PAF
#undef VFR
#undef PIN
#undef MX3
#undef GAPA
#undef GAPB
#undef EX
#undef VRD
#undef KRD
#undef QK
#undef STEP
#undef ENDW
#undef DRAIN
#undef HOOK
#undef FARB
#undef RESC
#undef ROT
    { auto rr = __builtin_amdgcn_permlane32_swap(__float_as_uint(l_reg), __float_as_uint(l_reg), false, false); l_reg = __uint_as_float(rr[0]) + __uint_as_float(rr[1]); }
    if (MODE == 0) l_reg += fexp2(C.sink[h] * cfg::LOG2E - mhat);
    if (hi == 0) wsf[32 + r32] = l_reg;
    asm volatile("s_waitcnt lgkmcnt(0)" ::: "memory");
    float rli[16];
#pragma unroll
    for (int r = 0; r < 16; ++r) rli[r] = __builtin_amdgcn_rcpf(wsf[32 + crow(r, hi)]);
    if (MODE != 2) {
        bf16* Ow = C.Y + ((long)b * L + qpos0) * 1024 + (MODE == 0 ? 0 : 256) + h * 64;
        unsigned short* stg = (unsigned short*)(shm + LDS_OST + wid * OST_W);
#pragma unroll
        for (int r = 0; r < 16; ++r) { const int orow = crow(r, hi);
#pragma unroll
            for (int d0 = 0; d0 < 2; ++d0) stg[orow * 64 + d0 * 32 + r32] = (unsigned short)f2bf(o[d0][r] * rli[r]); }
        asm volatile("s_waitcnt lgkmcnt(0)" ::: "memory");
#pragma unroll
        for (int i = 0; i < 4; ++i) { const int row = i * 8 + (lane >> 3), ch = lane & 7; const u32x4 v = *(const u32x4*)(stg + row * 64 + ch * 8); *(u32x4*)(Ow + (long)row * 1024 + ch * 8) = v; }
    } else {
        const int g = wid >> 2, c = (wid >> 1) & 1, rb = wid & 1;
        float* buf = (float*)(shm + LDS_OST + (g * 2 + rb) * OST_W);
        if (c == 1) {
#pragma unroll
            for (int r = 0; r < 16; ++r) { const int orow = crow(r, hi);
#pragma unroll
                for (int d0 = 0; d0 < 2; ++d0) buf[orow * 66 + d0 * 32 + r32] = o[d0][r] * rli[r]; }
        }
        asm volatile("s_waitcnt lgkmcnt(0)\n\ts_barrier" ::: "memory");
        if (c == 0) {
#pragma unroll
            for (int r = 0; r < 16; ++r) { const int orow = crow(r, hi);
#pragma unroll
                for (int d0 = 0; d0 < 2; ++d0) { float* e = buf + orow * 66 + d0 * 32 + r32; *e = o[d0][r] * rli[r] - C.lam * *e; } }
            asm volatile("s_waitcnt lgkmcnt(0)" ::: "memory");
            const int row = lane >> 1, half = lane & 1; const float* src = buf + row * 66 + half * 32;
            float x[32]; float ss = 0.f;
#pragma unroll
            for (int d = 0; d < 32; ++d) { x[d] = src[d]; ss += x[d] * x[d]; }
            ss += __shfl_xor(ss, 1);
            const float rn = __builtin_amdgcn_rsqf(ss * (1.0f / 64.0f) + cfg::RMS_EPS) * C.lam_scale;
            const float* sg = C.subg + half * 32;
            bf16* yp = C.Y + ((long)b * L + qpos0 + row) * 1024 + 512 + h * 64 + half * 32;
#pragma unroll
            for (int d = 0; d < 32; d += 8) { u32x4 w;
                w.x = pk2(x[d] * rn * sg[d], x[d + 1] * rn * sg[d + 1]); w.y = pk2(x[d + 2] * rn * sg[d + 2], x[d + 3] * rn * sg[d + 3]);
                w.z = pk2(x[d + 4] * rn * sg[d + 4], x[d + 5] * rn * sg[d + 5]); w.w = pk2(x[d + 6] * rn * sg[d + 6], x[d + 7] * rn * sg[d + 7]);
                *(u32x4*)(yp + d) = w; }
        }
    }
    asm volatile("s_waitcnt lgkmcnt(0)\n\ts_barrier" ::: "memory");
#undef DMA_K
#undef DMA_V
#undef ATT_KT
}
#undef SBAR
}

namespace hg {
typedef float f32x4 __attribute__((ext_vector_type(4)));
typedef short bf16x8 __attribute__((ext_vector_type(8)));
typedef unsigned u32x4 __attribute__((ext_vector_type(4)));
constexpr int B_QT = 0, B_KE = 18432, B_VT = 36864, B_SS = 54272, B_KT = 63488, B_RR = 80896, B_TOT = 83200, B_SX = 85248, B_END = 87552;
static_assert(B_END <= 131072, "HGRN LDS map");
#define HG_MFMA(a, b, c) __builtin_amdgcn_mfma_f32_16x16x32_bf16(a, b, c, 0, 0, 0)
#define WT_STORE(p, v) __hip_atomic_store((p), (v), __ATOMIC_RELAXED, __HIP_MEMORY_SCOPE_AGENT)

struct Ptrs { const bf16* DQ; const bf16* ZF; const bf16* ZB; const bf16* DI; const bf16* DG; const float* lbf; const float* lbb; float* ST; float* AC; };

__device__ __forceinline__ bf16x8 pack8(const float* x) { u32x4 w; w.x = pk2(x[0], x[1]); w.y = pk2(x[2], x[3]); w.z = pk2(x[4], x[5]); w.w = pk2(x[6], x[7]); return __builtin_bit_cast(bf16x8, w); }

struct Raw { unsigned short zf[16], zb[16], q[16], v[16]; };
template <bool S1MODE>
__device__ __forceinline__ void pre_load(const Ptrs& P, int b, int h, int c, int tid, Raw& R) {
    const int I = tid >> 6, k = tid & 63;
#pragma unroll
    for (int i = 0; i < 16; ++i) {
        const size_t off = (size_t)(b * cfg::L + 128 * c + 16 * I + i) * 256 + h * 64 + k;
        R.zf[i] = P.ZF[off]; R.zb[i] = P.ZB[off]; R.v[i] = P.DI[off]; if (!S1MODE) R.q[i] = P.DQ[off];
    }
}
template <bool S1MODE>
__device__ __forceinline__ void pre_compute(const Ptrs& P, int h, int c, int dir, unsigned char* lb_, int tid, const Raw& R) {
    const int I = dir ? 7 - (tid >> 6) : (tid >> 6), k = tid & 63;
#define RN(a, i) (dir ? R.a[15 - (i)] : R.a[i])
    unsigned short* QT = (unsigned short*)(lb_ + B_QT); unsigned short* KE = (unsigned short*)(lb_ + B_KE); unsigned short* VT = (unsigned short*)(lb_ + B_VT);
    unsigned short* KT = (unsigned short*)(lb_ + B_KT); float* RR = (float*)(lb_ + B_RR); float* TOT = (float*)(lb_ + B_TOT);
    const float lb = (dir ? P.lbb : P.lbf)[h * 64 + k];
    float pr = 1.f; float fv[16], kq[16];
#pragma unroll
    for (int i = 0; i < 16; ++i) {
        const int tau = 16 * I + i;
        const float z = __builtin_amdgcn_fmed3f(bf2f(dir ? R.zb[15 - i] : R.zf[i]), -80.0f, 80.0f), ez = __builtin_amdgcn_exp2f(-cfg::LOG2E * z), sg = __builtin_amdgcn_rcpf(1.0f + ez);
        const float fr_ = lb + (1.0f - lb) * sg, f = fmaxf(fr_, 1e-30f);
        pr *= f; fv[i] = f;
        kq[i] = 1.0f - fr_;
        if (!S1MODE) QT[tau * 72 + k] = (unsigned short)pk2(bf2f(RN(q, i)) * pr, 0.f);
    }
    if (c == 0) {
#pragma unroll
        for (int i = 0; i < 16; ++i) { const int tau = 16 * I + i, t = dir ? 127 - tau : tau; if (t < cfg::FRONT) kq[i] = 0.0f; }
    }
    { u32x4 w0, w1;
      w0.x = RN(v, 0) | ((unsigned)RN(v, 1) << 16); w0.y = RN(v, 2) | ((unsigned)RN(v, 3) << 16); w0.z = RN(v, 4) | ((unsigned)RN(v, 5) << 16); w0.w = RN(v, 6) | ((unsigned)RN(v, 7) << 16);
      w1.x = RN(v, 8) | ((unsigned)RN(v, 9) << 16); w1.y = RN(v, 10) | ((unsigned)RN(v, 11) << 16); w1.z = RN(v, 12) | ((unsigned)RN(v, 13) << 16); w1.w = RN(v, 14) | ((unsigned)RN(v, 15) << 16);
      *(u32x4*)(lb_ + B_VT + k * 272 + 32 * I) = w0; *(u32x4*)(lb_ + B_VT + k * 272 + 32 * I + 16) = w1; }
    { float sf = 1.f;
#pragma unroll
      for (int i = 15; i >= 0; --i) { kq[i] *= sf; sf *= fv[i]; } }
    if (!S1MODE) {
#pragma unroll
        for (int i = 0; i < 16; ++i) KE[(16 * I + i) * 72 + k] = (unsigned short)pk2(kq[i], 0.f);
    }
    TOT[I * 64 + k] = pr;
    __syncthreads();
    float dd[8];
#pragma unroll
    for (int J = 0; J < 8; ++J) dd[J] = TOT[J * 64 + k];
    if (S1MODE) {
        float ef = 1.f, all = 1.f;
#pragma unroll
        for (int J = 0; J < 8; ++J) { ef *= (J > I) ? dd[J] : 1.0f; all *= dd[J]; }
        float x[16];
#pragma unroll
        for (int i = 0; i < 16; ++i) x[i] = kq[i] * ef;
        *(bf16x8*)(lb_ + B_KT + k * 272 + 32 * I) = pack8(x); *(bf16x8*)(lb_ + B_KT + k * 272 + 32 * I + 16) = pack8(x + 8);
        if (tid < 64) RR[8 * 64 + k] = all;
        __syncthreads();
    } else {
        float r = 1.f;
#pragma unroll
        for (int J = 0; J < 8; ++J) r *= (J < I) ? dd[J] : 1.0f;
        RR[I * 64 + k] = r;
        __syncthreads();
    }
}
#undef RN
__device__ __forceinline__ int hg_item_bh(int item) { return item < 256 ? item >> 4 : item - 256; }
__device__ __forceinline__ int hg_item_j(int item) { return item < 256 ? item & 15 : 16; }
__device__ __forceinline__ size_t st_item(int b, int h, int c, int dir) { return (size_t)(((b * 4 + h) * 33 + c) * 2 + dir); }

__device__ __forceinline__ void s1_body(const Ptrs& P, int b, int h, int c, unsigned char* lb_, int tid, const Raw& R) {
    const int w = __builtin_amdgcn_readfirstlane(tid >> 6), lane = tid & 63, i = lane & 15, q4 = lane >> 4, kb = w >> 1, vh = w & 1;
#pragma unroll
    for (int dir = 0; dir < 2; ++dir) {
        __syncthreads();
        pre_compute<true>(P, h, c, dir, lb_, tid, R);
        f32x4 c0 = {0.f, 0.f, 0.f, 0.f}, c1 = {0.f, 0.f, 0.f, 0.f};
#pragma unroll
        for (int step = 0; step < 4; ++step) {
            const bf16x8 a = *(const bf16x8*)(lb_ + B_KT + (16 * kb + i) * 272 + 16 * q4 + 64 * step);
            const bf16x8 b0 = *(const bf16x8*)(lb_ + B_VT + (32 * vh + i) * 272 + 16 * q4 + 64 * step), b1 = *(const bf16x8*)(lb_ + B_VT + (32 * vh + 16 + i) * 272 + 16 * q4 + 64 * step);
            c0 = HG_MFMA(a, b0, c0); c1 = HG_MFMA(a, b1, c1); }
        const size_t it = st_item(b, h, c, dir); float* L = P.ST + it * 4096;
#pragma unroll
        for (int r = 0; r < 4; ++r) { const int kk = 16 * kb + 4 * q4 + r; WT_STORE(L + kk * 64 + 32 * vh + i, c0[r]); WT_STORE(L + kk * 64 + 32 * vh + 16 + i, c1[r]); }
        if (tid < 64) WT_STORE(P.AC + it * 64 + tid, ((const float*)(lb_ + B_RR))[8 * 64 + tid]);
    }
}
__device__ __forceinline__ void s1_item(const Ptrs& P, int item, unsigned char* lb_, int tid) {
    const int bh = hg_item_bh(item), j = hg_item_j(item), c0 = 2 * j, h = bh & 3, b = bh >> 2; const bool two = c0 + 1 < 33;
    Raw Ra, Rb; pre_load<true>(P, b, h, c0, tid, Ra); pre_load<true>(P, b, h, two ? c0 + 1 : c0, tid, Rb);
    s1_body(P, b, h, c0, lb_, tid, Ra);
    if (two) s1_body(P, b, h, c0 + 1, lb_, tid, Rb);
}

__device__ __forceinline__ void scan(const Ptrs& P, int gid, int nthreads) {
    for (int e = gid; e < 32 * 4096; e += nthreads) {
        const int chain = e >> 12, el = e & 4095, dir = chain & 1, bh = chain >> 1, k = el >> 6;
        float Lv[33], av[33];
#pragma unroll
        for (int cc = 0; cc < 33; ++cc) { const int c = dir ? 32 - cc : cc; const size_t it = (size_t)((bh * 33 + c) * 2 + dir); Lv[cc] = P.ST[it * 4096 + el]; av[cc] = P.AC[it * 64 + k]; }
        float st = 0.f;
#pragma unroll
        for (int cc = 0; cc < 33; ++cc) { const int c = dir ? 32 - cc : cc; const size_t it = (size_t)((bh * 33 + c) * 2 + dir); P.ST[it * 4096 + el] = st; st = av[cc] * st + Lv[cc]; }
    }
}

__device__ __forceinline__ void scan_chain(const Ptrs& P, int chain, int tid) {
    const int dir = chain & 1, bh = chain >> 1;
    for (int j = 0; j < 8; ++j) {
        const int el = tid + 512 * j, k = el >> 6;
        float Lv[33], av[33];
#pragma unroll
        for (int cc = 0; cc < 33; ++cc) { const int c = dir ? 32 - cc : cc; const size_t it = (size_t)((bh * 33 + c) * 2 + dir); Lv[cc] = P.ST[it * 4096 + el]; av[cc] = P.AC[it * 64 + k]; }
        float st = 0.f;
#pragma unroll
        for (int cc = 0; cc < 33; ++cc) { const int c = dir ? 32 - cc : cc; const size_t it = (size_t)((bh * 33 + c) * 2 + dir); WT_STORE(P.ST + it * 4096 + el, st); st = av[cc] * st + Lv[cc]; }
    }
}

struct S3Pre { Raw R; v2u gq[4]; f32x4 sa[2], sb[2]; };
__device__ __forceinline__ void s3_body(const Ptrs& P, const float* outg, bf16* Y, int b, int h, int c, unsigned char* lb_, int tid, const S3Pre& Q) {
    const int w = __builtin_amdgcn_readfirstlane(tid >> 6), lane = tid & 63, i = lane & 15, q4 = lane >> 4;
    const float* RR = (const float*)(lb_ + B_RR);
    f32x4 acc[4];
#pragma unroll
    for (int vb = 0; vb < 4; ++vb) acc[vb] = (f32x4){0.f, 0.f, 0.f, 0.f};
    const Raw& R = Q.R; const int skk = tid >> 3, sv0 = (tid & 7) * 8;
#pragma unroll
    for (int dir = 0; dir < 2; ++dir) {
        __syncthreads();
        { unsigned short* SS = (unsigned short*)(lb_ + B_SS);
#pragma unroll
          for (int j = 0; j < 4; ++j) { SS[(sv0 + j) * 72 + skk] = (unsigned short)f2bf(Q.sa[dir][j]); SS[(sv0 + 4 + j) * 72 + skk] = (unsigned short)f2bf(Q.sb[dir][j]); } }
        pre_compute<false>(P, h, c, dir, lb_, tid, R);
        const int Ib = dir ? 7 - w : w, ip = dir ? 15 - i : i, trow = 16 * Ib + ip;
        float qv[16], ri[16];
        { const bf16x8 qa = *(const bf16x8*)(lb_ + B_QT + trow * 144 + 16 * q4), qb = *(const bf16x8*)(lb_ + B_QT + trow * 144 + 16 * q4 + 64);
#pragma unroll
          for (int j = 0; j < 8; ++j) { qv[j] = bf2f((unsigned short)qa[j]); qv[8 + j] = bf2f((unsigned short)qb[j]); }
          const f32x4 r0 = *(const f32x4*)(RR + Ib * 64 + 8 * q4), r1 = *(const f32x4*)(RR + Ib * 64 + 8 * q4 + 4), r2 = *(const f32x4*)(RR + Ib * 64 + 32 + 8 * q4), r3 = *(const f32x4*)(RR + Ib * 64 + 32 + 8 * q4 + 4);
#pragma unroll
          for (int j = 0; j < 4; ++j) { ri[j] = r0[j]; ri[4 + j] = r1[j]; ri[8 + j] = r2[j]; ri[12 + j] = r3[j]; } }
        { float x[16];
#pragma unroll
          for (int j = 0; j < 16; ++j) x[j] = qv[j] * ri[j];
          const bf16x8 bq0 = pack8(x), bq1 = pack8(x + 8);
#pragma unroll
          for (int vb = 0; vb < 4; ++vb) { const unsigned char* sp = lb_ + B_SS + (16 * vb + i) * 144 + 16 * q4;
              acc[vb] = HG_MFMA(*(const bf16x8*)sp, bq0, acc[vb]); acc[vb] = HG_MFMA(*(const bf16x8*)(sp + 64), bq1, acc[vb]); } }
        const float* TOTc = (const float*)(lb_ + B_TOT);
        float Fq[16];
        { const f32x4 d0 = *(const f32x4*)(TOTc + Ib * 64 + 8 * q4), d1 = *(const f32x4*)(TOTc + Ib * 64 + 8 * q4 + 4), d2 = *(const f32x4*)(TOTc + Ib * 64 + 32 + 8 * q4), d3 = *(const f32x4*)(TOTc + Ib * 64 + 32 + 8 * q4 + 4);
#pragma unroll
          for (int j = 0; j < 4; ++j) { Fq[j] = __builtin_amdgcn_rcpf(fmaxf(d0[j], 1e-37f)); Fq[4 + j] = __builtin_amdgcn_rcpf(fmaxf(d1[j], 1e-37f)); Fq[8 + j] = __builtin_amdgcn_rcpf(fmaxf(d2[j], 1e-37f)); Fq[12 + j] = __builtin_amdgcn_rcpf(fmaxf(d3[j], 1e-37f)); } }
        for (int J0 = Ib & ~1; J0 >= 0; J0 -= 2) {
            u32x4 pbw = {0u, 0u, 0u, 0u};
#pragma unroll
            for (int hb = 1; hb >= 0; --hb) {
                const int J = J0 + hb;
                if (J <= Ib) {
                    float x[16];
#pragma unroll
                    for (int j = 0; j < 16; ++j) x[j] = qv[j] * Fq[j];
                    const bf16x8 bq0 = pack8(x), bq1 = pack8(x + 8);
                    const unsigned char* kp = lb_ + B_KE + (16 * J + i) * 144 + 16 * q4;
                    f32x4 at = {0.f, 0.f, 0.f, 0.f};
                    at = HG_MFMA(*(const bf16x8*)kp, bq0, at); at = HG_MFMA(*(const bf16x8*)(kp + 64), bq1, at);
                    if (J == Ib) {
#pragma unroll
                        for (int r = 0; r < 4; ++r) if (4 * q4 + r > ip) at[r] = 0.f;
#pragma unroll
                        for (int j = 0; j < 16; ++j) Fq[j] = 1.0f;
                    } else {
                        const f32x4 d0 = *(const f32x4*)(TOTc + J * 64 + 8 * q4), d1 = *(const f32x4*)(TOTc + J * 64 + 8 * q4 + 4), d2 = *(const f32x4*)(TOTc + J * 64 + 32 + 8 * q4), d3 = *(const f32x4*)(TOTc + J * 64 + 32 + 8 * q4 + 4);
#pragma unroll
                        for (int j = 0; j < 4; ++j) { Fq[j] *= d0[j]; Fq[4 + j] *= d1[j]; Fq[8 + j] *= d2[j]; Fq[12 + j] *= d3[j]; }
                    }
                    if (hb == 0) { pbw.x = pk2(at[0], at[1]); pbw.y = pk2(at[2], at[3]); } else { pbw.z = pk2(at[0], at[1]); pbw.w = pk2(at[2], at[3]); }
                }
            }
            const int J1 = (J0 + 1 <= Ib) ? J0 + 1 : J0;
            const bf16x8 pb = __builtin_bit_cast(bf16x8, pbw);
#pragma unroll
            for (int vb = 0; vb < 4; ++vb) { const unsigned char* vp = lb_ + B_VT + (16 * vb + i) * 272 + 8 * q4;
                const v2u a0 = *(const v2u*)(vp + 32 * J0), a1 = *(const v2u*)(vp + 32 * J1);
                const u32x4 aw = {a0.x, a0.y, a1.x, a1.y};
                acc[vb] = HG_MFMA(__builtin_bit_cast(bf16x8, aw), pb, acc[vb]); }
        }
    }
    float ss = 0.f;
#pragma unroll
    for (int vb = 0; vb < 4; ++vb) ss += (acc[vb][0] * acc[vb][0] + acc[vb][1] * acc[vb][1]) + (acc[vb][2] * acc[vb][2] + acc[vb][3] * acc[vb][3]);
    ss += __shfl_xor(ss, 16); ss += __shfl_xor(ss, 32);
    const float rn = __builtin_amdgcn_rsqf(ss * (1.0f / 64.0f) + cfg::RMS_EPS);
    const size_t m = (size_t)b * cfg::L + 128 * c + 16 * w + i;
    v2u wv[4];
#pragma unroll
    for (int vb = 0; vb < 4; ++vb) { const int v = 16 * vb + 4 * q4;
        const v2u g = Q.gq[vb]; const f32x4 og = *(const f32x4*)(outg + v);
        const float gg[4] = {bflo(g.x), bfhi(g.x), bflo(g.y), bfhi(g.y)}; float y[4];
#pragma unroll
        for (int r = 0; r < 4; ++r) y[r] = acc[vb][r] * rn * og[r] * (gg[r] * __builtin_amdgcn_rcpf(1.0f + __builtin_amdgcn_exp2f(-cfg::LOG2E * gg[r])));
        wv[vb].x = pk2(y[0], y[1]); wv[vb].y = pk2(y[2], y[3]); }
#pragma unroll
    for (int vb = 0; vb < 4; vb += 2) {
        const auto s0 = __builtin_amdgcn_permlane16_swap(wv[vb].x, wv[vb + 1].x, false, false); const auto s1 = __builtin_amdgcn_permlane16_swap(wv[vb].y, wv[vb + 1].y, false, false);
        u32x4 o; o.x = s0[0]; o.y = s1[0]; o.z = s0[1]; o.w = s1[1];
        *(u32x4*)(Y + m * 1024 + 768 + h * 64 + 16 * vb + ((q4 & 1) ? 16 + 4 * (q4 - 1) : 4 * q4)) = o; }
}
__device__ __forceinline__ void s3_pre(const Ptrs& P, int b, int h, int c, int tid, S3Pre& Q) {
    const int w = __builtin_amdgcn_readfirstlane(tid >> 6), lane = tid & 63, i = lane & 15, q4 = lane >> 4;
    pre_load<false>(P, b, h, c, tid, Q.R);
    const size_t m = (size_t)b * cfg::L + 128 * c + 16 * w + i;
#pragma unroll
    for (int vb = 0; vb < 4; ++vb) Q.gq[vb] = *(const v2u*)(P.DG + m * 256 + h * 64 + 16 * vb + 4 * q4);
}
__device__ __forceinline__ void s3_states(const Ptrs& P, int b, int h, int c, int tid, S3Pre& Q) {
    const int skk = tid >> 3, sv0 = (tid & 7) * 8;
#pragma unroll
    for (int dir = 0; dir < 2; ++dir) { const float* S = P.ST + st_item(b, h, c, dir) * 4096; Q.sa[dir] = *(const f32x4*)(S + skk * 64 + sv0); Q.sb[dir] = *(const f32x4*)(S + skk * 64 + sv0 + 4); }
}
template <class WaitF>
__device__ __forceinline__ void s3_item(const Ptrs& P, const float* outg, bf16* Y, int item, unsigned char* lb_, int tid, WaitF wait_states) {
    const int bh = hg_item_bh(item), j = hg_item_j(item), c0 = 2 * j, h = bh & 3, b = bh >> 2; const bool two = c0 + 1 < 33; const int c1 = two ? c0 + 1 : c0;
    S3Pre Qa, Qb;
    s3_pre(P, b, h, c0, tid, Qa); pre_load<false>(P, b, h, c1, tid, Qb.R);
    wait_states();
    s3_states(P, b, h, c0, tid, Qa);
    s3_body(P, outg, Y, b, h, c0, lb_, tid, Qa);
    if (two) { { const int w = __builtin_amdgcn_readfirstlane(tid >> 6), lane = tid & 63, i = lane & 15, q4 = lane >> 4; const size_t m = (size_t)b * cfg::L + 128 * c1 + 16 * w + i;
#pragma unroll
          for (int vb = 0; vb < 4; ++vb) Qb.gq[vb] = *(const v2u*)(P.DG + m * 256 + h * 64 + 16 * vb + 4 * q4); }
        s3_states(P, b, h, c1, tid, Qb); s3_body(P, outg, Y, b, h, c1, lb_, tid, Qb); }
}
}

constexpr int NWAVES = 8;
#ifndef DIS
#define DIS 0
#endif
#ifndef MK_SPLIT
#define MK_SPLIT 0
#endif
#define LDS_WAIT() asm volatile("s_waitcnt lgkmcnt(0)" ::: "memory")
#define RLX_AGENT __ATOMIC_RELAXED, __HIP_MEMORY_SCOPE_AGENT
constexpr int CW_SCHED = 0, CW_DEP = 1024, CW_BAR = 12288; constexpr size_t CTL_ZERO_BYTES = 65536;
constexpr int MISC_OFF = 131072 + 320;
#ifndef DEP_SPIN
#define DEP_SPIN 1
#endif
#ifndef DEP_ACQ
#define DEP_ACQ 1
#endif
__device__ __forceinline__ void dep_signal(unsigned* cnt, bool t0) {
    asm volatile("s_waitcnt vmcnt(0)" ::: "memory");
    __syncthreads();
    if (t0 && cnt) { const unsigned one = 1u; asm volatile("global_atomic_add %0, %1, off" :: "v"(cnt), "v"(one) : "memory"); }
}
__device__ __forceinline__ void dep_wait(unsigned* cnt, unsigned want, bool t0) {
    if (t0) { unsigned sp = 0;
        while (DEP_SPIN && __hip_atomic_load(cnt, __ATOMIC_RELAXED, __HIP_MEMORY_SCOPE_AGENT) < want) { __builtin_amdgcn_s_sleep(4); if (++sp > (1u << 18)) break; }
        if (DEP_ACQ) { __builtin_amdgcn_fence(__ATOMIC_ACQUIRE, "agent"); asm volatile("s_waitcnt vmcnt(0)" ::: "memory"); } }
    __syncthreads();
}
#ifndef PROBE_QMASK
#define PROBE_QMASK 127
#endif
#ifndef PROBE_REP
#define PROBE_REP 0
#endif
#ifndef USE_XCD_BAR
#define USE_XCD_BAR 1
#endif
#ifndef ATT_PIPE
#define ATT_PIPE 1
#endif
#if ATT_PIPE
#define ATT_UNIT att::attn_unit_p
#else
#define ATT_UNIT att::attn_unit
#endif
#ifndef NAIVE_ATTN
#define NAIVE_ATTN 0
#endif
#define XB_TMO      128
#define XB_XCNT(j)  (256  + 64 * (j))
#define XB_XSUB(j)  (1280 + 64 * (j))
#define XB_XGEN(j)  (2304 + 64 * (j))
#define XB_TOP      3328
#define XB_TOPGEN   3392
#define XCD_BAR_WORDS 3456
#define XB_SPIN_CAP (1u << 18)

__device__ __forceinline__ unsigned xb_ld(unsigned* p)              { return __hip_atomic_load(p, __ATOMIC_RELAXED, __HIP_MEMORY_SCOPE_AGENT); }
__device__ __forceinline__ unsigned xb_add(unsigned* p, unsigned v) { return __hip_atomic_fetch_add(p, v, __ATOMIC_RELAXED, __HIP_MEMORY_SCOPE_AGENT); }
__device__ __forceinline__ unsigned xb_xcc_id() { return (unsigned)__builtin_amdgcn_s_getreg((3 << 11) | 20) & 0xFu; }
#define XB_SPIN(cond, bar) do { unsigned _sp = 0; while (cond) { __builtin_amdgcn_s_sleep(1); \
    if ((++_sp & 255u) == 0u) { if (xb_ld(&(bar)[XB_TMO])) break; if (_sp > XB_SPIN_CAP) { atomicAdd(&(bar)[XB_TMO], 1u); break; } } } } while (0)

struct XcdBarrier {
    unsigned* bar; unsigned x; int t0;
    volatile LAS unsigned* st;
};

__device__ __forceinline__ XcdBarrier xcd_barrier_post(unsigned* bar, volatile LAS unsigned* st) {
    XcdBarrier b; b.bar = bar; b.x = xb_xcc_id(); b.st = st;
    if (threadIdx.x == 0) (void)xb_add(&bar[XB_XCNT(b.x)], 1u);
    return b;
}
__device__ __forceinline__ void xcd_barrier_complete(unsigned* bar, unsigned x, unsigned& nloc, unsigned& nx) {
    const unsigned G = gridDim.x * gridDim.y * gridDim.z;
    unsigned sum, cnt, mine, sp = 0u;
    for (;;) {
        sum = 0u; cnt = 0u; mine = 0u;
#pragma unroll
        for (unsigned j = 0; j < 16; ++j) { const unsigned c = xb_ld(&bar[XB_XCNT(j)]); sum += c; cnt += (c > 0u) ? 1u : 0u; mine = (j == x) ? c : mine; }
        if (sum == G) break;
        __builtin_amdgcn_s_sleep(1);
        if ((++sp & 255u) == 0u) { if (xb_ld(&bar[XB_TMO])) break; if (sp > XB_SPIN_CAP) { atomicAdd(&bar[XB_TMO], 1u); break; } }
    }
    nloc = mine > 0u ? mine : 1u; nx = cnt > 0u ? cnt : 1u;
}

__device__ __forceinline__ void xcd_barrier(const XcdBarrier& b) {
    asm volatile("s_waitcnt vmcnt(0)" ::: "memory");
    __syncthreads();
    if (b.t0) {
        unsigned* bar = b.bar;
        __builtin_amdgcn_s_waitcnt(0);
        unsigned nloc = b.st[0], nx = b.st[1];
        if (nloc == 0u) { xcd_barrier_complete(bar, b.x, nloc, nx); b.st[0] = nloc; b.st[1] = nx; }
        const unsigned old = xb_add(&bar[XB_XSUB(b.x)], 1u);
        const unsigned gen = old / nloc;
        if (old + 1u == (gen + 1u) * nloc) {
            __builtin_amdgcn_fence(__ATOMIC_RELEASE, "agent");
            asm volatile("s_waitcnt vmcnt(0)" ::: "memory");
            const unsigned og = xb_add(&bar[XB_TOP], 1u);
            const unsigned tg = og / nx;
            if (og + 1u == (tg + 1u) * nx) xb_add(&bar[XB_TOPGEN], 1u);
            else XB_SPIN(xb_ld(&bar[XB_TOPGEN]) == tg, bar);
            __builtin_amdgcn_fence(__ATOMIC_ACQUIRE, "agent");
            xb_add(&bar[XB_XGEN(b.x)], 1u);
            asm volatile("s_waitcnt vmcnt(0)" ::: "memory");
        } else {
            XB_SPIN(xb_ld(&bar[XB_XGEN(b.x)]) == gen, bar);
            __builtin_amdgcn_fence(__ATOMIC_ACQUIRE, "agent");
            asm volatile("s_waitcnt vmcnt(0)" ::: "memory");
        }
    }
    __syncthreads();
}
using cfg::T; using cfg::L;

struct Args { const float* in[19]; float* out; unsigned char* ws; int ph_lo, ph_hi; };
typedef const __attribute__((address_space(4))) Args* CArgs;
__device__ __forceinline__ CArgs phase_args() { CArgs p = (CArgs)__builtin_amdgcn_kernarg_segment_ptr(); asm volatile("" : "+s"(p)); return p; }

__device__ __forceinline__ float wave_sum(float v) {
#pragma unroll
    for (int o = 1; o < 64; o <<= 1) v += __shfl_xor(v, o);
    return v;
}

struct RmId { __device__ __forceinline__ int operator()(int n) const { return n; } };
struct RmW1 { __device__ __forceinline__ int operator()(int n) const { const int pn = n >> 8, cc = n & 255; return pn < 6 ? (pn << 8) + 128 * ((cc & 63) >> 5) + 32 * (cc >> 6) + (cc & 31) : n; } };
struct RmGU { int half; __device__ __forceinline__ int operator()(int j) const { return ((j >> 7) << 8) + half * 128 + (j & 127); } };
typedef float tf4 __attribute__((ext_vector_type(4)));
__device__ __forceinline__ void transpose_load(const float* W, int N, const float* gain, int nblk, int item, int lane, tf4 (&wv)[8], float (&gv)[8]) {
    const int kb = item / nblk, nb = item % nblk, k0 = 64 * kb, n0 = 32 * nb;
#pragma unroll
    for (int i = 0; i < 8; ++i) wv[i] = *(const tf4*)(W + (size_t)(k0 + 8 * i + (lane >> 3)) * N + n0 + 4 * (lane & 7));
    if (gain) {
#pragma unroll
        for (int i = 0; i < 8; ++i) gv[i] = gain[k0 + 8 * i + (lane >> 3)];
    }
}
template <class RowMap>
__device__ __forceinline__ void transpose_finish(int K, bf16* WT, bool hasgain, RowMap rm, LAS float* scr, int nblk, int item, int lane, const tf4 (&wv)[8], const float (&gv)[8]) {
    const int kb = item / nblk, nb = item % nblk, k0 = 64 * kb, n0 = 32 * nb;
#pragma unroll
    for (int i = 0; i < 8; ++i) { const tf4 v = hasgain ? wv[i] * gv[i] : wv[i]; LAS float* d = scr + (8 * i + (lane >> 3)) * 33 + 4 * (lane & 7); d[0] = v[0]; d[1] = v[1]; d[2] = v[2]; d[3] = v[3]; }
    LDS_WAIT(); asm volatile("" ::: "memory");
    const int c = lane & 7;
#pragma unroll
    for (int j = 0; j < 4; ++j) { const int n = (lane >> 3) + 8 * j; const LAS float* s = scr + (8 * c) * 33 + n;
        v4u o; o.x = pk2(s[0 * 33], s[1 * 33]); o.y = pk2(s[2 * 33], s[3 * 33]); o.z = pk2(s[4 * 33], s[5 * 33]); o.w = pk2(s[6 * 33], s[7 * 33]);
        *(v4u*)(WT + (size_t)rm(n0 + n) * K + k0 + 8 * c) = o; }
    LDS_WAIT(); asm volatile("" ::: "memory");
}
template <class RowMap>
__device__ __forceinline__ void transpose_run(const float* W, int K, int N, bf16* WT, const float* gain, RowMap rm, LAS float* scr, int first, int count, int stride, int lane) {
    const int nblk = N / 32; const bool hg_ = gain != nullptr;
    tf4 a[8] = {}, b[8] = {}; float ga[8] = {}, gb[8] = {};
    if (count > 0) transpose_load(W, N, gain, nblk, first, lane, a, ga);
    for (int j = 0; j < count; j += 2) {
        const bool two = j + 1 < count;
        if (two) transpose_load(W, N, gain, nblk, first + (j + 1) * stride, lane, b, gb);
        transpose_finish(K, WT, hg_, rm, scr, nblk, first + j * stride, lane, a, ga);
        if (two) { if (j + 2 < count) transpose_load(W, N, gain, nblk, first + (j + 2) * stride, lane, a, ga);
            transpose_finish(K, WT, hg_, rm, scr, nblk, first + (j + 1) * stride, lane, b, gb); }
    }
}

__device__ __forceinline__ int t5_bucket(int rel) {
    const int n = rel < 0 ? -rel : rel;
    int v = n;
    if (n >= 8) { const int j = 31 - __builtin_clz((unsigned)(n * n)) - 6; v = 8 + j; v = v > 15 ? 15 : v; }
    return (rel > 0 ? 16 : 0) + v;
}

constexpr int W_I1 = 16 * (cfg::NIN / 32), W_IB = 16 * 32, W_IO = 16 * 32, W_IG = 16 * (cfg::DFF / 32), W_IU = W_IG, W_ID = (cfg::DFF / 64) * 32, W_NITEMS = W_I1 + W_IB + W_IO + W_IG + W_IU + W_ID;
__device__ __forceinline__ void w_run(CArgs ap, int l, int r, int count, int stride, LAS float* scr, int lane) {
    unsigned char* ws = ap->ws;
    if (r < W_I1) { transpose_run(ap->in[5] + (size_t)l * 1024 * cfg::NIN, 1024, cfg::NIN, (bf16*)(ws + cfg::WS_W1), ap->in[4] + l * 1024, RmW1{}, scr, r, count, stride, lane); return; } r -= W_I1;
    if (r < W_IB) { transpose_run(ap->in[12] + (size_t)l * 1024 * 1024, 1024, 1024, (bf16*)(ws + cfg::WS_WB), nullptr, RmId{}, scr, r, count, stride, lane); return; } r -= W_IB;
    if (r < W_IO) { transpose_run(ap->in[13] + (size_t)l * 1024 * 1024, 1024, 1024, (bf16*)(ws + cfg::WS_WO), nullptr, RmId{}, scr, r, count, stride, lane); return; } r -= W_IO;
    if (r < W_IG) { transpose_run(ap->in[15] + (size_t)l * 1024 * cfg::DFF, 1024, cfg::DFF, (bf16*)(ws + cfg::WS_WGU), ap->in[14] + l * 1024, RmGU{0}, scr, r, count, stride, lane); return; } r -= W_IG;
    if (r < W_IU) { transpose_run(ap->in[16] + (size_t)l * 1024 * cfg::DFF, 1024, cfg::DFF, (bf16*)(ws + cfg::WS_WGU), ap->in[14] + l * 1024, RmGU{1}, scr, r, count, stride, lane); return; } r -= W_IU;
    transpose_run(ap->in[17] + (size_t)l * cfg::DFF * 1024, cfg::DFF, 1024, (bf16*)(ws + cfg::WS_WD), nullptr, RmId{}, scr, r, count, stride, lane);
}
__device__ __forceinline__ void w_gains(CArgs ap, int l, int lane) { float* qkg = (float*)(ap->ws + cfg::WS_TAB + cfg::TAB_QKG); qkg[lane] = ap->in[7][l * 64 + lane]; qkg[64 + lane] = ap->in[8][l * 64 + lane]; }
__device__ __forceinline__ void phase_w(CArgs ap, int l, LAS unsigned char* lds, int gw, int NGW, int wave, int lane) {
    LAS float* scr = (LAS float*)(lds + wave * 16384);
    if (gw == 0) w_gains(ap, l, lane);
    if (gw < W_I1) w_run(ap, l, gw, (W_I1 - gw + NGW - 1) / NGW, NGW, scr, lane);
}

__device__ __forceinline__ void phase_init(CArgs ap, int gw, int NGW, int lane, int tid) {
    unsigned char* ws = ap->ws;
    bf16* hb = (bf16*)(ws + cfg::WS_HB); float* ssq = (float*)(ws + cfg::WS_SSQ);
    typedef float f4 __attribute__((ext_vector_type(4)));
    for (int m0 = gw; m0 < T; m0 += 3 * NGW) {
        f4 v[3][4];
#pragma unroll
        for (int u = 0; u < 3; ++u) {
            const int m = m0 + u * NGW < T ? m0 + u * NGW : T - 1; const int b = m / L, pos = m - b * L;
            const float* src = pos < cfg::MEND ? ap->in[1] + (size_t)(pos < cfg::FRONT ? 0 : pos - cfg::FRONT) * 1024 : ap->in[0] + (size_t)(b * cfg::SEQ + pos - cfg::MEND) * 1024;
#pragma unroll
            for (int j = 0; j < 4; ++j) v[u][j] = ((const f4*)src)[64 * j + lane];
        }
#pragma unroll
        for (int u = 0; u < 3; ++u) {
            const int m = m0 + u * NGW;
            if (m < T) {
                const int b = m / L, pos = m - b * L;
                if (pos < cfg::FRONT) {
#pragma unroll
                    for (int j = 0; j < 4; ++j) v[u][j] = (f4){0.f, 0.f, 0.f, 0.f}; }
                float s = 0.f;
#pragma unroll
                for (int j = 0; j < 4; ++j) s += (v[u][j][0] * v[u][j][0] + v[u][j][1] * v[u][j][1]) + (v[u][j][2] * v[u][j][2] + v[u][j][3] * v[u][j][3]);
                s = wave_sum(s);
#pragma unroll
                for (int j = 0; j < 4; ++j) { v2u w; w.x = pk2(v[u][j][0], v[u][j][1]); w.y = pk2(v[u][j][2], v[u][j][3]); ((v2u*)(hb + (size_t)m * 1024))[64 * j + lane] = w; }
                if (lane < 16) ssq[(size_t)m * 16 + lane] = lane == 0 ? s : 0.f;
            }
        }
    }
    {
        float* tab = (float*)(ws + cfg::WS_TAB);
        float* rt = tab + cfg::TAB_RT / 4; float* luta = tab + cfg::TAB_LUTA / 4; float* lutc = tab + cfg::TAB_LUTC / 4; float* lbt = tab + cfg::TAB_LB / 4; float* lam = tab + cfg::TAB_LAM / 4;
        for (int j = (int)blockIdx.x * 512 + tid; j < 1040 + 1028 + 1024 + 2; j += (int)gridDim.x * 512) {
            if (j < 1040) { const int idx = j, v = idx / 16 - 1, i = idx % 16; const float inv = powf(10000.0f, -(float)i / 16.0f); const float ang = (float)v * inv; rt[idx * 2] = cosf(ang); rt[idx * 2 + 1] = sinf(ang); }
            else if (j < 2068) { const int idx = j - 1040, rel = idx / 4 - 128, hh = idx % 4, bk = t5_bucket(rel);
                luta[idx] = ap->in[2][bk * 8 + hh] * cfg::LOG2E; lutc[idx] = ap->in[2][bk * 8 + 4 + hh] * cfg::LOG2E; }
            else if (j < 3092) { const int idx = j - 2068, l_ = idx >> 9, dir = (idx >> 8) & 1, k = idx & 255;
                const float a0 = ap->in[3][(dir * 2 + 0) * 256 + k], a1 = ap->in[3][(dir * 2 + 1) * 256 + k];
                lbt[idx] = l_ == 0 ? 0.0f : 1.0f / (1.0f + expf(a0 - a1)); }
            else { const int t_ = j - 3092; const float* lp = ap->in[9] + t_ * 128; float s1 = 0.f, s2 = 0.f; for (int d = 0; d < 32; ++d) { s1 += lp[d] * lp[32 + d]; s2 += lp[64 + d] * lp[96 + d]; }
                const float init = 0.8f - 0.6f * expf(-0.3f * (float)t_); lam[t_ * 2] = expf(s1) - expf(s2) + init; lam[t_ * 2 + 1] = init; }
        }
    }
}

template <int MODE>
__device__ __forceinline__ void naive_attn_item(CArgs ap, int l, int item, float* lds, int tid) {
    unsigned char* ws = ap->ws;
    const float* tab = (const float*)(ws + cfg::WS_TAB);
    const float* lut = tab + (MODE == 0 ? cfg::TAB_LUTA : cfg::TAB_LUTC) / 4;
    const unsigned char* mb = ws + cfg::WS_QKV + (size_t)MODE * cfg::QKV_MIX;
    const bf16* Qg = (const bf16*)mb; const bf16* Kg = (const bf16*)(mb + (size_t)T * 512); const bf16* Vg = (const bf16*)(mb + (size_t)T * 768);
    bf16* Y = (bf16*)ap->out;
    constexpr int QD = (MODE == 2) ? 32 : 64;
    int b, qb, hp = 0;
    if (MODE == 2) { hp = item & 1; qb = (item >> 1) % 33; b = (item >> 1) / 33; } else { qb = item % 33; b = item / 33; }
    const int gc = tid >> 7, i = tid & 127;
    int h, kvh, kofs;
    if (MODE == 2) { const int g = gc >> 1, c = gc & 1; h = 2 * hp + g; kvh = hp; kofs = kvh * 64 + 32 * c; }
    else { h = gc; kvh = h >> 1; kofs = kvh * 64; }
    const int pos = qb * 128 + i, m = b * L + pos;
    float* Ks = lds; float* Vs = lds + 64 * 128;
    float q[QD], o[64];
    { const bf16* qp = Qg + (size_t)m * 256 + h * 64 + (MODE == 2 ? 32 * (gc & 1) : 0);
#pragma unroll
      for (int d = 0; d < QD; d += 2) { const unsigned w = *(const unsigned*)(qp + d); q[d] = bflo(w); q[d + 1] = bfhi(w); } }
#pragma unroll
    for (int d = 0; d < 64; ++d) o[d] = 0.f;
    float mx = -1e30f, lsum = 0.f;
    int ktlo, nwin, ntiles;
    if (MODE == 0) { ktlo = 2 * qb - 2; if (ktlo < 2) ktlo = 2; int kthi = 2 * qb + 3; if (kthi > 65) kthi = 65; nwin = kthi - ktlo + 1; ntiles = nwin + 1; }
    else { ktlo = 1; nwin = 65; ntiles = 65; }
    for (int it = 0; it < ntiles; ++it) {
        const int kt = it < nwin ? ktlo + it : 1; const bool window = (MODE == 0) && it < nwin;
        __syncthreads();
        { const int j = tid >> 3, cc = (tid & 7) * 16; const size_t ro = (size_t)(b * L + kt * 64 + j) * 128 + cc;
          const v4u k0 = *(const v4u*)(Kg + ro), k1 = *(const v4u*)(Kg + ro + 8), v0 = *(const v4u*)(Vg + ro), v1 = *(const v4u*)(Vg + ro + 8);
          float* kd = Ks + j * 128 + cc; float* vd = Vs + j * 128 + cc;
#pragma unroll
          for (int e = 0; e < 4; ++e) { kd[2 * e] = bflo(k0[e]); kd[2 * e + 1] = bfhi(k0[e]); kd[8 + 2 * e] = bflo(k1[e]); kd[9 + 2 * e] = bfhi(k1[e]);
                                        vd[2 * e] = bflo(v0[e]); vd[2 * e + 1] = bfhi(v0[e]); vd[8 + 2 * e] = bflo(v1[e]); vd[9 + 2 * e] = bfhi(v1[e]); } }
        __syncthreads();
        for (int j = 0; j < 64; ++j) {
            const int kpos = kt * 64 + j;
            if (kpos < cfg::FRONT) continue;
            const int rel = kpos - pos;
            bool ok = true; float s = 0.f;
            if (MODE != 1) { const int cl = rel < -128 ? -128 : (rel > 128 ? 128 : rel); s = lut[(cl + 128) * 4 + h]; }
            if (window) ok = (rel >= -128) && (rel <= 128);
            const float* kr = Ks + j * 128 + kofs;
#pragma unroll
            for (int d = 0; d < QD; ++d) s += q[d] * kr[d];
            if (ok) {
                if (s > mx) { const float f = fexp2(mx - s); lsum *= f;
#pragma unroll
                    for (int d = 0; d < 64; ++d) o[d] *= f;
                    mx = s; }
                const float p = fexp2(s - mx); lsum += p;
                const float* vr = Vs + j * 128 + kvh * 64;
#pragma unroll
                for (int d = 0; d < 64; ++d) o[d] += p * vr[d];
            }
        }
    }
    if (MODE == 0) {
        const float s = ap->in[6][l * 4 + h] * cfg::LOG2E;
        if (s > mx) { const float f = fexp2(mx - s); lsum *= f;
#pragma unroll
            for (int d = 0; d < 64; ++d) o[d] *= f;
            mx = s; }
        lsum += fexp2(s - mx);
    }
    const float inv = 1.0f / lsum;
    if (MODE != 2) {
        bf16* yp = Y + (size_t)m * 1024 + (MODE == 0 ? 0 : 256) + h * 64;
#pragma unroll
        for (int d = 0; d < 64; d += 2) *(unsigned*)(yp + d) = pk2(o[d] * inv, o[d + 1] * inv);
    } else {
        const int g = gc >> 1, c = gc & 1;
        float* Ox = lds;
        __syncthreads();
        if (c == 1) { float* op = Ox + (size_t)(g * 128 + i) * 65;
#pragma unroll
            for (int d = 0; d < 64; ++d) op[d] = o[d] * inv; }
        __syncthreads();
        if (c == 0) {
            const float lam = tab[cfg::TAB_LAM / 4 + 2 * l], lam_init = tab[cfg::TAB_LAM / 4 + 2 * l + 1];
            const float* op = Ox + (size_t)(g * 128 + i) * 65; const float* sg = ap->in[10] + l * 64;
            float ss = 0.f;
#pragma unroll
            for (int d = 0; d < 64; ++d) { o[d] = o[d] * inv - lam * op[d]; ss += o[d] * o[d]; }
            const float r = __builtin_amdgcn_rsqf(ss * (1.0f / 64.0f) + cfg::RMS_EPS) * (1.0f - lam_init);
            bf16* yp = Y + (size_t)m * 1024 + 512 + h * 64;
#pragma unroll
            for (int d = 0; d < 64; d += 2) *(unsigned*)(yp + d) = pk2(o[d] * r * sg[d], o[d + 1] * r * sg[d + 1]);
        }
    }
}

__device__ __forceinline__ void hgrn_chain_item(CArgs ap, int l, int item, float* lds, int tid) {
    unsigned char* ws = ap->ws;
    const int dir = item & 1, h = (item >> 1) & 3, b = item >> 3;
    const float* lbt = (const float*)(ws + cfg::WS_TAB) + cfg::TAB_LB / 4 + (l * 2 + dir) * 256 + h * 64;
    const bf16* DQ = (const bf16*)(ws + cfg::WS_D); const bf16* Z = (const bf16*)(ws + cfg::WS_D + (size_t)(1 + dir) * cfg::D_ARR); const bf16* DI = (const bf16*)(ws + cfg::WS_D + 3 * cfg::D_ARR);
    bf16* O = (bf16*)(ws + cfg::WS_OFB + (size_t)dir * cfg::D_ARR);
    float* fS = lds; float* kS = lds + 1024; float* qS = lds + 2048; float* vS = lds + 3072; float* po = lds + 4096;
    const int kg = tid >> 6, v = tid & 63;
    float S[8];
#pragma unroll
    for (int i2 = 0; i2 < 8; ++i2) S[i2] = 0.f;
    constexpr int NB = L / 16;
    unsigned short zr[2], qr[2], vr[2];
    const int stt[2] = {tid >> 6, (tid >> 6) + 8}; const int sk = tid & 63;
#define HG_LOAD(bi) do { _Pragma("unroll") for (int e = 0; e < 2; ++e) { const int s_ = 16 * (bi) + stt[e]; const int pos_ = dir ? L - 1 - s_ : s_; const size_t off_ = (size_t)(b * L + pos_) * 256 + h * 64 + sk; \
        zr[e] = Z[off_]; qr[e] = DQ[off_]; vr[e] = DI[off_]; } } while (0)
#define HG_STAGE(bi) do { _Pragma("unroll") for (int e = 0; e < 2; ++e) { const int s_ = 16 * (bi) + stt[e]; const int pos_ = dir ? L - 1 - s_ : s_; \
        const float z_ = bf2f(zr[e]), ez_ = __expf(-z_), sg_ = 1.0f / (1.0f + ez_), sn_ = ez_ * sg_, lb_ = lbt[sk]; \
        fS[stt[e] * 64 + sk] = lb_ + (1.0f - lb_) * sg_; kS[stt[e] * 64 + sk] = pos_ >= cfg::FRONT ? (1.0f - lb_) * sn_ : 0.0f; qS[stt[e] * 64 + sk] = bf2f(qr[e]); vS[stt[e] * 64 + sk] = bf2f(vr[e]); } } while (0)
    __syncthreads();
    HG_LOAD(0); HG_STAGE(0);
    __syncthreads();
    typedef float f4 __attribute__((ext_vector_type(4)));
    for (int bi = 0; bi < NB; ++bi) {
        if (bi + 1 < NB) HG_LOAD(bi + 1);
#pragma unroll
        for (int tt = 0; tt < 16; ++tt) {
            const f4 f0 = *(const f4*)(fS + tt * 64 + kg * 8), f1 = *(const f4*)(fS + tt * 64 + kg * 8 + 4);
            const f4 k0 = *(const f4*)(kS + tt * 64 + kg * 8), k1 = *(const f4*)(kS + tt * 64 + kg * 8 + 4);
            const f4 q0 = *(const f4*)(qS + tt * 64 + kg * 8), q1 = *(const f4*)(qS + tt * 64 + kg * 8 + 4);
            const float vv = vS[tt * 64 + v];
            float acc = 0.f;
#pragma unroll
            for (int i2 = 0; i2 < 4; ++i2) { S[i2] = f0[i2] * S[i2] + k0[i2] * vv; acc += q0[i2] * S[i2]; }
#pragma unroll
            for (int i2 = 0; i2 < 4; ++i2) { S[4 + i2] = f1[i2] * S[4 + i2] + k1[i2] * vv; acc += q1[i2] * S[4 + i2]; }
            po[(tt * 8 + kg) * 64 + v] = acc;
        }
        __syncthreads();
#pragma unroll
        for (int e = 0; e < 2; ++e) { const int s_ = 16 * bi + stt[e]; const int pos_ = dir ? L - 1 - s_ : s_;
            float sum = 0.f;
#pragma unroll
            for (int g8 = 0; g8 < 8; ++g8) sum += po[(stt[e] * 8 + g8) * 64 + sk];
            O[(size_t)(b * L + pos_) * 256 + h * 64 + sk] = (bf16)f2bf(sum); }
        if (bi + 1 < NB) HG_STAGE(bi + 1);
        __syncthreads();
    }
#undef HG_LOAD
#undef HG_STAGE
}

__device__ __forceinline__ void phase_hgrn_post(CArgs ap, int l, int gw, int NGW, int lane) {
    unsigned char* ws = ap->ws;
    const bf16* OF = (const bf16*)(ws + cfg::WS_OFB); const bf16* OB = (const bf16*)(ws + cfg::WS_OFB + cfg::D_ARR); const bf16* DG = (const bf16*)(ws + cfg::WS_D + 4 * cfg::D_ARR);
    bf16* Y = (bf16*)ap->out;
    const float* og = ap->in[11] + l * 64 + ((4 * lane) & 63);
    for (int m = gw; m < T; m += NGW) {
        const size_t off = (size_t)m * 256 + 4 * lane;
        const v2u f = *(const v2u*)(OF + off), bb = *(const v2u*)(OB + off), g = *(const v2u*)(DG + off);
        float o[4] = {bflo(f.x) + bflo(bb.x), bfhi(f.x) + bfhi(bb.x), bflo(f.y) + bflo(bb.y), bfhi(f.y) + bfhi(bb.y)};
        const float gg[4] = {bflo(g.x), bfhi(g.x), bflo(g.y), bfhi(g.y)};
        float ss = (o[0] * o[0] + o[1] * o[1]) + (o[2] * o[2] + o[3] * o[3]);
        ss += __shfl_xor(ss, 1); ss += __shfl_xor(ss, 2); ss += __shfl_xor(ss, 4); ss += __shfl_xor(ss, 8);
        const float r = __builtin_amdgcn_rsqf(ss * (1.0f / 64.0f) + cfg::RMS_EPS);
        float y[4];
#pragma unroll
        for (int j = 0; j < 4; ++j) y[j] = o[j] * r * og[j] * (gg[j] / (1.0f + __expf(-gg[j])));
        v2u w; w.x = pk2(y[0], y[1]); w.y = pk2(y[2], y[3]);
        *(v2u*)(Y + (size_t)m * 1024 + 768 + 4 * lane) = w;
    }
}

__device__ __forceinline__ void phase_final(CArgs ap, int gw, int NGW, int lane) {
    typedef float f4 __attribute__((ext_vector_type(4)));
    const f4* gl = (const f4*)ap->in[18]; const bf16* hb = (const bf16*)(ap->ws + cfg::WS_HB);
    f4 g[4];
#pragma unroll
    for (int j = 0; j < 4; ++j) g[j] = gl[64 * j + lane];
    constexpr int NR = cfg::BATCH * cfg::SEQ;
    for (int r = gw; r < NR; r += NGW) {
        const int b = r / cfg::SEQ, s_ = r - b * cfg::SEQ; const v2u* src = (const v2u*)(hb + (size_t)(b * cfg::L + cfg::MEND + s_) * 1024);
        f4 v[4];
#pragma unroll
        for (int j = 0; j < 4; ++j) { const v2u w = src[64 * j + lane]; v[j] = (f4){bflo(w.x), bfhi(w.x), bflo(w.y), bfhi(w.y)}; }
        float s = 0.f;
#pragma unroll
        for (int j = 0; j < 4; ++j) s += (v[j][0] * v[j][0] + v[j][1] * v[j][1]) + (v[j][2] * v[j][2] + v[j][3] * v[j][3]);
        const float rs = __builtin_amdgcn_rsqf(wave_sum(s) * (1.0f / 1024.0f) + cfg::RMS_EPS);
        f4* row = (f4*)(ap->out + (size_t)r * 1024);
#pragma unroll
        for (int j = 0; j < 4; ++j) row[64 * j + lane] = v[j] * rs * g[j];
    }
}

constexpr int PH_PER_LAYER = 9, PH_FINAL = 18, N_PHASES = 19;
__global__ void __launch_bounds__(NWAVES * 64, 2) enc_fwd(Args a_unused) {
    extern __shared__ __attribute__((aligned(16))) unsigned char lds[];
    LAS unsigned char* ldsl = (LAS unsigned char*)lds;
    const int G = gridDim.x, bx = blockIdx.x, NGW = G * NWAVES;
    const int wave0 = __builtin_amdgcn_readfirstlane(threadIdx.x >> 6);
#define TIDS() unsigned z_ = 0u; asm volatile("" : "+v"(z_)); int tid = (wave0 << 6) | (int)__builtin_amdgcn_mbcnt_hi(~0u, __builtin_amdgcn_mbcnt_lo(~0u, z_));     \
    int bxl = bx; asm volatile("" : "+s"(bxl)); const int lane = tid & 63, wave = __builtin_amdgcn_readfirstlane(tid >> 6), gw = bxl * NWAVES + wave; (void)lane; (void)gw
    int lo, hi; { CArgs ap = phase_args(); lo = ap->ph_lo; hi = ap->ph_hi; }
#define IN(k) (lo <= (k) && (k) < hi)
#define HG_PTRS() const float* lbt_ = (const float*)(ws + cfg::WS_TAB + cfg::TAB_LB) + l * 512; \
    hg::Ptrs HP{(const bf16*)(ws + cfg::WS_D), (const bf16*)(ws + cfg::WS_D + cfg::D_ARR), (const bf16*)(ws + cfg::WS_D + 2 * cfg::D_ARR), (const bf16*)(ws + cfg::WS_D + 3 * cfg::D_ARR), (const bf16*)(ws + cfg::WS_D + 4 * cfg::D_ARR), \
                lbt_, lbt_ + 256, (float*)(ws + cfg::WS_OFB), (float*)(ws + cfg::WS_TAB + 65536)}
    for (int u = threadIdx.x; u < (cfg::LDS_BYTES - 131072) / 4; u += NWAVES * 64) ((LAS unsigned*)(ldsl + 131072))[u] = 0u;
    __syncthreads();
#if MK_SPLIT
#define GRID_BAR(k) do {} while (0)
#else
    cg::grid_group grid = cg::this_grid();
#if USE_XCD_BAR
    { CArgs ap = phase_args(); (void)xcd_barrier_post((unsigned*)ap->ws + CW_BAR, (volatile LAS unsigned*)(ldsl + MISC_OFF) + 8); }
#define GRID_BAR(k) do { { CArgs ap_ = phase_args(); XcdBarrier b_; b_.bar = (unsigned*)ap_->ws + CW_BAR; b_.x = xb_xcc_id(); { unsigned z_ = 0u; asm volatile("" : "+v"(z_)); b_.t0 = (wave0 == 0) && (__builtin_amdgcn_mbcnt_hi(~0u, __builtin_amdgcn_mbcnt_lo(~0u, z_)) == 0u); } b_.st = (volatile LAS unsigned*)(ldsl + MISC_OFF) + 8; xcd_barrier(b_); } } while (0)
#else
#define GRID_BAR(k) grid.sync()
#endif
#endif
#define SEAM(k) do { if (IN(k) && IN((k) + 1)) GRID_BAR(k); } while (0)
    for (int l = 0; l < cfg::DEPTH; ++l) {
        const int p0 = l * PH_PER_LAYER;
        if (l == 0 && IN(p0 + 0) && !(DIS & 1)) for (int rep_ = 0; rep_ < 1 + ((PROBE_REP >> 0) & 1); ++rep_) { if (rep_) GRID_BAR(1); TIDS(); CArgs ap = phase_args(); phase_w(ap, l, ldsl, gw, NGW, wave, lane); phase_init(ap, gw, NGW, lane, tid); }
        if (l == 0) SEAM(p0 + 0);
        if (IN(p0 + 1) && !(DIS & 2)) for (int rep_ = 0; rep_ < 1 + ((PROBE_REP >> 1) & 1); ++rep_) { if (rep_) GRID_BAR(1);
            TIDS(); CArgs ap = phase_args(); unsigned char* ws = ap->ws;
            pg8::Gemm g{(const bf16*)(ws + cfg::WS_HB), (const bf16*)(ws + cfg::WS_W1), T, cfg::NIN, 1024}; pg8::StaticOrder S; S.init(T, cfg::NIN, G, bxl);
            pg8::build_rstd_tables(S, (const float*)(ws + cfg::WS_SSQ), (LAS float*)(ldsl + pg8::RSTD_LDS_OFF), tid);
            pg8::Epi1 E{ws};
            pg8::gemm_phase<pg8::Epi1, pg8::StaticOrder, true, true>(ldsl, g, S, E, tid);
        }
        SEAM(p0 + 1);
        if (IN(p0 + 2) && !(DIS & 4)) for (int rep_ = 0; rep_ < 1 + ((PROBE_REP >> 2) & 1); ++rep_) { if (rep_) GRID_BAR(1);
            TIDS(); CArgs ap = phase_args(); unsigned char* ws = ap->ws;
#if NAIVE_ATTN
            constexpr int NI = 32 + 132 + 132 + 264;
            for (int it = bxl; it < NI; it += G) {
                __syncthreads();
                if (it < 32) hgrn_chain_item(ap, l, it, (float*)lds, tid);
                else if (it < 164) naive_attn_item<0>(ap, l, it - 32, (float*)lds, tid);
                else if (it < 296) naive_attn_item<1>(ap, l, it - 164, (float*)lds, tid);
                else naive_attn_item<2>(ap, l, it - 296, (float*)lds, tid);
            }
#else
            constexpr int CV1 = W_I1 / 64, CV2 = (W_NITEMS - W_I1) / 64;
            const int NCV = (l == 0) ? CV1 + CV2 : CV2;
            const int NH = 272, Q_SC = NH, Q_C = Q_SC + 32, Q_B = Q_C + 528, Q_CV = Q_B + 264, Q_A = Q_CV + NCV, Q_S3 = Q_A + 264, NI = Q_S3 + 272;
            volatile LAS unsigned* nxt = (volatile LAS unsigned*)(ldsl + MISC_OFF) + 16;
            const bool t0 = (tid == 0);
            unsigned nx = 0u; const unsigned one_ = 1u;
            if (t0) { CArgs ap3 = phase_args(); unsigned* hp_ = (unsigned*)ap3->ws + CW_SCHED + 64 * l + 128 * rep_; asm volatile("global_atomic_add %0, %1, %2, off sc0" : "=v"(nx) : "v"(hp_), "v"(one_) : "memory"); }
            { float* lutl = (float*)(lds + att::LDS_LUT); const float* tab = (const float*)(ws + cfg::WS_TAB);
              for (int i = tid; i < 1028; i += 512) { const int d_ = (i & 3) * 260 + (i >> 2); lutl[d_] = tab[cfg::TAB_LUTC / 4 + i]; lutl[1088 + d_] = tab[cfg::TAB_LUTA / 4 + i]; }
              if (tid < 64) { CArgs ap4 = phase_args(); lutl[2176 + tid] = ap4->in[10][l * 64 + tid]; lutl[2240 + tid] = ap4->in[11][l * 64 + tid]; if (tid < 4) lutl[2304 + tid] = ap4->in[6][l * 4 + tid]; } }
            for (;;) {
                if (t0) { asm volatile("s_waitcnt vmcnt(0)" : "+v"(nx) :: "memory"); *nxt = nx; }
                __syncthreads();
                int it = __builtin_amdgcn_readfirstlane((int)*nxt); asm volatile("" : "+s"(it));
                __syncthreads();
                if (it >= NI) break;
                if (t0) { CArgs ap3 = phase_args(); unsigned* hp_ = (unsigned*)ap3->ws + CW_SCHED + 64 * l + 128 * rep_; asm volatile("global_atomic_add %0, %1, %2, off sc0" : "=v"(nx) : "v"(hp_), "v"(one_) : "memory"); }
                int tq = tid; asm volatile("" : "+v"(tq));
                CArgs ap2 = phase_args(); unsigned char* ws = ap2->ws;
                unsigned* dep = (unsigned*)ws + CW_DEP + (l * 16) * 128 + rep_ * 4096;
#if PROBE_REP
                if (rep_ && !((PROBE_QMASK >> (it < NH ? 0 : it < Q_C ? 5 : it < Q_B ? 2 : it < Q_CV ? 1 : it < Q_A ? 4 : it < Q_S3 ? 3 : 6)) & 1)) continue;
#endif
                unsigned* sig = nullptr;
                if (it < NH) { HG_PTRS(); hg::s1_item(HP, it, (unsigned char*)lds, tq); sig = dep + hg::hg_item_bh(it) * 128; }
                else if (it >= Q_C && it < Q_B) { const float* tabf = (const float*)(ws + cfg::WS_TAB); att::Ctx C{ws + cfg::WS_QKV + 2 * cfg::QKV_MIX, (bf16*)ap2->out, nullptr, (const float*)(lds + att::LDS_LUT) + 2176, tabf[cfg::TAB_LAM / 4 + 2 * l], 1.0f - tabf[cfg::TAB_LAM / 4 + 2 * l + 1]}; ATT_UNIT<2>(C, it - Q_C, (char*)lds, tq); }
                else if (it < Q_C) { const int chain = it - Q_SC, bh = chain >> 1; dep_wait(dep + bh * 128, 17u, t0); HG_PTRS(); hg::scan_chain(HP, chain, tq); sig = dep + bh * 128 + 64; }
                else if (it < Q_CV) { att::Ctx C{ws + cfg::WS_QKV + 1 * cfg::QKV_MIX, (bf16*)ap2->out, nullptr, nullptr, 0.f, 0.f}; ATT_UNIT<1>(C, it - Q_B, (char*)lds, tq); }
                else if (it < Q_A) { const int wv = __builtin_amdgcn_readfirstlane(tq >> 6), ci = it - Q_CV; LAS float* scr = (LAS float*)(ldsl + wv * 16384); if (it == Q_CV && l == 0 && tq < 64) w_gains(ap2, 1, tq);
                    const bool nextW1 = (l == 0) && ci < CV1; const int lw = nextW1 ? 1 : l, r0 = (nextW1 ? ci * 64 : W_I1 + (ci - (l == 0 ? CV1 : 0)) * 64) + wv * 8;
                    w_run(ap2, lw, r0, 8, 1, scr, tq & 63); }
                else if (it < Q_S3) { att::Ctx C{ws + cfg::WS_QKV, (bf16*)ap2->out, (const float*)(lds + att::LDS_LUT) + 2304, nullptr, 0.f, 0.f}; att::attn_unit<0>(C, it - Q_A, (char*)lds, tq); }
                else { const int i3 = it - Q_S3; HG_PTRS(); hg::s3_item(HP, (const float*)(lds + att::LDS_LUT) + 2240, (bf16*)ap2->out, i3, (unsigned char*)lds, tq, [&]() { if (!(PROBE_REP && rep_ && !((PROBE_QMASK >> 5) & 1))) dep_wait(dep + hg::hg_item_bh(i3) * 128 + 64, 2u, t0); }); }
                asm volatile("" : "+s"(sig));
                dep_signal(sig, t0);
            }
#endif
        }
        SEAM(p0 + 2);
#if NAIVE_ATTN
        if (IN(p0 + 3) && !(DIS & 8)) { TIDS(); CArgs ap = phase_args(); phase_hgrn_post(ap, l, gw, NGW, lane); }
        SEAM(p0 + 3);
#endif
        if (IN(p0 + 5) && !(DIS & 16)) for (int rep_ = 0; rep_ < 1 + ((PROBE_REP >> 5) & 1); ++rep_) { if (rep_) GRID_BAR(1);
            TIDS(); CArgs ap = phase_args(); unsigned char* ws = ap->ws;
            pg8::tail_branch((const bf16*)ap->out  , (const bf16*)(ws + cfg::WS_WB), ws + cfg::WS_GATE, (bf16*)(ws + cfg::WS_MERGED), bxl, wave, lane, (float*)lds);
            pg8::Gemm g{(const bf16*)ap->out  , (const bf16*)(ws + cfg::WS_WB), pg8::TAIL_ROW0, 1024, 1024}; pg8::StaticOrder S; S.init(pg8::TAIL_ROW0, 1024, G, bxl);
            pg8::EpiHorner E{ws};
            pg8::gemm_phase<pg8::EpiHorner, pg8::StaticOrder, true, true>(ldsl, g, S, E, tid);
        }
        SEAM(p0 + 5);
        if (IN(p0 + 6) && !(DIS & 32)) for (int rep_ = 0; rep_ < 1 + ((PROBE_REP >> 6) & 1); ++rep_) { if (rep_) GRID_BAR(1);
            TIDS(); CArgs ap = phase_args(); unsigned char* ws = ap->ws;
            pg8::tail_res((const bf16*)(ws + cfg::WS_MERGED), (const bf16*)(ws + cfg::WS_WO), 1024, ap->out, (bf16*)(ws + cfg::WS_HB), (float*)(ws + cfg::WS_SSQ), 1, nullptr, nullptr, bxl, wave, lane, (float*)lds);
            pg8::Gemm g{(const bf16*)(ws + cfg::WS_MERGED), (const bf16*)(ws + cfg::WS_WO), pg8::TAIL_ROW0, 1024, 1024}; pg8::StaticOrder S; S.init(pg8::TAIL_ROW0, 1024, G, bxl);
            pg8::EpiRes E{ws, 1};
            pg8::gemm_phase<pg8::EpiRes, pg8::StaticOrder, true, true>(ldsl, g, S, E, tid);
        }
        SEAM(p0 + 6);
        if (IN(p0 + 7) && !(DIS & 64)) for (int rep_ = 0; rep_ < 1 + ((PROBE_REP >> 7) & 1); ++rep_) { if (rep_) GRID_BAR(1);
            TIDS(); CArgs ap = phase_args(); unsigned char* ws = ap->ws;
            pg8::Gemm g{(const bf16*)(ws + cfg::WS_HB), (const bf16*)(ws + cfg::WS_WGU), T, cfg::NGU, 1024}; pg8::StaticOrder S; S.init(T, cfg::NGU, G, bxl);
            pg8::build_rstd_tables(S, (const float*)(ws + cfg::WS_SSQ), (LAS float*)(ldsl + pg8::RSTD_LDS_OFF), tid);
            pg8::EpiGLU E{ws};
            pg8::gemm_phase<pg8::EpiGLU, pg8::StaticOrder, true, true>(ldsl, g, S, E, tid);
        }
        SEAM(p0 + 7);
        if (IN(p0 + 8) && !(DIS & 128)) for (int rep_ = 0; rep_ < 1 + ((PROBE_REP >> 8) & 1); ++rep_) { if (rep_) GRID_BAR(1);
            TIDS(); CArgs ap = phase_args(); unsigned char* ws = ap->ws;
            const bool fuse_final = (l + 1 == cfg::DEPTH) && (G == 256);
            pg8::tail_res((const bf16*)(ws + cfg::WS_FF), (const bf16*)(ws + cfg::WS_WD), cfg::DFF, ap->out, (bf16*)(ws + cfg::WS_HB), (float*)(ws + cfg::WS_SSQ), (l + 1 < cfg::DEPTH), fuse_final ? ap->in[18] : nullptr, (unsigned*)ws + cfg::CW_FIN + 1024, bxl, wave, lane, (float*)lds);
            pg8::Gemm g{(const bf16*)(ws + cfg::WS_FF), (const bf16*)(ws + cfg::WS_WD), pg8::TAIL_ROW0, 1024, cfg::DFF}; pg8::StaticOrder S; S.init(pg8::TAIL_ROW0, 1024, G, bxl);
            if (fuse_final) { pg8::EpiResFinal E{ap->out, ws, ap->in[18]}; pg8::gemm_phase<pg8::EpiResFinal, pg8::StaticOrder, false, true>(ldsl, g, S, E, tid); }
            else { pg8::EpiRes E{ws, (l + 1 < cfg::DEPTH) ? 1 : 0}; pg8::gemm_phase<pg8::EpiRes, pg8::StaticOrder, true, true>(ldsl, g, S, E, tid); }
        }
        if (!((l + 1 == cfg::DEPTH) && (G == 256))) SEAM(p0 + 8);
    }
    if (IN(PH_FINAL) && G != 256) { TIDS(); CArgs ap = phase_args(); phase_final(ap, gw, NGW, lane); }
#undef IN
#undef SEAM
}

extern "C" void kernel_launch(void* const* d_in, const int* in_sizes, int n_in, void* d_out, int out_size, void* d_ws, size_t ws_size, hipStream_t stream) {
    static int grid = 0;
    if (grid == 0) {
        if (n_in != 19 || ws_size < cfg::WS_END || out_size != cfg::BATCH * cfg::SEQ * cfg::DM) { fprintf(stderr, "kernel_launch: unexpected problem (n_in %d, ws %zu, out %d)\n", n_in, ws_size, out_size); grid = -1; return; }
        int dev = 0, cus = 0, per_cu = 0;
        hipGetDevice(&dev); hipDeviceGetAttribute(&cus, hipDeviceAttributeMultiprocessorCount, dev);
        hipFuncSetAttribute((const void*)enc_fwd, hipFuncAttributeMaxDynamicSharedMemorySize, cfg::LDS_BYTES);
        hipOccupancyMaxActiveBlocksPerMultiprocessor(&per_cu, (const void*)enc_fwd, NWAVES * 64, cfg::LDS_BYTES);
        if (per_cu < 1) { fprintf(stderr, "kernel_launch: occupancy query says %d blocks per CU\n", per_cu); per_cu = 1; }
        (void)hipGetLastError();
        grid = cus;
        if (cus != 256) fprintf(stderr, "kernel_launch: %d CUs; this kernel's thin-tail task map assumes 256 workgroups\n", cus);
    }
    if (grid < 0) return;
    (void)hipMemsetAsync(d_ws, 0, CTL_ZERO_BYTES, stream);
    Args a{};
    for (int i = 0; i < 19; ++i) a.in[i] = (const float*)d_in[i];
    a.out = (float*)d_out; a.ws = (unsigned char*)d_ws;
#if MK_SPLIT
    for (int p = 0; p < N_PHASES; ++p) { a.ph_lo = p; a.ph_hi = p + 1; hipLaunchKernelGGL(enc_fwd, dim3(grid), dim3(NWAVES * 64), cfg::LDS_BYTES, stream, a); }
#else
    a.ph_lo = 0; a.ph_hi = N_PHASES;
    void* args[] = {&a};
    hipError_t e = hipLaunchCooperativeKernel((const void*)enc_fwd, dim3(grid), dim3(NWAVES * 64), args, cfg::LDS_BYTES, stream);
    if (e != hipSuccess) fprintf(stderr, "kernel_launch: cooperative launch failed: %s (grid %d)\n", hipGetErrorString(e), grid);
#endif
}
```
